# Optimizing an MI355X kernel written in HIP

```python
import math
import jax, jax.numpy as jnp
from jax import lax
import numpy as np


D_MODEL = 1024
BATCH = 8
SEQ = 2048
DEPTH = 4

N_A = DEPTH // 2
N_B = DEPTH - N_A
RET_HEADS = 4
RET_QK_DIM = D_MODEL // RET_HEADS
RET_V_DIM = 2 * RET_QK_DIM
RET_CHUNK = 128
RET_ROPE_BASE = 10000.0
DIFF_HEAD_DIM = 64
DIFF_HEADS = D_MODEL // (2 * DIFF_HEAD_DIM)
DIFF_V_DIM = 2 * DIFF_HEAD_DIM
ROPE_THETA = 500000.0
ROPE_DIM = DIFF_HEAD_DIM // 4
Q_BLOCK = 128
D_FF = 4 * D_MODEL
EPS = 1e-6

kernel_name = 'yoco_retention_diffattn_sandwich_adaln'


def _rms(x, g=None):
    xf = x.astype(jnp.float32)
    y = xf * lax.rsqrt(jnp.mean(xf * xf, axis=-1, keepdims=True) + EPS)
    if g is not None:
        y = y * g.astype(jnp.float32)
    return y.astype(x.dtype)


def _rope_tables(positions, rot_dim, base, dtype):
    inv = base ** (-jnp.arange(0, rot_dim, 2, dtype=jnp.float32) / rot_dim)
    ang = positions.astype(jnp.float32)[..., None] * inv
    return jnp.cos(ang)[:, :, None, :].astype(dtype), jnp.sin(ang)[:, :, None, :].astype(dtype)


def _rope(x, cos, sin):
    r = 2 * cos.shape[-1]
    x1 = x[..., : r // 2]
    x2 = x[..., r // 2: r]
    return jnp.concatenate([x1 * cos - x2 * sin, x2 * cos + x1 * sin, x[..., r:]], axis=-1)


def _retention(h, cos, sin, w_in, w_out):
    B, S, _ = h.shape
    H, dk, dv, C = RET_HEADS, RET_QK_DIM, RET_V_DIM, RET_CHUNK
    N = S // C
    proj = h @ w_in
    q, k, v, g = jnp.split(proj, [H * dk, 2 * H * dk, 2 * H * dk + H * dv], axis=-1)
    q = _rope(q.reshape(B, S, H, dk), cos, sin)
    k = _rope(k.reshape(B, S, H, dk), cos, sin) * (dk ** -0.5)
    v = v.reshape(B, S, H, dv)
    to_chunks = lambda t: t.reshape(B, N, C, H, t.shape[-1]).transpose(1, 0, 3, 2, 4)
    qs, ks, vs = to_chunks(q), to_chunks(k), to_chunks(v)
    log_g = jnp.log1p(-jnp.exp2(-5.0 - jnp.arange(H, dtype=jnp.float32)))
    idx = jnp.arange(C, dtype=jnp.float32)
    diff = idx[:, None] - idx[None, :]
    dmask = jnp.where(diff >= 0, jnp.exp(jnp.maximum(diff, 0.0)[None] * log_g[:, None, None]), 0.0).astype(h.dtype)
    xi = jnp.exp((idx + 1.0)[None] * log_g[:, None]).astype(h.dtype)
    zeta = jnp.exp((C - 1.0 - idx)[None] * log_g[:, None]).astype(h.dtype)
    chunk_decay = jnp.exp(C * log_g).astype(h.dtype)
    intra = jnp.einsum('nbhcm,nbhme->nbhce', jnp.einsum('nbhcd,nbhmd->nbhcm', qs, ks) * dmask, vs)

    def step(R, inp):
        qc, kc, vc = inp
        cross = jnp.einsum('bhcd,bhde->bhce', qc, R) * xi[None, :, :, None]
        R = R * chunk_decay[None, :, None, None] + jnp.einsum('bhcd,bhce->bhde', kc, vc * zeta[None, :, :, None])
        return R, cross

    R0 = jnp.zeros((B, H, dk, dv), h.dtype)
    _, cross = lax.scan(step, R0, (qs, ks, vs))
    o = (intra + cross).transpose(1, 0, 3, 2, 4).reshape(B, S, H, dv)
    o = _rms(o).reshape(B, S, H * dv)
    return (jax.nn.silu(g) * o) @ w_out


def _shared_kv(x, c_act, g, ada_w, ada_b, w_kv, cos, sin):
    B, S, _ = x.shape
    shift, scale = jnp.split((c_act @ ada_w + ada_b)[:, None, :], 2, axis=-1)
    kv = (_rms(x, g) * (1 + scale) + shift) @ w_kv
    k, v = jnp.split(kv, 2, axis=-1)
    k = _rope(k.reshape(B, S, 2 * DIFF_HEADS, DIFF_HEAD_DIM), cos, sin)
    v = v.reshape(B, S, DIFF_HEADS, DIFF_V_DIM)
    return k, v


def _diff_attention(h, k, v, cos, sin, w_q, w_o, lam, subln_g, lambda_init):
    B, S, _ = h.shape
    H, d, QB = DIFF_HEADS, DIFF_HEAD_DIM, Q_BLOCK
    NB = S // QB
    q = _rope((h @ w_q).reshape(B, S, 2 * H, d), cos, sin) * (d ** -0.5)
    lf = lam.astype(jnp.float32)
    lam_full = jnp.exp(jnp.sum(lf[0] * lf[1])) - jnp.exp(jnp.sum(lf[2] * lf[3])) + lambda_init
    q_blocks = q.reshape(B, NB, QB, 2 * H, d).transpose(1, 0, 2, 3, 4)
    starts = jnp.arange(NB, dtype=jnp.int32) * QB
    key_idx = jnp.arange(S, dtype=jnp.int32)

    def block(args):
        qb, s0 = args
        s = jnp.einsum('bqhd,bkhd->bhqk', qb, k).astype(jnp.float32)
        causal = (s0 + jnp.arange(QB, dtype=jnp.int32))[:, None] >= key_idx[None, :]
        p = jax.nn.softmax(jnp.where(causal, s, -jnp.inf), axis=-1).reshape(B, H, 2, QB, S)
        w = (p[:, :, 0] - lam_full * p[:, :, 1]).astype(v.dtype)
        o = jnp.einsum('bhqk,bkhe->bqhe', w, v)
        return _rms(o, subln_g) * (1.0 - lambda_init)

    o = lax.map(block, (q_blocks, starts))
    return o.transpose(1, 0, 2, 3, 4).reshape(B, S, H * DIFF_V_DIM) @ w_o


def setup_inputs(seed: int = 0) -> dict:
    key = jax.random.key(seed)
    ks = jax.random.split(key, 18)
    D = D_MODEL
    nrm = lambda k, shape, s: jax.random.normal(k, shape, jnp.float32) * s
    x = nrm(ks[0], (BATCH, SEQ, D), 1.0)
    c = nrm(ks[1], (BATCH, D), 1.0)
    offsets = jax.random.randint(ks[2], (BATCH, 1), 0, 1024, dtype=jnp.int32)
    positions = offsets + jnp.arange(SEQ, dtype=jnp.int32)[None, :]
    return {
        'x': x,
        'c': c,
        'positions': positions,
        'norm_g': 1.0 + nrm(ks[3], (DEPTH, 4, D), 0.02),
        'ada_w': nrm(ks[4], (DEPTH, D, 6 * D), 0.5 * D ** -0.5),
        'ada_b': nrm(ks[5], (DEPTH, 6 * D), 0.01),
        'ret_w_in': nrm(ks[6], (N_A, D, 2 * RET_HEADS * RET_QK_DIM + 2 * RET_HEADS * RET_V_DIM), D ** -0.5),
        'ret_w_out': nrm(ks[7], (N_A, RET_HEADS * RET_V_DIM, D), (RET_HEADS * RET_V_DIM) ** -0.5),
        'kv_norm_g': 1.0 + nrm(ks[8], (D,), 0.02),
        'kv_ada_w': nrm(ks[9], (D, 2 * D), 0.5 * D ** -0.5),
        'kv_ada_b': nrm(ks[10], (2 * D,), 0.01),
        'kv_w': nrm(ks[11], (D, 2 * DIFF_HEADS * DIFF_HEAD_DIM + DIFF_HEADS * DIFF_V_DIM), D ** -0.5),
        'diff_w_q': nrm(ks[12], (N_B, D, 2 * DIFF_HEADS * DIFF_HEAD_DIM), D ** -0.5),
        'diff_w_o': nrm(ks[13], (N_B, DIFF_HEADS * DIFF_V_DIM, D), (DIFF_HEADS * DIFF_V_DIM) ** -0.5),
        'diff_lam': nrm(ks[14], (N_B, 4, DIFF_HEAD_DIM), 0.1),
        'diff_subln_g': 1.0 + nrm(ks[15], (N_B, DIFF_V_DIM), 0.02),
        'mlp_w1': nrm(ks[16], (DEPTH, D, D_FF), D ** -0.5),
        'mlp_w2': nrm(ks[17], (DEPTH, D_FF, D), D_FF ** -0.5),
    }


def reference(x, c, positions, norm_g, ada_w, ada_b, ret_w_in, ret_w_out, kv_norm_g, kv_ada_w, kv_ada_b,
              kv_w, diff_w_q, diff_w_o, diff_lam, diff_subln_g, mlp_w1, mlp_w2):
    c_act = jax.nn.silu(c)
    ret_cos, ret_sin = _rope_tables(positions, RET_QK_DIM, RET_ROPE_BASE, x.dtype)
    cos, sin = _rope_tables(positions, ROPE_DIM, ROPE_THETA, x.dtype)
    k_sh, v_sh = None, None
    for l in range(DEPTH):
        if l == N_A:
            k_sh, v_sh = _shared_kv(x, c_act, kv_norm_g, kv_ada_w, kv_ada_b, kv_w, cos, sin)
        mod = (c_act @ ada_w[l] + ada_b[l])[:, None, :]
        sh_a, sc_a, ga_a, sh_m, sc_m, ga_m = jnp.split(mod, 6, axis=-1)
        h = _rms(x, norm_g[l, 0]) * (1 + sc_a) + sh_a
        if l < N_A:
            y = _retention(h, ret_cos, ret_sin, ret_w_in[l], ret_w_out[l])
        else:
            j = l - N_A
            y = _diff_attention(h, k_sh, v_sh, cos, sin, diff_w_q[j], diff_w_o[j], diff_lam[j],
                                diff_subln_g[j], 0.8 - 0.6 * math.exp(-0.3 * l))
        x = x + (1 + ga_a) * _rms(y, norm_g[l, 1])
        h = _rms(x, norm_g[l, 2]) * (1 + sc_m) + sh_m
        y = jnp.square(jax.nn.relu(h @ mlp_w1[l])) @ mlp_w2[l]
        x = x + (1 + ga_m) * _rms(y, norm_g[l, 3])
    return x
```

```cpp
#include <hip/hip_runtime.h>
#include <hip/hip_cooperative_groups.h>
#include <cstdio>
#include <cstdint>
#include <cmath>
namespace cg = cooperative_groups;

#define LAS __attribute__((address_space(3)))
typedef unsigned short bf16_t;
typedef short bf16x8 __attribute__((ext_vector_type(8)));
typedef float f32x4 __attribute__((ext_vector_type(4)));
typedef float f32x16 __attribute__((ext_vector_type(16)));
typedef unsigned u32x4 __attribute__((ext_vector_type(4)));
typedef unsigned u32x2 __attribute__((ext_vector_type(2)));
typedef float f32x2_t __attribute__((ext_vector_type(2)));
typedef __bf16 bf16x2_t __attribute__((ext_vector_type(2)));

__device__ __forceinline__ unsigned pk2(float lo, float hi) { f32x2_t v = {lo, hi}; bf16x2_t b = __builtin_convertvector(v, bf16x2_t); return __builtin_bit_cast(unsigned, b); }
__device__ __forceinline__ bf16_t f2bf(float x) { return (bf16_t)(pk2(x, 0.f) & 0xffffu); }
__device__ __forceinline__ u32x4 pk8(f32x4 a, f32x4 b) { u32x4 w; w.x = pk2(a[0], a[1]); w.y = pk2(a[2], a[3]); w.z = pk2(b[0], b[1]); w.w = pk2(b[2], b[3]); return w; }
__device__ __forceinline__ float bf2f(unsigned short h) { return __uint_as_float(((unsigned)h) << 16); }

constexpr int DM = 1024, NB = 8, SEQ = 2048, MTOK = NB * SEQ, DFF = 4096;
constexpr float EPS = 1e-6f;
constexpr size_t MiB = 1u << 20;
constexpr size_t WS_MOD = 0, WS_KVMOD = 1 * MiB, WS_RCOS = 2 * MiB, WS_RSIN = 10 * MiB, WS_DCOS = 18 * MiB, WS_DSIN = 19 * MiB;
constexpr size_t WS_W = 20 * MiB;
constexpr size_t WS_H = 52 * MiB;
constexpr size_t WS_A = 84 * MiB;
constexpr size_t WS_B = 116 * MiB;
constexpr size_t WS_R = 148 * MiB;
constexpr size_t WS_KZT = 276 * MiB;
constexpr size_t WS_VT = 308 * MiB;
constexpr size_t WS_Y = 276 * MiB;
constexpr size_t WO_RET_IN = 0, WO_RET_OUT = 6291456, WO_RET_W1 = 8388608, WO_RET_W2 = 12582912;
constexpr size_t WO_DF_Q = 0, WO_DF_O = 1048576, WO_DF_W1 = 2097152, WO_DF_W2 = 6291456, WO_DF_KV = 10485760;

namespace pg8 {
#define PG8_LAS __attribute__((address_space(3)))
constexpr int BM = 256, BK = 64, HALF = 128, HTB = HALF * BK * 2, STAGE_BYTES = 8 * HTB, NXCD = 8, WGM = 8;
__host__ __device__ __forceinline__ int lds_byte(int r, int c) { const int st = (r >> 4) * 2 + (c >> 5), rr = r & 15, cc = c & 31, ob = rr * 64 + cc * 2; return st * 1024 + (ob ^ (((ob >> 9) & 1) << 5)); }
__host__ __device__ __forceinline__ void stage_rc(int b, int& R, int& C) { const int st = b / 1024, sb = b % 1024, swz = sb ^ (((sb >> 9) & 1) << 5); R = (st >> 1) * 16 + swz / 64; C = (st & 1) * 32 + (swz % 64) / 2; }
__host__ __device__ __forceinline__ int perm32(int rho) { const int n = rho >> 4, i = rho & 15; return 8 * (i >> 2) + 4 * n + (i & 3); }
struct Unit { int pm, pn; };
struct Gemm { const bf16_t* A; const bf16_t* Bt; int M, N, K; };
struct StaticOrder {
    int nM, nN, nwg, G, c;
    __host__ __device__ void init(int M, int N, int G_, int c_) { nM = M / BM; nN = N / BM; nwg = nM * nN; G = G_; c = c_; }
    __host__ __device__ bool next(int i, Unit& u) const {
        const long L = (long)i * G + c; if (L >= nwg) return false;
        int wgid = (int)L; { const int q = nwg / NXCD, r = nwg % NXCD, xcd = wgid % NXCD, off = wgid / NXCD; wgid = (xcd < r ? xcd * (q + 1) : r * (q + 1) + (xcd - r) * q) + off; }
        const int nig = WGM * nN, gid = wgid / nig, fm = gid * WGM, gsz = (nM - fm) < WGM ? (nM - fm) : WGM;
        u.pm = fm + ((wgid % nig) % gsz); u.pn = (wgid % nig) / gsz; return true;
    }
    __device__ __forceinline__ void a_ready(const Unit&) const {}
    __device__ __forceinline__ void done(const Unit&) const {}
};

struct EpiF32 {
    static constexpr bool PERM = false, AFTER_DRAIN = false;
    float* Y; int ldc;
    __device__ __forceinline__ void operator()(const f32x4 (&acc)[2][2][4][2], const Unit& u, int wr, int wc, int fr, int fq) const {
        int row0 = u.pm * BM + wr * 64 + fr, col0 = u.pn * BM + wc * 32 + 4 * fq;
        asm volatile("" : "+v"(row0), "+v"(col0));
#pragma unroll
        for (int ai = 0; ai < 2; ++ai)
#pragma unroll
            for (int m = 0; m < 4; ++m) { float* rp = Y + (size_t)(row0 + ai * HALF + m * 16) * ldc + col0;
#pragma unroll
                for (int bj = 0; bj < 2; ++bj)
#pragma unroll
                    for (int n = 0; n < 2; ++n) *(f32x4*)(rp + bj * HALF + n * 16) = acc[ai][bj][m][n]; }
    }
};
struct EpiRelu2 {
    static constexpr bool PERM = true, AFTER_DRAIN = false;
    bf16_t* O; int ldc;
    __device__ __forceinline__ void operator()(const f32x4 (&acc)[2][2][4][2], const Unit& u, int wr, int wc, int fr, int fq) const {
        const int row0 = u.pm * BM + wr * 64 + fr, col0 = u.pn * BM + wc * 32 + 8 * fq;
#pragma unroll
        for (int ai = 0; ai < 2; ++ai)
#pragma unroll
            for (int m = 0; m < 4; ++m) { bf16_t* rp = O + (size_t)(row0 + ai * HALF + m * 16) * ldc + col0;
#pragma unroll
                for (int bj = 0; bj < 2; ++bj) { f32x4 v0 = acc[ai][bj][m][0], v1 = acc[ai][bj][m][1];
#pragma unroll
                    for (int i = 0; i < 4; ++i) { float a = fmaxf(v0[i], 0.f), b = fmaxf(v1[i], 0.f); v0[i] = a * a; v1[i] = b * b; }
                    *(u32x4*)(rp + bj * HALF) = pk8(v0, v1); } }
    }
};
struct EpiRetProj {
    static constexpr bool PERM = true, AFTER_DRAIN = false;
    bf16_t *q, *k, *kzT, *vT, *g; const float *rcos, *rsin;
    __device__ __forceinline__ void operator()(const f32x4 (&acc)[2][2][4][2], const Unit& u, int wr, int wc, int fr, int fq) const {
        const int pn = u.pn, rbase = u.pm * BM + wr * 64 + fr, cl = wc * 32 + 8 * fq;
        if (pn < 8) {
            const int head = pn & 3; const bool isk = pn >= 4;
            const float lg = __log2f(1.0f - exp2f(-5.0f - (float)head));
            bf16_t* dst = isk ? k : q; const float sc = isk ? 0.0625f : 1.0f;
#pragma unroll
            for (int ai = 0; ai < 2; ++ai)
#pragma unroll
                for (int m = 0; m < 4; ++m) {
                    const int row = rbase + ai * HALF + m * 16;
                    const f32x4 c0 = *(const f32x4*)(rcos + (size_t)row * 128 + cl), c1 = *(const f32x4*)(rcos + (size_t)row * 128 + cl + 4);
                    const f32x4 s0 = *(const f32x4*)(rsin + (size_t)row * 128 + cl), s1 = *(const f32x4*)(rsin + (size_t)row * 128 + cl + 4);
                    const f32x4 a0 = acc[ai][0][m][0], a1 = acc[ai][0][m][1], b0 = acc[ai][1][m][0], b1 = acc[ai][1][m][1];
                    f32x4 o10 = (a0 * c0 - b0 * s0) * sc, o11 = (a1 * c1 - b1 * s1) * sc, o20 = (b0 * c0 + a0 * s0) * sc, o21 = (b1 * c1 + a1 * s1) * sc;
                    bf16_t* rp = dst + (size_t)row * 1024 + head * 256 + cl;
                    *(u32x4*)(rp) = pk8(o10, o11); *(u32x4*)(rp + 128) = pk8(o20, o21);
                    if (isk) {
                        const float zeta = exp2f((float)(127 - (row & 127)) * lg);
                        bf16_t* tb = kzT + ((size_t)((row >> 11) * 4 + head) * 256 + cl) * 2048 + (row & 2047);
#pragma unroll
                        for (int i = 0; i < 4; ++i) { tb[(size_t)i * 2048] = f2bf(o10[i] * zeta); tb[(size_t)(4 + i) * 2048] = f2bf(o11[i] * zeta);
                                                      tb[(size_t)(128 + i) * 2048] = f2bf(o20[i] * zeta); tb[(size_t)(132 + i) * 2048] = f2bf(o21[i] * zeta); }
                    }
                }
        } else if (pn < 16) {
            const int head = (pn - 8) >> 1, e0 = ((pn - 8) & 1) * 256 + cl;
#pragma unroll
            for (int ai = 0; ai < 2; ++ai)
#pragma unroll
                for (int m = 0; m < 4; ++m) {
                    const int row = rbase + ai * HALF + m * 16;
                    bf16_t* tb = vT + ((size_t)((row >> 11) * 4 + head) * 512 + e0) * 2048 + (row & 2047);
#pragma unroll
                    for (int bj = 0; bj < 2; ++bj)
#pragma unroll
                        for (int n = 0; n < 2; ++n)
#pragma unroll
                            for (int i = 0; i < 4; ++i) tb[(size_t)(bj * 128 + 4 * n + i) * 2048] = f2bf(acc[ai][bj][m][n][i]);
                }
        } else {
            const int col0 = (pn - 16) * 256 + cl;
#pragma unroll
            for (int ai = 0; ai < 2; ++ai)
#pragma unroll
                for (int m = 0; m < 4; ++m) { bf16_t* rp = g + (size_t)(rbase + ai * HALF + m * 16) * 2048 + col0;
#pragma unroll
                    for (int bj = 0; bj < 2; ++bj) *(u32x4*)(rp + bj * HALF) = pk8(acc[ai][bj][m][0], acc[ai][bj][m][1]); }
        }
    }
};
template <bool KV> struct EpiRope64 {
    static constexpr bool PERM = true, AFTER_DRAIN = false;
    bf16_t* dst; bf16_t* vT; const float *dcos, *dsin; float scale;
    __device__ __forceinline__ void operator()(const f32x4 (&acc)[2][2][4][2], const Unit& u, int wr, int wc, int fr, int fq) const {
        const int pn = u.pn, rbase = u.pm * BM + wr * 64 + fr, cl = wc * 32 + 8 * fq;
        if (!KV || pn < 4) {
            const bool dorope = ((wc & 1) == 0) && (fq < 2);
#pragma unroll
            for (int ai = 0; ai < 2; ++ai)
#pragma unroll
                for (int m = 0; m < 4; ++m) {
                    const int row = rbase + ai * HALF + m * 16;
                    const f32x4 c0 = *(const f32x4*)(dcos + (size_t)row * 8), c1 = *(const f32x4*)(dcos + (size_t)row * 8 + 4);
                    const f32x4 s0 = *(const f32x4*)(dsin + (size_t)row * 8), s1 = *(const f32x4*)(dsin + (size_t)row * 8 + 4);
                    bf16_t* rp = dst + (size_t)row * 1024 + pn * 256 + cl;
#pragma unroll
                    for (int bj = 0; bj < 2; ++bj) {
                        f32x4 v[2];
#pragma unroll
                        for (int n = 0; n < 2; ++n) {
                            const f32x4 x = acc[ai][bj][m][n]; f32x4 oth;
#pragma unroll
                            for (int i = 0; i < 4; ++i) oth[i] = __shfl_xor(x[i], 16);
                            const f32x4 cs = n ? c1 : c0, sn = n ? s1 : s0;
                            const f32x4 rot = (fq == 0) ? (x * cs - oth * sn) : (x * cs + oth * sn);
                            v[n] = (dorope ? rot : x) * scale;
                        }
                        *(u32x4*)(rp + bj * HALF) = pk8(v[0], v[1]);
                    }
                }
        } else {
#pragma unroll
            for (int ai = 0; ai < 2; ++ai)
#pragma unroll
                for (int m = 0; m < 4; ++m) {
                    const int row = rbase + ai * HALF + m * 16;
#pragma unroll
                    for (int bj = 0; bj < 2; ++bj) {
                        const int H = 2 * (pn - 4) + bj;
                        bf16_t* tb = vT + ((size_t)((row >> 11) * 8 + H) * 128 + cl) * 2048 + (row & 2047);
#pragma unroll
                        for (int n = 0; n < 2; ++n)
#pragma unroll
                            for (int i = 0; i < 4; ++i) tb[(size_t)(4 * n + i) * 2048] = f2bf(acc[ai][bj][m][n][i]);
                    }
                }
        }
    }
};

template <class Epi, class Sched, bool ALIGN_EPI = false, bool SP2 = false>
__device__ __forceinline__ void gemm_phase(PG8_LAS unsigned char* lds, const Gemm g, const Sched& S, const Epi& E) {
    int tid_o = threadIdx.x; asm volatile("" : "+v"(tid_o));
    const int tid = tid_o, wid = __builtin_amdgcn_readfirstlane(tid >> 6), lane = tid & 63, wr = wid >> 2, wc = wid & 3, fr = lane & 15, fq = lane >> 4;
    const int K = g.K, nt = K / BK;
    unsigned voffA[2], voffB[2];
#pragma unroll
    for (int i = 0; i < 2; ++i) { int R, C; stage_rc(tid * 16 + i * 8192, R, C); const int Rb = Epi::PERM ? ((R & ~31) + perm32(R & 31)) : R;
        voffA[i] = (unsigned)(R * K + C) * 2u; voffB[i] = (unsigned)(Rb * K + C) * 2u; }
    const size_t kstep = (size_t)(BK * 2);
    const size_t hstep = (size_t)HALF * K * 2;
    const size_t tstep = 2 * hstep;
    const unsigned ldsw = (unsigned)wid * 1024u;
    const int aoff = lds_byte(wr * 64 + fr, fq * 8), boff = lds_byte(wc * 32 + fr, fq * 8);
#define PG8_SA(b, h) (((b) * 2 + (h)) * HTB)
#define PG8_SB(b, h) ((4 + (b) * 2 + (h)) * HTB)
#define PG8_STAGE(bufoff, gbase, voff) do { _Pragma("unroll") for (int _i = 0; _i < 2; ++_i) \
        __builtin_amdgcn_global_load_lds((const unsigned*)((const char*)(gbase) + (voff)[_i]), (PG8_LAS unsigned*)(lds + (bufoff) + ldsw + _i * 8192), 16, 0, 0); } while (0)
#define PG8_LDA(dst, b, h) do { _Pragma("unroll") for (int m = 0; m < 4; ++m) _Pragma("unroll") for (int k = 0; k < 2; ++k) dst[m][k] = *(const PG8_LAS bf16x8*)(lds + PG8_SA(b, h) + aoff + m * 2048 + k * 1024); } while (0)
#define PG8_LDB(dst, b, h) do { _Pragma("unroll") for (int n = 0; n < 2; ++n) _Pragma("unroll") for (int k = 0; k < 2; ++k) dst[n][k] = *(const PG8_LAS bf16x8*)(lds + PG8_SB(b, h) + boff + n * 2048 + k * 1024); } while (0)
#define PG8_MMA(ai, bj, At, Bt) do { __builtin_amdgcn_s_setprio(1); _Pragma("unroll") for (int m = 0; m < 4; ++m) _Pragma("unroll") for (int n = 0; n < 2; ++n) _Pragma("unroll") for (int k = 0; k < 2; ++k) \
        acc[ai][bj][m][n] = __builtin_amdgcn_mfma_f32_16x16x32_bf16(Bt[n][k], At[m][k], acc[ai][bj][m][n], 0, 0, 0); __builtin_amdgcn_s_setprio(0); } while (0)
#define PG8_WAIT_V(n) asm volatile("s_waitcnt vmcnt(" #n ")" ::: "memory")
#define PG8_WAIT_L(n) asm volatile("s_waitcnt lgkmcnt(" #n ")" ::: "memory")
#define PG8_BAR __builtin_amdgcn_s_barrier()
#define PG8_SCHED __builtin_amdgcn_sched_barrier(0)
    Unit cur, nxt; int ui = 0;
    if (!S.next(0, cur)) return;
    f32x4 acc[2][2][4][2];
#pragma unroll
    for (int a = 0; a < 2; ++a)
#pragma unroll
        for (int b = 0; b < 2; ++b)
#pragma unroll
            for (int m = 0; m < 4; ++m)
#pragma unroll
                for (int n = 0; n < 2; ++n) acc[a][b][m][n] = (f32x4){0.f, 0.f, 0.f, 0.f};
    bf16x8 At[4][2], B0[2][2], B1[2][2];
    const char* cA = (const char*)g.A + (size_t)cur.pm * tstep; const char* cB = (const char*)g.Bt + (size_t)cur.pn * tstep;
    S.a_ready(cur);
    if constexpr (SP2) {
        PG8_STAGE(PG8_SB(0, 0), cB, voffB); PG8_STAGE(PG8_SB(0, 1), cB + hstep, voffB); PG8_STAGE(PG8_SA(0, 0), cA, voffA); PG8_STAGE(PG8_SA(0, 1), cA + hstep, voffA);
        if (wr == 1) PG8_BAR;
        PG8_WAIT_V(2); PG8_BAR;
        PG8_STAGE(PG8_SB(1, 0), cB + kstep, voffB); PG8_STAGE(PG8_SA(1, 0), cA + kstep, voffA); PG8_STAGE(PG8_SB(1, 1), cB + hstep + kstep, voffB);
        PG8_WAIT_V(6); PG8_BAR;
    } else {
        PG8_STAGE(PG8_SB(0, 0), cB, voffB); PG8_STAGE(PG8_SA(0, 0), cA, voffA); PG8_STAGE(PG8_SB(0, 1), cB + hstep, voffB); PG8_STAGE(PG8_SA(0, 1), cA + hstep, voffA);
        if (wr == 1) PG8_BAR;
        PG8_WAIT_V(4); PG8_BAR;
        PG8_STAGE(PG8_SB(1, 0), cB + kstep, voffB); PG8_STAGE(PG8_SA(1, 0), cA + kstep, voffA); PG8_STAGE(PG8_SB(1, 1), cB + hstep + kstep, voffB);
        PG8_WAIT_V(6); PG8_BAR;
    }
    for (;;) {
        const bool has_next = S.next(ui + 1, nxt);
        const char* nA = has_next ? (const char*)g.A + (size_t)nxt.pm * tstep : cA; const char* nB = has_next ? (const char*)g.Bt + (size_t)nxt.pn * tstep : cB;
        for (int t = 0; t < nt; t += 2) {
            const bool last = (t == nt - 2);
            const char* a1 = cA + (size_t)(t + 1) * kstep;
            const char* a2 = last ? nA : cA + (size_t)(t + 2) * kstep; const char* b2 = last ? nB : cB + (size_t)(t + 2) * kstep;
            const char* a3 = a2 + kstep; const char* b3 = b2 + kstep;
            if (last && has_next) S.a_ready(nxt);
            if constexpr (SP2) {
            PG8_LDB(B0, 0, 0); PG8_LDB(B1, 0, 1); PG8_SCHED; PG8_LDA(At, 0, 0); PG8_STAGE(PG8_SA(1, 1), a1 + hstep, voffA);
            PG8_WAIT_V(8); PG8_WAIT_L(0); PG8_BAR; PG8_MMA(0, 0, At, B0); PG8_MMA(0, 1, At, B1); PG8_BAR; PG8_SCHED;
            PG8_LDA(At, 0, 1); PG8_STAGE(PG8_SB(0, 0), b2, voffB); PG8_STAGE(PG8_SB(0, 1), b2 + hstep, voffB); PG8_STAGE(PG8_SA(0, 0), a2, voffA);
            PG8_WAIT_V(8); PG8_WAIT_L(0); PG8_BAR; PG8_MMA(1, 0, At, B0); PG8_MMA(1, 1, At, B1); PG8_BAR; PG8_SCHED;
            PG8_LDB(B0, 1, 0); PG8_LDB(B1, 1, 1); PG8_SCHED; PG8_LDA(At, 1, 0); PG8_STAGE(PG8_SA(0, 1), a2 + hstep, voffA);
            PG8_WAIT_V(8); PG8_WAIT_L(0); PG8_BAR; PG8_MMA(0, 0, At, B0); PG8_MMA(0, 1, At, B1); PG8_BAR; PG8_SCHED;
            PG8_LDA(At, 1, 1); PG8_STAGE(PG8_SB(1, 0), b3, voffB); PG8_STAGE(PG8_SB(1, 1), b3 + hstep, voffB); PG8_STAGE(PG8_SA(1, 0), a3, voffA);
            PG8_WAIT_V(8); PG8_WAIT_L(0); PG8_BAR; PG8_MMA(1, 0, At, B0); PG8_MMA(1, 1, At, B1); PG8_BAR; PG8_SCHED;
            } else {
            PG8_LDB(B0, 0, 0); PG8_SCHED; PG8_LDA(At, 0, 0); PG8_STAGE(PG8_SA(1, 1), a1 + hstep, voffA);
            PG8_WAIT_L(8); PG8_BAR; PG8_WAIT_L(0); PG8_MMA(0, 0, At, B0); PG8_BAR; PG8_SCHED;
            PG8_LDB(B1, 0, 1); PG8_STAGE(PG8_SB(0, 0), b2, voffB);
            PG8_BAR; PG8_WAIT_L(0); PG8_MMA(0, 1, At, B1); PG8_BAR;
            PG8_LDA(At, 0, 1); PG8_STAGE(PG8_SA(0, 0), a2, voffA);
            PG8_BAR; PG8_WAIT_L(0); PG8_MMA(1, 0, At, B0); PG8_BAR; PG8_SCHED;
            PG8_STAGE(PG8_SB(0, 1), b2 + hstep, voffB);
            PG8_WAIT_V(6); PG8_BAR; PG8_MMA(1, 1, At, B1); PG8_BAR;
            PG8_LDB(B0, 1, 0); PG8_SCHED; PG8_LDA(At, 1, 0); PG8_STAGE(PG8_SA(0, 1), a2 + hstep, voffA);
            PG8_WAIT_L(8); PG8_BAR; PG8_WAIT_L(0); PG8_MMA(0, 0, At, B0); PG8_BAR; PG8_SCHED;
            PG8_LDB(B1, 1, 1); PG8_STAGE(PG8_SB(1, 0), b3, voffB);
            PG8_BAR; PG8_WAIT_L(0); PG8_MMA(0, 1, At, B1); PG8_BAR;
            PG8_LDA(At, 1, 1); PG8_STAGE(PG8_SA(1, 0), a3, voffA);
            PG8_BAR; PG8_WAIT_L(0); PG8_MMA(1, 0, At, B0); PG8_BAR; PG8_SCHED;
            PG8_STAGE(PG8_SB(1, 1), b3 + hstep, voffB);
            PG8_WAIT_V(6); PG8_BAR; PG8_MMA(1, 1, At, B1); PG8_BAR;
            }
        }
        if constexpr (ALIGN_EPI) { if (wr == 0) PG8_BAR; }
        if constexpr (!Epi::AFTER_DRAIN) { E(acc, cur, wr, wc, fr, fq); S.done(cur); }
        if (!has_next) break;
#pragma unroll
        for (int a = 0; a < 2; ++a)
#pragma unroll
            for (int b = 0; b < 2; ++b)
#pragma unroll
                for (int m = 0; m < 4; ++m)
#pragma unroll
                    for (int n = 0; n < 2; ++n) acc[a][b][m][n] = (f32x4){0.f, 0.f, 0.f, 0.f};
        cur = nxt; cA = nA; cB = nB; ++ui;
        if constexpr (ALIGN_EPI) { if (wr == 1) PG8_BAR; }
    }
    PG8_WAIT_V(0);
    if constexpr (!ALIGN_EPI) { if (wr == 0) PG8_BAR; }
    PG8_BAR;
    if constexpr (Epi::AFTER_DRAIN) { E.fused(acc, cur, wr, wc, fr, fq, lds, wid, lane); S.done(cur); }
#undef PG8_SA
#undef PG8_SB
#undef PG8_STAGE
#undef PG8_LDA
#undef PG8_LDB
#undef PG8_MMA
#undef PG8_WAIT_V
#undef PG8_WAIT_L
#undef PG8_BAR
#undef PG8_SCHED
}
}

__device__ __forceinline__ int opq_tid() { int t = threadIdx.x; asm volatile("" : "+v"(t)); return t; }
#define MFMA32(a, b, c) __builtin_amdgcn_mfma_f32_32x32x16_bf16((a), (b), (c), 0, 0, 0)
__device__ __forceinline__ int crow(int r, int hi) { return (r & 3) + 8 * (r >> 2) + 4 * hi; }
__device__ __forceinline__ float wave_sum(float v) {
#pragma unroll
    for (int o = 1; o < 64; o <<= 1) v += __shfl_xor(v, o);
    return v;
}
__device__ __forceinline__ f32x16 zero16() { f32x16 z;
#pragma unroll
    for (int i = 0; i < 16; ++i) z[i] = 0.f;
    return z; }

__device__ __forceinline__ void p0_mod_gemv(LAS unsigned char* lds, const float* c, const float* ada_w, const float* ada_b, const float* kv_ada_w, const float* kv_ada_b, float* mod, float* kvmod) {
    LAS float* cact = (LAS float*)lds;
    LAS float* red = (LAS float*)(lds + 32768);
    const int tid = opq_tid();
    for (int i = tid; i < 8192; i += 512) { const float v = c[i]; cact[i] = v / (1.0f + expf(-v)); }
    __syncthreads();
    const int cg4 = tid & 15, kg = tid >> 4;
    for (int u = blockIdx.x; u < 416; u += gridDim.x) {
        const float* W; const float* bias; float* out; int N, cb;
        if (u < 384) { const int l = u / 96; cb = (u % 96) * 64; W = ada_w + (size_t)l * 1024 * 6144; N = 6144; bias = ada_b + l * 6144; out = mod + (size_t)l * 8 * 6144; }
        else { cb = (u - 384) * 64; W = kv_ada_w; N = 2048; bias = kv_ada_b; out = kvmod; }
        f32x4 acc[8];
#pragma unroll
        for (int b = 0; b < 8; ++b) acc[b] = (f32x4){0.f, 0.f, 0.f, 0.f};
        const float* wp = W + (size_t)(kg * 32) * N + cb + 4 * cg4;
#pragma unroll 4
        for (int kk = 0; kk < 32; ++kk) {
            const f32x4 w = *(const f32x4*)(wp + (size_t)kk * N);
#pragma unroll
            for (int b = 0; b < 8; ++b) acc[b] += w * cact[b * 1024 + kg * 32 + kk];
        }
#pragma unroll
        for (int b = 0; b < 8; ++b) *(LAS f32x4*)(red + (kg * 8 + b) * 64 + 4 * cg4) = acc[b];
        __syncthreads();
        { const int b = tid >> 6, col = tid & 63; float s = bias[cb + col];
#pragma unroll 8
          for (int g = 0; g < 32; ++g) s += red[(g * 8 + b) * 64 + col];
          out[(size_t)b * N + cb + col] = s; }
        __syncthreads();
    }
}


__device__ __forceinline__ void gemv8(LAS unsigned char* lds, const float* in, int K, const float* W, int N, float* out, int act) {
    LAS float* cact = (LAS float*)lds;
    LAS float* red = (LAS float*)(lds + 32768);
    const int tid = opq_tid();
    const int cg4 = tid & 15, kg = tid >> 4;
    for (int u = blockIdx.x; u < N / 64; u += gridDim.x) {
        f32x4 acc[8];
#pragma unroll
        for (int b = 0; b < 8; ++b) acc[b] = (f32x4){0.f, 0.f, 0.f, 0.f};
        for (int kc = 0; kc < K; kc += 1024) {
            __syncthreads();
            for (int i = tid; i < 8192; i += 512) cact[i] = in[(size_t)(i >> 10) * K + kc + (i & 1023)];
            __syncthreads();
            const float* wp = W + (size_t)(kc + kg * 32) * N + u * 64 + 4 * cg4;
#pragma unroll 4
            for (int kk = 0; kk < 32; ++kk) {
                const f32x4 w = *(const f32x4*)(wp + (size_t)kk * N);
#pragma unroll
                for (int b = 0; b < 8; ++b) acc[b] += w * cact[b * 1024 + kg * 32 + kk];
            }
        }
#pragma unroll
        for (int b = 0; b < 8; ++b) *(LAS f32x4*)(red + (kg * 8 + b) * 64 + 4 * cg4) = acc[b];
        __syncthreads();
        { const int b = tid >> 6, col = tid & 63; float s = 0.f;
#pragma unroll 8
          for (int g = 0; g < 32; ++g) s += red[(g * 8 + b) * 64 + col];
          if (act == 1) { s = fmaxf(s, 0.f); s = s * s; }
          out[(size_t)b * N + u * 64 + col] = s; }
        __syncthreads();
    }
}

__device__ __forceinline__ void transpose_item(const float* W, int K, int N, bf16_t* WT, LAS float* scr, int item, int lane) {
    const int nblk = N / 32, kb = item / nblk, nb = item % nblk, k0 = 64 * kb, n0 = 32 * nb;
#pragma unroll 8
    for (int i = 0; i < 32; ++i) { const int kk = 2 * i + (lane >> 5); scr[kk * 33 + (lane & 31)] = W[(size_t)(k0 + kk) * N + n0 + (lane & 31)]; }
    asm volatile("s_waitcnt lgkmcnt(0)" ::: "memory");
    const int c = lane & 7;
#pragma unroll
    for (int j = 0; j < 4; ++j) { const int n = (lane >> 3) + 8 * j; const LAS float* s = scr + (8 * c) * 33 + n;
        u32x4 o; o.x = pk2(s[0 * 33], s[1 * 33]); o.y = pk2(s[2 * 33], s[3 * 33]); o.z = pk2(s[4 * 33], s[5 * 33]); o.w = pk2(s[6 * 33], s[7 * 33]);
        *(u32x4*)(WT + (size_t)(n0 + n) * K + k0 + 8 * c) = o; }
    asm volatile("s_waitcnt lgkmcnt(0)" ::: "memory");
}
struct WSpec { const float* W; int K, N; size_t off; };
__device__ __forceinline__ void convert_weights(LAS unsigned char* lds, bf16_t* wbuf, const WSpec& a, const WSpec& b, const WSpec& c, const WSpec& d, const WSpec& e, int nmat) {
    const int tid = opq_tid(); const int lane = tid & 63, wave = tid >> 6;
    LAS float* scr = (LAS float*)(lds + wave * 16384);
    const int gw = blockIdx.x * 8 + wave, NGW = gridDim.x * 8;
    const int ia = (a.K / 64) * (a.N / 32), ib = (b.K / 64) * (b.N / 32), ic = (c.K / 64) * (c.N / 32), id = (d.K / 64) * (d.N / 32), ie = nmat > 4 ? (e.K / 64) * (e.N / 32) : 0;
    const int total = ia + ib + ic + id + ie;
    for (int it = gw; it < total; it += NGW) {
        int r = it;
        if (r < ia) { transpose_item(a.W, a.K, a.N, wbuf + a.off, scr, r, lane); continue; } r -= ia;
        if (r < ib) { transpose_item(b.W, b.K, b.N, wbuf + b.off, scr, r, lane); continue; } r -= ib;
        if (r < ic) { transpose_item(c.W, c.K, c.N, wbuf + c.off, scr, r, lane); continue; } r -= ic;
        if (r < id) { transpose_item(d.W, d.K, d.N, wbuf + d.off, scr, r, lane); continue; } r -= id;
        transpose_item(e.W, e.K, e.N, wbuf + e.off, scr, r, lane);
    }
}

__device__ __forceinline__ void rope_tables(const int* pos, float* rcos, float* rsin, float* dcos, float* dsin) {
    const int gt = blockIdx.x * 512 + opq_tid(), NT = gridDim.x * 512;
    for (int idx = gt; idx < MTOK * 128; idx += NT) {
        const int tok = idx >> 7, j = idx & 127;
        const float inv = (float)exp2(-(double)(2 * j) * (13.287712379549449 / 256.0));
        const float ang = (float)pos[tok] * inv;
        double rv = (double)ang * 0.15915494309189535; rv -= rint(rv);
        const float fr = (float)rv;
        rcos[idx] = __builtin_amdgcn_cosf(fr); rsin[idx] = __builtin_amdgcn_sinf(fr);
    }
    for (int idx = gt; idx < MTOK * 8; idx += NT) {
        const int tok = idx >> 3, j = idx & 7;
        const float inv = (float)exp2(-(double)(2 * j) * (18.931568569324174 / 16.0));
        const float ang = (float)pos[tok] * inv;
        double rv = (double)ang * 0.15915494309189535; rv -= rint(rv);
        const float fr = (float)rv;
        dcos[idx] = __builtin_amdgcn_cosf(fr); dsin[idx] = __builtin_amdgcn_sinf(fr);
    }
}

__device__ __forceinline__ void row_phase(const float* xin, float* xout, const float* y, const float* gy, const float* gate, int gate_bs,
                                          int nout, const float* g0, const float* sc0, const float* sh0, int bs0, bf16_t* d0,
                                          const float* g1, const float* sc1, const float* sh1, int bs1, bf16_t* d1, const float* ysh, float* h0s) {
    const int tid = opq_tid(); const int lane = tid & 63, gw = blockIdx.x * 8 + (tid >> 6), NGW = gridDim.x * 8;
    for (int row = gw; row < MTOK; row += NGW) {
        const int b = row >> 11;
        f32x4 xv[4];
#pragma unroll
        for (int j = 0; j < 4; ++j) xv[j] = *(const f32x4*)(xin + (size_t)row * 1024 + 4 * lane + 256 * j);
        if (y) {
            f32x4 yv[4]; float s = 0.f;
            const float* yrow = (ysh && (row & 2047) == 0) ? (ysh + (size_t)b * 1024) : (y + (size_t)row * 1024);
#pragma unroll
            for (int j = 0; j < 4; ++j) { yv[j] = *(const f32x4*)(yrow + 4 * lane + 256 * j); s += (yv[j][0] * yv[j][0] + yv[j][1] * yv[j][1]) + (yv[j][2] * yv[j][2] + yv[j][3] * yv[j][3]); }
            const float rstd = rsqrtf(wave_sum(s) * (1.0f / 1024.0f) + EPS);
#pragma unroll
            for (int j = 0; j < 4; ++j) { const int col = 4 * lane + 256 * j;
                const f32x4 gg = *(const f32x4*)(gy + col), ga = *(const f32x4*)(gate + (size_t)b * gate_bs + col);
                xv[j] += (ga + 1.0f) * (yv[j] * rstd * gg);
                *(f32x4*)(xout + (size_t)row * 1024 + col) = xv[j]; }
        }
        if (nout > 0) {
            float s = 0.f;
#pragma unroll
            for (int j = 0; j < 4; ++j) s += (xv[j][0] * xv[j][0] + xv[j][1] * xv[j][1]) + (xv[j][2] * xv[j][2] + xv[j][3] * xv[j][3]);
            const float rstd = rsqrtf(wave_sum(s) * (1.0f / 1024.0f) + EPS);
#pragma unroll
            for (int j = 0; j < 4; ++j) { const int col = 4 * lane + 256 * j;
                const f32x4 gg = *(const f32x4*)(g0 + col), sc = *(const f32x4*)(sc0 + (size_t)b * bs0 + col), sh = *(const f32x4*)(sh0 + (size_t)b * bs0 + col);
                const f32x4 h = (xv[j] * rstd * gg) * (sc + 1.0f) + sh;
                u32x2 w; w.x = pk2(h[0], h[1]); w.y = pk2(h[2], h[3]);
                *(u32x2*)(d0 + (size_t)row * 1024 + col) = w;
                if (h0s && (row & 2047) == 0) *(f32x4*)(h0s + (size_t)b * 1024 + col) = h; }
            if (nout > 1) {
#pragma unroll
                for (int j = 0; j < 4; ++j) { const int col = 4 * lane + 256 * j;
                    const f32x4 gg = *(const f32x4*)(g1 + col), sc = *(const f32x4*)(sc1 + (size_t)b * bs1 + col), sh = *(const f32x4*)(sh1 + (size_t)b * bs1 + col);
                    const f32x4 h = (xv[j] * rstd * gg) * (sc + 1.0f) + sh;
                    u32x2 w; w.x = pk2(h[0], h[1]); w.y = pk2(h[2], h[3]);
                    *(u32x2*)(d1 + (size_t)row * 1024 + col) = w; }
            }
        }
    }
}

__device__ __forceinline__ void gate_phase(bf16_t* o, const bf16_t* g, const float* proj0, float* gated0) {
    const int tid = opq_tid(); const int lane = tid & 63, gw = blockIdx.x * 8 + (tid >> 6), NGW = gridDim.x * 8;
    if (gw < 32) {
        const int b = gw >> 2, h = gw & 3; const float* pr = proj0 + (size_t)b * 6144;
        const f32x4 qv = *(const f32x4*)(pr + h * 256 + 4 * lane), kv = *(const f32x4*)(pr + 1024 + h * 256 + 4 * lane);
        const float s00 = wave_sum((qv[0] * kv[0] + qv[1] * kv[1]) + (qv[2] * kv[2] + qv[3] * kv[3])) * 0.0625f;
        const f32x4 v0 = *(const f32x4*)(pr + 2048 + h * 512 + 8 * lane), v1 = *(const f32x4*)(pr + 2048 + h * 512 + 8 * lane + 4);
        const f32x4 g0 = *(const f32x4*)(pr + 4096 + h * 512 + 8 * lane), g1 = *(const f32x4*)(pr + 4096 + h * 512 + 8 * lane + 4);
        const f32x4 o0 = v0 * s00, o1 = v1 * s00;
        const float ss = wave_sum((o0[0] * o0[0] + o0[1] * o0[1]) + (o0[2] * o0[2] + o0[3] * o0[3]) + (o1[0] * o1[0] + o1[1] * o1[1]) + (o1[2] * o1[2] + o1[3] * o1[3]));
        const float rstd = rsqrtf(ss * (1.0f / 512.0f) + EPS);
        f32x4 r0, r1;
#pragma unroll
        for (int i = 0; i < 4; ++i) { r0[i] = (g0[i] / (1.0f + expf(-g0[i]))) * (o0[i] * rstd); r1[i] = (g1[i] / (1.0f + expf(-g1[i]))) * (o1[i] * rstd); }
        *(f32x4*)(gated0 + (size_t)b * 2048 + h * 512 + 8 * lane) = r0; *(f32x4*)(gated0 + (size_t)b * 2048 + h * 512 + 8 * lane + 4) = r1;
    }
    for (int it = gw; it < MTOK * 4; it += NGW) {
        const size_t off = (size_t)it * 512 + 8 * lane;
        const u32x4 ov = *(const u32x4*)(o + off), gv = *(const u32x4*)(g + off);
        float of[8], gf[8];
#pragma unroll
        for (int i = 0; i < 4; ++i) { of[2 * i] = __uint_as_float(ov[i] << 16); of[2 * i + 1] = __uint_as_float(ov[i] & 0xffff0000u);
                                      gf[2 * i] = __uint_as_float(gv[i] << 16); gf[2 * i + 1] = __uint_as_float(gv[i] & 0xffff0000u); }
        float s = 0.f;
#pragma unroll
        for (int i = 0; i < 8; ++i) s += of[i] * of[i];
        const float rstd = rsqrtf(wave_sum(s) * (1.0f / 512.0f) + EPS);
        float r[8];
#pragma unroll
        for (int i = 0; i < 8; ++i) r[i] = (gf[i] / (1.0f + __expf(-gf[i]))) * (of[i] * rstd);
        u32x4 w; w.x = pk2(r[0], r[1]); w.y = pk2(r[2], r[3]); w.z = pk2(r[4], r[5]); w.w = pk2(r[6], r[7]);
        *(u32x4*)(o + off) = w;
    }
}

constexpr int P_LD = 136, R_LD = 264;
__device__ __forceinline__ void ret_scan(LAS unsigned char* lds, const bf16_t* q, const bf16_t* k, const bf16_t* kzT, const bf16_t* vT, bf16_t* o) {
    LAS bf16_t* Pl = (LAS bf16_t*)lds;
    LAS bf16_t* Rl = (LAS bf16_t*)(lds + 128 * P_LD * 2);
    const int tid = opq_tid(); const int lane = tid & 63, wid = __builtin_amdgcn_readfirstlane(tid >> 6), l31 = lane & 31, hi = lane >> 5;
    for (int unit = blockIdx.x; unit < 256; unit += gridDim.x) {
        const int b = unit >> 5, h = (unit >> 3) & 3, es = unit & 7;
        const float lg = __log2f(1.0f - exp2f(-5.0f - (float)h));
        const float decay = exp2f(128.0f * lg);
        f32x16 Rt[2]; Rt[0] = zero16(); Rt[1] = zero16();
        const bf16_t* vTb = vT + ((size_t)(b * 4 + h) * 512 + es * 64) * 2048;
        const bf16_t* kzb = kzT + ((size_t)(b * 4 + h) * 256 + 32 * wid + l31) * 2048;
        for (int n = 0; n < 16; ++n) {
            const int t0 = b * 2048 + n * 128;
#pragma unroll
            for (int eb = 0; eb < 2; ++eb)
#pragma unroll
                for (int r = 0; r < 16; ++r) Rl[(32 * eb + crow(r, hi)) * R_LD + 32 * wid + l31] = f2bf(Rt[eb][r]);
            {
                const int cb = wid >> 1;
                const bf16_t* qa = q + (size_t)(t0 + 32 * cb + l31) * 1024 + h * 256 + 8 * hi;
#pragma unroll
                for (int mt = 0; mt < 2; ++mt) {
                    const int mb = 2 * (wid & 1) + mt;
                    f32x16 acc = zero16();
                    if (mb <= cb) {
                        const bf16_t* kb = k + (size_t)(t0 + 32 * mb + l31) * 1024 + h * 256 + 8 * hi;
#pragma unroll
                        for (int ks = 0; ks < 16; ++ks) acc = MFMA32(*(const bf16x8*)(qa + 16 * ks), *(const bf16x8*)(kb + 16 * ks), acc);
                    }
#pragma unroll
                    for (int r = 0; r < 16; ++r) {
                        const int c = 32 * cb + crow(r, hi), m = 32 * mb + l31, df = c - m;
                        const float v = (df >= 0) ? acc[r] * exp2f((float)df * lg) : 0.f;
                        Pl[c * P_LD + m] = f2bf(v);
                    }
                }
            }
            __syncthreads();
            {
                const int cb = wid >> 1, eb = wid & 1;
                const bf16_t* qa = q + (size_t)(t0 + 32 * cb + l31) * 1024 + h * 256 + 8 * hi;
                f32x16 acc = zero16();
#pragma unroll
                for (int ks = 0; ks < 16; ++ks) acc = MFMA32(*(const bf16x8*)(qa + 16 * ks), *(const LAS bf16x8*)(Rl + (32 * eb + l31) * R_LD + 16 * ks + 8 * hi), acc);
#pragma unroll
                for (int r = 0; r < 16; ++r) acc[r] *= exp2f((float)(32 * cb + crow(r, hi) + 1) * lg);
                const bf16_t* vb = vTb + (size_t)(32 * eb + l31) * 2048 + n * 128 + 8 * hi;
                for (int ks = 0; ks < 2 * (cb + 1); ++ks) acc = MFMA32(*(const LAS bf16x8*)(Pl + (32 * cb + l31) * P_LD + 16 * ks + 8 * hi), *(const bf16x8*)(vb + 16 * ks), acc);
                bf16_t* op = o + (size_t)(t0 + 32 * cb) * 2048 + h * 512 + es * 64 + 32 * eb + l31;
#pragma unroll
                for (int r = 0; r < 16; ++r) op[(size_t)crow(r, hi) * 2048] = f2bf(acc[r]);
            }
#pragma unroll
            for (int eb = 0; eb < 2; ++eb) {
                const bf16_t* va = vTb + (size_t)(32 * eb + l31) * 2048 + n * 128 + 8 * hi;
                f32x16 acc = Rt[eb] * decay;
#pragma unroll
                for (int ks = 0; ks < 8; ++ks) acc = MFMA32(*(const bf16x8*)(va + 16 * ks), *(const bf16x8*)(kzb + n * 128 + 16 * ks + 8 * hi), acc);
                Rt[eb] = acc;
            }
            __syncthreads();
        }
    }
}

__device__ __forceinline__ void diff_attn(LAS unsigned char* lds, const bf16_t* qb_, const bf16_t* ksh, const bf16_t* vTsh, bf16_t* aout,
                                          const float* lam, const float* subg, float linit) {
    LAS float* xch = (LAS float*)lds;
    const int tid = opq_tid(); const int lane = tid & 63, wid = __builtin_amdgcn_readfirstlane(tid >> 6), l31 = lane & 31, hi = lane >> 5, grp = wid >> 2, wq = wid & 3;
    float lam_full;
    { const float p1 = lam[lane] * lam[64 + lane], p2 = lam[128 + lane] * lam[192 + lane];
      lam_full = expf(wave_sum(p1)) - expf(wave_sum(p2)) + linit; }
    const int pi_l = 16 * (((l31 & 3) + 4 * (l31 >> 3)) >> 3) + 8 * ((l31 >> 2) & 1) + (((l31 & 3) + 4 * (l31 >> 3)) & 7);
    for (int u = blockIdx.x; u < 1024; u += gridDim.x) {
        const int vv = u & 255, ii = u >> 8, bh = vv >> 2, s4 = vv & 3;
        const int qblk = (ii == 0) ? s4 : (ii == 1) ? 7 - s4 : (ii == 2) ? 8 + s4 : 15 - s4;
        const int b = bh >> 3, H = bh & 7, head = 2 * H + grp;
        const int qs0 = qblk * 128 + 32 * wq, myq = qs0 + l31;
        bf16x8 qf[4];
        { const bf16_t* qp = qb_ + (size_t)(b * 2048 + myq) * 1024 + head * 64 + 8 * hi;
#pragma unroll
          for (int ks = 0; ks < 4; ++ks) qf[ks] = *(const bf16x8*)(qp + 16 * ks); }
        f32x16 OT[4];
#pragma unroll
        for (int e = 0; e < 4; ++e) OT[e] = zero16();
        float m_run = -1e30f, l_run = 0.f;
        const int ntiles = qblk * 4 + wq + 1;
        const bf16_t* kbase = ksh + (size_t)(b * 2048 + pi_l) * 1024 + head * 64 + 8 * hi;
        const bf16_t* vbase = vTsh + ((size_t)(b * 8 + H) * 128 + l31) * 2048 + 8 * hi;
        for (int t = 0; t < ntiles; ++t) {
            const int kv0 = 32 * t;
            f32x16 acc = zero16();
            { const bf16_t* kp = kbase + (size_t)kv0 * 1024;
#pragma unroll
              for (int ks = 0; ks < 4; ++ks) acc = MFMA32(*(const bf16x8*)(kp + 16 * ks), qf[ks], acc); }
            if (t == ntiles - 1) {
#pragma unroll
                for (int r = 0; r < 16; ++r) { const int kv = kv0 + 16 * (r >> 3) + 8 * hi + (r & 7); if (kv > myq) acc[r] = -INFINITY; }
            }
            float rm = acc[0];
#pragma unroll
            for (int r = 1; r < 16; ++r) rm = fmaxf(rm, acc[r]);
            rm = fmaxf(rm, __shfl_xor(rm, 32));
            const float m_new = fmaxf(m_run, rm);
            const float alpha = __builtin_amdgcn_exp2f(m_run - m_new);
            float rs = 0.f;
#pragma unroll
            for (int r = 0; r < 16; ++r) { acc[r] = __builtin_amdgcn_exp2f(acc[r] - m_new); rs += acc[r]; }
            rs += __shfl_xor(rs, 32);
            l_run = l_run * alpha + rs; m_run = m_new;
#pragma unroll
            for (int e = 0; e < 4; ++e) OT[e] *= alpha;
            bf16x8 pf[2];
#pragma unroll
            for (int kk = 0; kk < 2; ++kk) { u32x4 w; w.x = pk2(acc[8 * kk], acc[8 * kk + 1]); w.y = pk2(acc[8 * kk + 2], acc[8 * kk + 3]); w.z = pk2(acc[8 * kk + 4], acc[8 * kk + 5]); w.w = pk2(acc[8 * kk + 6], acc[8 * kk + 7]);
                                             pf[kk] = __builtin_bit_cast(bf16x8, w); }
            const bf16_t* vp = vbase + kv0;
#pragma unroll
            for (int e = 0; e < 4; ++e)
#pragma unroll
                for (int kk = 0; kk < 2; ++kk) OT[e] = MFMA32(*(const bf16x8*)(vp + (size_t)(32 * e) * 2048 + 16 * kk), pf[kk], OT[e]);
        }
        const float inv = 1.0f / l_run;
        if (grp == 1) {
            const float f = inv * lam_full;
#pragma unroll
            for (int e = 0; e < 4; ++e)
#pragma unroll
                for (int r = 0; r < 16; ++r) xch[(wq * 64 + e * 16 + r) * 64 + lane] = OT[e][r] * f;
        }
        __syncthreads();
        if (grp == 0) {
            float ss = 0.f;
#pragma unroll
            for (int e = 0; e < 4; ++e)
#pragma unroll
                for (int r = 0; r < 16; ++r) { const float v = OT[e][r] * inv - xch[(wq * 64 + e * 16 + r) * 64 + lane]; OT[e][r] = v; ss += v * v; }
            ss += __shfl_xor(ss, 32);
            const float rstd = rsqrtf(ss * (1.0f / 128.0f) + EPS) * (1.0f - linit);
            bf16_t* op = aout + (size_t)(b * 2048 + myq) * 1024 + H * 128;
#pragma unroll
            for (int e = 0; e < 4; ++e)
#pragma unroll
                for (int a = 0; a < 4; ++a) {
                    const int e0 = 32 * e + 8 * a + 4 * hi;
                    const f32x4 gg = *(const f32x4*)(subg + e0);
                    u32x2 w; w.x = pk2(OT[e][4 * a] * rstd * gg[0], OT[e][4 * a + 1] * rstd * gg[1]); w.y = pk2(OT[e][4 * a + 2] * rstd * gg[2], OT[e][4 * a + 3] * rstd * gg[3]);
                    *(u32x2*)(op + e0) = w;
                }
        }
        __syncthreads();
    }
}

struct Params {
    const float *x, *c; const int* pos;
    const float *norm_g, *ada_w, *ada_b, *ret_w_in, *ret_w_out, *kv_norm_g, *kv_ada_w, *kv_ada_b, *kv_w, *diff_w_q, *diff_w_o, *diff_lam, *diff_subln_g, *mlp_w1, *mlp_w2;
    float* out; unsigned char* ws; float linit2, linit3, pad0, pad1;
};
constexpr int LDS_BYTES = 147456;

__device__ __forceinline__ void convert_layer(LAS unsigned char* lds, const Params& p, int l) {
    bf16_t* wbuf = (bf16_t*)(p.ws + WS_W);
    if (l < 2) {
        WSpec a{p.ret_w_in + (size_t)l * 1024 * 6144, 1024, 6144, WO_RET_IN}, b{p.ret_w_out + (size_t)l * 2048 * 1024, 2048, 1024, WO_RET_OUT},
              c{p.mlp_w1 + (size_t)l * 1024 * 4096, 1024, 4096, WO_RET_W1}, d{p.mlp_w2 + (size_t)l * 4096 * 1024, 4096, 1024, WO_RET_W2};
        convert_weights(lds, wbuf, a, b, c, d, d, 4);
    } else {
        const int j = l - 2;
        WSpec a{p.diff_w_q + (size_t)j * 1024 * 1024, 1024, 1024, WO_DF_Q}, b{p.diff_w_o + (size_t)j * 1024 * 1024, 1024, 1024, WO_DF_O},
              c{p.mlp_w1 + (size_t)l * 1024 * 4096, 1024, 4096, WO_DF_W1}, d{p.mlp_w2 + (size_t)l * 4096 * 1024, 4096, 1024, WO_DF_W2},
              e{p.kv_w, 1024, 2048, WO_DF_KV};
        convert_weights(lds, wbuf, a, b, c, d, e, l == 2 ? 5 : 4);
    }
}

__global__ void __launch_bounds__(512, 2) yoco_fwd(Params p) {
    extern __shared__ __attribute__((aligned(16))) unsigned char lds_raw[];
    LAS unsigned char* lds = (LAS unsigned char*)lds_raw;
    cg::grid_group grid = cg::this_grid();
    unsigned char* ws = p.ws;
    float* mod = (float*)(ws + WS_MOD); float* kvmod = (float*)(ws + WS_KVMOD);
    float* rcos = (float*)(ws + WS_RCOS); float* rsin = (float*)(ws + WS_RSIN); float* dcos = (float*)(ws + WS_DCOS); float* dsin = (float*)(ws + WS_DSIN);
    bf16_t* wbuf = (bf16_t*)(ws + WS_W); bf16_t* hbuf = (bf16_t*)(ws + WS_H);
    bf16_t* bufA = (bf16_t*)(ws + WS_A); bf16_t* bufB = (bf16_t*)(ws + WS_B);
    bf16_t* ubuf = (bf16_t*)(ws + WS_R);
    bf16_t* gbuf = (bf16_t*)(ws + WS_R); bf16_t* obuf = (bf16_t*)(ws + WS_R + 64 * MiB);
    bf16_t* qbuf = (bf16_t*)(ws + WS_R); bf16_t* aout = (bf16_t*)(ws + WS_R + 32 * MiB); bf16_t* hkv = (bf16_t*)(ws + WS_R + 64 * MiB);
    bf16_t* kzT = (bf16_t*)(ws + WS_KZT); bf16_t* vT = (bf16_t*)(ws + WS_VT);
    float* ybuf = (float*)(ws + WS_Y);
    float* h0s = (float*)(ws + WS_KVMOD + 131072); float* proj0 = (float*)(ws + WS_KVMOD + 196608); float* gated0 = (float*)(ws + WS_KVMOD + 393216);
    float* y0s = (float*)(ws + WS_KVMOD + 458752); float* u0s = (float*)(ws + WS_KVMOD + 524288);
    const int G = gridDim.x, bx = blockIdx.x;
#define GSYNC() do { asm volatile("s_waitcnt vmcnt(0) lgkmcnt(0)" ::: "memory"); grid.sync(); } while (0)

    p0_mod_gemv(lds, p.c, p.ada_w, p.ada_b, p.kv_ada_w, p.kv_ada_b, mod, kvmod);
    __syncthreads();
    convert_layer(lds, p, 0);
    rope_tables(p.pos, rcos, rsin, dcos, dsin);
    GSYNC();
    row_phase(p.x, nullptr, nullptr, nullptr, nullptr, 0, 1, p.norm_g, mod + 1024, mod, 6144, hbuf, nullptr, nullptr, nullptr, 0, nullptr, nullptr, h0s);
    GSYNC();

#pragma unroll
    for (int l = 0; l < 4; ++l) {
        const float* ng = p.norm_g + (size_t)l * 4 * 1024;
        const float* modl = mod + (size_t)l * 8 * 6144;
        const float* xcur = (l == 0) ? p.x : p.out;
        const bf16_t* mixA; const bf16_t* mixB; int mixK;
        if (l < 2) {
            {
                pg8::Gemm g{hbuf, wbuf + WO_RET_IN, MTOK, 6144, 1024}; pg8::StaticOrder S; S.init(MTOK, 6144, G, bx);
                pg8::EpiRetProj E{bufA, bufB, kzT, vT, gbuf, rcos, rsin};
#ifndef NO_G1
                pg8::gemm_phase<pg8::EpiRetProj, pg8::StaticOrder, true, true>(lds, g, S, E);
#endif
            }
            gemv8(lds, h0s, 1024, p.ret_w_in + (size_t)l * 1024 * 6144, 6144, proj0, 0);
            GSYNC();
#ifndef NO_RET
            ret_scan(lds, bufA, bufB, kzT, vT, obuf);
#endif
            GSYNC();
            gate_phase(obuf, gbuf, proj0, gated0);
            GSYNC();
            mixA = obuf; mixB = wbuf + WO_RET_OUT; mixK = 2048;
        } else {
            {
                pg8::Gemm g{hbuf, wbuf + WO_DF_Q, MTOK, 1024, 1024}; pg8::StaticOrder S; S.init(MTOK, 1024, G, bx);
                pg8::EpiRope64<false> E{qbuf, nullptr, dcos, dsin, 0.125f * 1.4426950408889634f};
#ifndef NO_GQ
                pg8::gemm_phase<pg8::EpiRope64<false>, pg8::StaticOrder, true, true>(lds, g, S, E);
#endif
            }
            if (l == 2) {
                pg8::Gemm g{hkv, wbuf + WO_DF_KV, MTOK, 2048, 1024}; pg8::StaticOrder S; S.init(MTOK, 2048, G, bx);
                pg8::EpiRope64<true> E{bufA, bufB, dcos, dsin, 1.0f};
#ifndef NO_GKV
                pg8::gemm_phase<pg8::EpiRope64<true>, pg8::StaticOrder, true, true>(lds, g, S, E);
#endif
            }
            GSYNC();
#ifndef NO_ATT
            diff_attn(lds, qbuf, bufA, bufB, aout, p.diff_lam + (size_t)(l - 2) * 256, p.diff_subln_g + (size_t)(l - 2) * 128, (l == 2) ? p.linit2 : p.linit3);
#endif
            GSYNC();
            mixA = aout; mixB = wbuf + WO_DF_O; mixK = 1024;
        }
        {
            pg8::Gemm g{mixA, mixB, MTOK, 1024, mixK}; pg8::StaticOrder S; S.init(MTOK, 1024, G, bx);
            pg8::EpiF32 E{ybuf, 1024};
#ifndef NO_GF
            pg8::gemm_phase<pg8::EpiF32, pg8::StaticOrder, true, true>(lds, g, S, E);
#endif
        }
        if (l < 2) gemv8(lds, gated0, 2048, p.ret_w_out + (size_t)l * 2048 * 1024, 1024, y0s, 0);
        GSYNC();
        row_phase(xcur, p.out, ybuf, ng + 1024, modl + 2048, 6144, 1, ng + 2048, modl + 4096, modl + 3072, 6144, hbuf, nullptr, nullptr, nullptr, 0, nullptr, (l < 2) ? y0s : nullptr, (l < 2) ? h0s : nullptr);
        GSYNC();
        {
            pg8::Gemm g{hbuf, wbuf + (l < 2 ? WO_RET_W1 : WO_DF_W1), MTOK, 4096, 1024}; pg8::StaticOrder S; S.init(MTOK, 4096, G, bx);
            pg8::EpiRelu2 E{ubuf, 4096};
#ifndef NO_GR
            pg8::gemm_phase<pg8::EpiRelu2, pg8::StaticOrder, true, true>(lds, g, S, E);
#endif
        }
        if (l < 2) gemv8(lds, h0s, 1024, p.mlp_w1 + (size_t)l * 1024 * 4096, 4096, u0s, 1);
        GSYNC();
        {
            pg8::Gemm g{ubuf, wbuf + (l < 2 ? WO_RET_W2 : WO_DF_W2), MTOK, 1024, 4096}; pg8::StaticOrder S; S.init(MTOK, 1024, G, bx);
            pg8::EpiF32 E{ybuf, 1024};
#ifndef NO_GF
            pg8::gemm_phase<pg8::EpiF32, pg8::StaticOrder, true, true>(lds, g, S, E);
#endif
        }
        if (l < 2) gemv8(lds, u0s, 4096, p.mlp_w2 + (size_t)l * 4096 * 1024, 1024, y0s, 0);
        GSYNC();
        if (l < 3) {
            const float* ngn = p.norm_g + (size_t)(l + 1) * 4 * 1024; const float* modn = mod + (size_t)(l + 1) * 8 * 6144;
            row_phase(p.out, p.out, ybuf, ng + 3072, modl + 5120, 6144, (l == 1) ? 2 : 1, ngn, modn + 1024, modn, 6144, hbuf,
                      p.kv_norm_g, kvmod + 1024, kvmod, 2048, hkv, (l < 2) ? y0s : nullptr, (l == 0) ? h0s : nullptr);
            __syncthreads();
            convert_layer(lds, p, l + 1);
            GSYNC();
        } else {
            row_phase(p.out, p.out, ybuf, ng + 3072, modl + 5120, 6144, 0, nullptr, nullptr, nullptr, 0, nullptr, nullptr, nullptr, nullptr, 0, nullptr, nullptr, nullptr);
        }
    }
}

extern "C" void kernel_launch(void* const* d_in, const int* in_sizes, int n_in, void* d_out, int out_size, void* d_ws, size_t ws_size, hipStream_t stream) {
    static int grid_blocks = 0;
    if (!grid_blocks) {
        int dev = 0, cus = 0, per_cu = 0;
        hipGetDevice(&dev);
        hipDeviceGetAttribute(&cus, hipDeviceAttributeMultiprocessorCount, dev);
        hipFuncSetAttribute((const void*)yoco_fwd, hipFuncAttributeMaxDynamicSharedMemorySize, LDS_BYTES);
        if (hipOccupancyMaxActiveBlocksPerMultiprocessor(&per_cu, (const void*)yoco_fwd, 512, LDS_BYTES) != hipSuccess || per_cu < 1) per_cu = 1;
        (void)hipGetLastError();
        if (cus < 1) cus = 256;
        grid_blocks = cus * per_cu;
    }
    Params p{};
    p.x = (const float*)d_in[0]; p.c = (const float*)d_in[1]; p.pos = (const int*)d_in[2];
    p.norm_g = (const float*)d_in[3]; p.ada_w = (const float*)d_in[4]; p.ada_b = (const float*)d_in[5];
    p.ret_w_in = (const float*)d_in[6]; p.ret_w_out = (const float*)d_in[7]; p.kv_norm_g = (const float*)d_in[8];
    p.kv_ada_w = (const float*)d_in[9]; p.kv_ada_b = (const float*)d_in[10]; p.kv_w = (const float*)d_in[11];
    p.diff_w_q = (const float*)d_in[12]; p.diff_w_o = (const float*)d_in[13]; p.diff_lam = (const float*)d_in[14];
    p.diff_subln_g = (const float*)d_in[15]; p.mlp_w1 = (const float*)d_in[16]; p.mlp_w2 = (const float*)d_in[17];
    p.out = (float*)d_out; p.ws = (unsigned char*)d_ws;
    p.linit2 = (float)(0.8 - 0.6 * exp(-0.3 * 2.0)); p.linit3 = (float)(0.8 - 0.6 * exp(-0.3 * 3.0));
    void* args[] = {&p};
    hipError_t e = hipLaunchCooperativeKernel((const void*)yoco_fwd, dim3(grid_blocks), dim3(512), args, LDS_BYTES, stream);
    if (e != hipSuccess) fprintf(stderr, "cooperative launch failed: %s (grid %d)\n", hipGetErrorString(e), grid_blocks);
}
```

```cpp
#include <hip/hip_runtime.h>
#include <hip/hip_cooperative_groups.h>
#include <cstdio>
#include <cstdint>
#include <cmath>
namespace cg = cooperative_groups;

#define LAS __attribute__((address_space(3)))
typedef unsigned short bf16_t;
typedef short bf16x8 __attribute__((ext_vector_type(8)));
typedef float f32x4 __attribute__((ext_vector_type(4)));
typedef float f32x16 __attribute__((ext_vector_type(16)));
typedef unsigned u32x4 __attribute__((ext_vector_type(4)));
typedef unsigned u32x2 __attribute__((ext_vector_type(2)));
typedef float f32x2_t __attribute__((ext_vector_type(2)));
typedef __bf16 bf16x2_t __attribute__((ext_vector_type(2)));

__device__ __forceinline__ unsigned pk2(float lo, float hi) { f32x2_t v = {lo, hi}; bf16x2_t b = __builtin_convertvector(v, bf16x2_t); return __builtin_bit_cast(unsigned, b); }
__device__ __forceinline__ bf16_t f2bf(float x) { return (bf16_t)(pk2(x, 0.f) & 0xffffu); }
__device__ __forceinline__ u32x4 pk8(f32x4 a, f32x4 b) { u32x4 w; w.x = pk2(a[0], a[1]); w.y = pk2(a[2], a[3]); w.z = pk2(b[0], b[1]); w.w = pk2(b[2], b[3]); return w; }
__device__ __forceinline__ float bf2f(unsigned short h) { return __uint_as_float(((unsigned)h) << 16); }

constexpr int DM = 1024, NB = 8, SEQ = 2048, MTOK = NB * SEQ, DFF = 4096;
constexpr float EPS = 1e-6f;
constexpr size_t MiB = 1u << 20;
constexpr size_t WS_MOD = 0, WS_KVMOD = 1 * MiB, WS_RCOS = 2 * MiB, WS_RSIN = 10 * MiB, WS_DCOS = 18 * MiB, WS_DSIN = 19 * MiB;
constexpr size_t WS_W = 20 * MiB;
constexpr size_t WS_H = 52 * MiB;
constexpr size_t WS_A = 84 * MiB;
constexpr size_t WS_B = 116 * MiB;
constexpr size_t WS_R = 148 * MiB;
constexpr size_t WS_KZT = 276 * MiB;
constexpr size_t WS_VT = 308 * MiB;
constexpr size_t WS_Y = 276 * MiB;
constexpr size_t WO_RET_IN = 0, WO_RET_OUT = 6291456, WO_RET_W1 = 8388608, WO_RET_W2 = 12582912;
constexpr size_t WO_DF_Q = 0, WO_DF_O = 1048576, WO_DF_W1 = 2097152, WO_DF_W2 = 6291456, WO_DF_KV = 10485760;

namespace pg8 {
#define PG8_LAS __attribute__((address_space(3)))
constexpr int BM = 256, BK = 64, HALF = 128, HTB = HALF * BK * 2, STAGE_BYTES = 8 * HTB, NXCD = 8, WGM = 8;
__host__ __device__ __forceinline__ int lds_byte(int r, int c) { const int st = (r >> 4) * 2 + (c >> 5), rr = r & 15, cc = c & 31, ob = rr * 64 + cc * 2; return st * 1024 + (ob ^ (((ob >> 9) & 1) << 5)); }
__host__ __device__ __forceinline__ void stage_rc(int b, int& R, int& C) { const int st = b / 1024, sb = b % 1024, swz = sb ^ (((sb >> 9) & 1) << 5); R = (st >> 1) * 16 + swz / 64; C = (st & 1) * 32 + (swz % 64) / 2; }
__host__ __device__ __forceinline__ int perm32(int rho) { const int n = rho >> 4, i = rho & 15; return 8 * (i >> 2) + 4 * n + (i & 3); }
struct Unit { int pm, pn; };
struct Gemm { const bf16_t* A; const bf16_t* Bt; int M, N, K; };
struct StaticOrder {
    int nM, nN, nwg, G, c;
    __host__ __device__ void init(int M, int N, int G_, int c_) { nM = M / BM; nN = N / BM; nwg = nM * nN; G = G_; c = c_; }
    __host__ __device__ bool next(int i, Unit& u) const {
        const long L = (long)i * G + c; if (L >= nwg) return false;
        int wgid = (int)L; { const int q = nwg / NXCD, r = nwg % NXCD, xcd = wgid % NXCD, off = wgid / NXCD; wgid = (xcd < r ? xcd * (q + 1) : r * (q + 1) + (xcd - r) * q) + off; }
        const int nig = WGM * nN, gid = wgid / nig, fm = gid * WGM, gsz = (nM - fm) < WGM ? (nM - fm) : WGM;
        u.pm = fm + ((wgid % nig) % gsz); u.pn = (wgid % nig) / gsz; return true;
    }
    __device__ __forceinline__ void a_ready(const Unit&) const {}
    __device__ __forceinline__ void done(const Unit&) const {}
};

struct EpiF32 {
    static constexpr bool PERM = false, AFTER_DRAIN = false;
    float* Y; int ldc;
    __device__ __forceinline__ void operator()(const f32x4 (&acc)[2][2][4][2], const Unit& u, int wr, int wc, int fr, int fq) const {
        int row0 = u.pm * BM + wr * 64 + fr, col0 = u.pn * BM + wc * 32 + 4 * fq;
        asm volatile("" : "+v"(row0), "+v"(col0));
#pragma unroll
        for (int ai = 0; ai < 2; ++ai)
#pragma unroll
            for (int m = 0; m < 4; ++m) { float* rp = Y + (size_t)(row0 + ai * HALF + m * 16) * ldc + col0;
#pragma unroll
                for (int bj = 0; bj < 2; ++bj)
#pragma unroll
                    for (int n = 0; n < 2; ++n) *(f32x4*)(rp + bj * HALF + n * 16) = acc[ai][bj][m][n]; }
    }
};
struct EpiRelu2 {
    static constexpr bool PERM = true, AFTER_DRAIN = false;
    bf16_t* O; int ldc;
    __device__ __forceinline__ void operator()(const f32x4 (&acc)[2][2][4][2], const Unit& u, int wr, int wc, int fr, int fq) const {
        const int row0 = u.pm * BM + wr * 64 + fr, col0 = u.pn * BM + wc * 32 + 8 * fq;
#pragma unroll
        for (int ai = 0; ai < 2; ++ai)
#pragma unroll
            for (int m = 0; m < 4; ++m) { bf16_t* rp = O + (size_t)(row0 + ai * HALF + m * 16) * ldc + col0;
#pragma unroll
                for (int bj = 0; bj < 2; ++bj) { f32x4 v0 = acc[ai][bj][m][0], v1 = acc[ai][bj][m][1];
#pragma unroll
                    for (int i = 0; i < 4; ++i) { float a = fmaxf(v0[i], 0.f), b = fmaxf(v1[i], 0.f); v0[i] = a * a; v1[i] = b * b; }
                    *(u32x4*)(rp + bj * HALF) = pk8(v0, v1); } }
    }
};
struct EpiRetProj {
    static constexpr bool PERM = true, AFTER_DRAIN = false;
    bf16_t *q, *k, *kzT, *vT, *g; const float *rcos, *rsin;
    __device__ __forceinline__ void operator()(const f32x4 (&acc)[2][2][4][2], const Unit& u, int wr, int wc, int fr, int fq) const {
        const int pn = u.pn, rbase = u.pm * BM + wr * 64 + fr, cl = wc * 32 + 8 * fq;
        if (pn < 8) {
            const int head = pn & 3; const bool isk = pn >= 4;
            const float lg = __log2f(1.0f - exp2f(-5.0f - (float)head));
            bf16_t* dst = isk ? k : q; const float sc = isk ? 0.0625f : 1.0f;
#pragma unroll
            for (int ai = 0; ai < 2; ++ai)
#pragma unroll
                for (int m = 0; m < 4; ++m) {
                    const int row = rbase + ai * HALF + m * 16;
                    const f32x4 c0 = *(const f32x4*)(rcos + (size_t)row * 128 + cl), c1 = *(const f32x4*)(rcos + (size_t)row * 128 + cl + 4);
                    const f32x4 s0 = *(const f32x4*)(rsin + (size_t)row * 128 + cl), s1 = *(const f32x4*)(rsin + (size_t)row * 128 + cl + 4);
                    const f32x4 a0 = acc[ai][0][m][0], a1 = acc[ai][0][m][1], b0 = acc[ai][1][m][0], b1 = acc[ai][1][m][1];
                    f32x4 o10 = (a0 * c0 - b0 * s0) * sc, o11 = (a1 * c1 - b1 * s1) * sc, o20 = (b0 * c0 + a0 * s0) * sc, o21 = (b1 * c1 + a1 * s1) * sc;
                    bf16_t* rp = dst + (size_t)row * 1024 + head * 256 + cl;
                    *(u32x4*)(rp) = pk8(o10, o11); *(u32x4*)(rp + 128) = pk8(o20, o21);
                    if (isk) {
                        const float zeta = exp2f((float)(127 - (row & 127)) * lg);
                        bf16_t* tb = kzT + ((size_t)((row >> 11) * 4 + head) * 256 + cl) * 2048 + (row & 2047);
#pragma unroll
                        for (int i = 0; i < 4; ++i) { tb[(size_t)i * 2048] = f2bf(o10[i] * zeta); tb[(size_t)(4 + i) * 2048] = f2bf(o11[i] * zeta);
                                                      tb[(size_t)(128 + i) * 2048] = f2bf(o20[i] * zeta); tb[(size_t)(132 + i) * 2048] = f2bf(o21[i] * zeta); }
                    }
                }
        } else if (pn < 16) {
            const int head = (pn - 8) >> 1, e0 = ((pn - 8) & 1) * 256 + cl;
#pragma unroll
            for (int ai = 0; ai < 2; ++ai)
#pragma unroll
                for (int m = 0; m < 4; ++m) {
                    const int row = rbase + ai * HALF + m * 16;
                    bf16_t* tb = vT + ((size_t)((row >> 11) * 4 + head) * 512 + e0) * 2048 + (row & 2047);
#pragma unroll
                    for (int bj = 0; bj < 2; ++bj)
#pragma unroll
                        for (int n = 0; n < 2; ++n)
#pragma unroll
                            for (int i = 0; i < 4; ++i) tb[(size_t)(bj * 128 + 4 * n + i) * 2048] = f2bf(acc[ai][bj][m][n][i]);
                }
        } else {
            const int col0 = (pn - 16) * 256 + cl;
#pragma unroll
            for (int ai = 0; ai < 2; ++ai)
#pragma unroll
                for (int m = 0; m < 4; ++m) { bf16_t* rp = g + (size_t)(rbase + ai * HALF + m * 16) * 2048 + col0;
#pragma unroll
                    for (int bj = 0; bj < 2; ++bj) *(u32x4*)(rp + bj * HALF) = pk8(acc[ai][bj][m][0], acc[ai][bj][m][1]); }
        }
    }
};
template <bool KV> struct EpiRope64 {
    static constexpr bool PERM = true, AFTER_DRAIN = false;
    bf16_t* dst; bf16_t* vT; const float *dcos, *dsin; float scale;
    __device__ __forceinline__ void operator()(const f32x4 (&acc)[2][2][4][2], const Unit& u, int wr, int wc, int fr, int fq) const {
        const int pn = u.pn, rbase = u.pm * BM + wr * 64 + fr, cl = wc * 32 + 8 * fq;
        if (!KV || pn < 4) {
            const bool dorope = ((wc & 1) == 0) && (fq < 2);
#pragma unroll
            for (int ai = 0; ai < 2; ++ai)
#pragma unroll
                for (int m = 0; m < 4; ++m) {
                    const int row = rbase + ai * HALF + m * 16;
                    const f32x4 c0 = *(const f32x4*)(dcos + (size_t)row * 8), c1 = *(const f32x4*)(dcos + (size_t)row * 8 + 4);
                    const f32x4 s0 = *(const f32x4*)(dsin + (size_t)row * 8), s1 = *(const f32x4*)(dsin + (size_t)row * 8 + 4);
                    bf16_t* rp = dst + (size_t)row * 1024 + pn * 256 + cl;
#pragma unroll
                    for (int bj = 0; bj < 2; ++bj) {
                        f32x4 v[2];
#pragma unroll
                        for (int n = 0; n < 2; ++n) {
                            const f32x4 x = acc[ai][bj][m][n]; f32x4 oth;
#pragma unroll
                            for (int i = 0; i < 4; ++i) oth[i] = __shfl_xor(x[i], 16);
                            const f32x4 cs = n ? c1 : c0, sn = n ? s1 : s0;
                            const f32x4 rot = (fq == 0) ? (x * cs - oth * sn) : (x * cs + oth * sn);
                            v[n] = (dorope ? rot : x) * scale;
                        }
                        *(u32x4*)(rp + bj * HALF) = pk8(v[0], v[1]);
                    }
                }
        } else {
#pragma unroll
            for (int ai = 0; ai < 2; ++ai)
#pragma unroll
                for (int m = 0; m < 4; ++m) {
                    const int row = rbase + ai * HALF + m * 16;
#pragma unroll
                    for (int bj = 0; bj < 2; ++bj) {
                        const int H = 2 * (pn - 4) + bj;
                        bf16_t* tb = vT + ((size_t)((row >> 11) * 8 + H) * 128 + cl) * 2048 + (row & 2047);
#pragma unroll
                        for (int n = 0; n < 2; ++n)
#pragma unroll
                            for (int i = 0; i < 4; ++i) tb[(size_t)(4 * n + i) * 2048] = f2bf(acc[ai][bj][m][n][i]);
                    }
                }
        }
    }
};

template <class Epi, class Sched, bool ALIGN_EPI = false, bool SP2 = false>
__device__ __forceinline__ void gemm_phase(PG8_LAS unsigned char* lds, const Gemm g, const Sched& S, const Epi& E) {
    int tid_o = threadIdx.x; asm volatile("" : "+v"(tid_o));
    const int tid = tid_o, wid = __builtin_amdgcn_readfirstlane(tid >> 6), lane = tid & 63, wr = wid >> 2, wc = wid & 3, fr = lane & 15, fq = lane >> 4;
    const int K = g.K, nt = K / BK;
    unsigned voffA[2], voffB[2];
#pragma unroll
    for (int i = 0; i < 2; ++i) { int R, C; stage_rc(tid * 16 + i * 8192, R, C); const int Rb = Epi::PERM ? ((R & ~31) + perm32(R & 31)) : R;
        voffA[i] = (unsigned)(R * K + C) * 2u; voffB[i] = (unsigned)(Rb * K + C) * 2u; }
    const size_t kstep = (size_t)(BK * 2);
    const size_t hstep = (size_t)HALF * K * 2;
    const size_t tstep = 2 * hstep;
    const unsigned ldsw = (unsigned)wid * 1024u;
    const int aoff = lds_byte(wr * 64 + fr, fq * 8), boff = lds_byte(wc * 32 + fr, fq * 8);
#define PG8_SA(b, h) (((b) * 2 + (h)) * HTB)
#define PG8_SB(b, h) ((4 + (b) * 2 + (h)) * HTB)
#define PG8_STAGE(bufoff, gbase, voff) do { _Pragma("unroll") for (int _i = 0; _i < 2; ++_i) \
        __builtin_amdgcn_global_load_lds((const unsigned*)((const char*)(gbase) + (voff)[_i]), (PG8_LAS unsigned*)(lds + (bufoff) + ldsw + _i * 8192), 16, 0, 0); } while (0)
#define PG8_LDA(dst, b, h) do { _Pragma("unroll") for (int m = 0; m < 4; ++m) _Pragma("unroll") for (int k = 0; k < 2; ++k) dst[m][k] = *(const PG8_LAS bf16x8*)(lds + PG8_SA(b, h) + aoff + m * 2048 + k * 1024); } while (0)
#define PG8_LDB(dst, b, h) do { _Pragma("unroll") for (int n = 0; n < 2; ++n) _Pragma("unroll") for (int k = 0; k < 2; ++k) dst[n][k] = *(const PG8_LAS bf16x8*)(lds + PG8_SB(b, h) + boff + n * 2048 + k * 1024); } while (0)
#define PG8_MMA(ai, bj, At, Bt) do { __builtin_amdgcn_s_setprio(1); _Pragma("unroll") for (int m = 0; m < 4; ++m) _Pragma("unroll") for (int n = 0; n < 2; ++n) _Pragma("unroll") for (int k = 0; k < 2; ++k) \
        acc[ai][bj][m][n] = __builtin_amdgcn_mfma_f32_16x16x32_bf16(Bt[n][k], At[m][k], acc[ai][bj][m][n], 0, 0, 0); __builtin_amdgcn_s_setprio(0); } while (0)
#define PG8_WAIT_V(n) asm volatile("s_waitcnt vmcnt(" #n ")" ::: "memory")
#define PG8_WAIT_L(n) asm volatile("s_waitcnt lgkmcnt(" #n ")" ::: "memory")
#define PG8_BAR __builtin_amdgcn_s_barrier()
#define PG8_SCHED __builtin_amdgcn_sched_barrier(0)
    Unit cur, nxt; int ui = 0;
    if (!S.next(0, cur)) return;
    f32x4 acc[2][2][4][2];
#pragma unroll
    for (int a = 0; a < 2; ++a)
#pragma unroll
        for (int b = 0; b < 2; ++b)
#pragma unroll
            for (int m = 0; m < 4; ++m)
#pragma unroll
                for (int n = 0; n < 2; ++n) acc[a][b][m][n] = (f32x4){0.f, 0.f, 0.f, 0.f};
    bf16x8 At[4][2], B0[2][2], B1[2][2];
    const char* cA = (const char*)g.A + (size_t)cur.pm * tstep; const char* cB = (const char*)g.Bt + (size_t)cur.pn * tstep;
    S.a_ready(cur);
    if constexpr (SP2) {
        PG8_STAGE(PG8_SB(0, 0), cB, voffB); PG8_STAGE(PG8_SB(0, 1), cB + hstep, voffB); PG8_STAGE(PG8_SA(0, 0), cA, voffA); PG8_STAGE(PG8_SA(0, 1), cA + hstep, voffA);
        if (wr == 1) PG8_BAR;
        PG8_WAIT_V(2); PG8_BAR;
        PG8_STAGE(PG8_SB(1, 0), cB + kstep, voffB); PG8_STAGE(PG8_SA(1, 0), cA + kstep, voffA); PG8_STAGE(PG8_SB(1, 1), cB + hstep + kstep, voffB);
        PG8_WAIT_V(6); PG8_BAR;
    } else {
        PG8_STAGE(PG8_SB(0, 0), cB, voffB); PG8_STAGE(PG8_SA(0, 0), cA, voffA); PG8_STAGE(PG8_SB(0, 1), cB + hstep, voffB); PG8_STAGE(PG8_SA(0, 1), cA + hstep, voffA);
        if (wr == 1) PG8_BAR;
        PG8_WAIT_V(4); PG8_BAR;
        PG8_STAGE(PG8_SB(1, 0), cB + kstep, voffB); PG8_STAGE(PG8_SA(1, 0), cA + kstep, voffA); PG8_STAGE(PG8_SB(1, 1), cB + hstep + kstep, voffB);
        PG8_WAIT_V(6); PG8_BAR;
    }
    for (;;) {
        const bool has_next = S.next(ui + 1, nxt);
        const char* nA = has_next ? (const char*)g.A + (size_t)nxt.pm * tstep : cA; const char* nB = has_next ? (const char*)g.Bt + (size_t)nxt.pn * tstep : cB;
        for (int t = 0; t < nt; t += 2) {
            const bool last = (t == nt - 2);
            const char* a1 = cA + (size_t)(t + 1) * kstep;
            const char* a2 = last ? nA : cA + (size_t)(t + 2) * kstep; const char* b2 = last ? nB : cB + (size_t)(t + 2) * kstep;
            const char* a3 = a2 + kstep; const char* b3 = b2 + kstep;
            if (last && has_next) S.a_ready(nxt);
            if constexpr (SP2) {
            PG8_LDB(B0, 0, 0); PG8_LDB(B1, 0, 1); PG8_SCHED; PG8_LDA(At, 0, 0); PG8_STAGE(PG8_SA(1, 1), a1 + hstep, voffA);
            PG8_WAIT_V(8); PG8_WAIT_L(0); PG8_BAR; PG8_MMA(0, 0, At, B0); PG8_MMA(0, 1, At, B1); PG8_BAR; PG8_SCHED;
            PG8_LDA(At, 0, 1); PG8_STAGE(PG8_SB(0, 0), b2, voffB); PG8_STAGE(PG8_SB(0, 1), b2 + hstep, voffB); PG8_STAGE(PG8_SA(0, 0), a2, voffA);
            PG8_WAIT_V(8); PG8_WAIT_L(0); PG8_BAR; PG8_MMA(1, 0, At, B0); PG8_MMA(1, 1, At, B1); PG8_BAR; PG8_SCHED;
            PG8_LDB(B0, 1, 0); PG8_LDB(B1, 1, 1); PG8_SCHED; PG8_LDA(At, 1, 0); PG8_STAGE(PG8_SA(0, 1), a2 + hstep, voffA);
            PG8_WAIT_V(8); PG8_WAIT_L(0); PG8_BAR; PG8_MMA(0, 0, At, B0); PG8_MMA(0, 1, At, B1); PG8_BAR; PG8_SCHED;
            PG8_LDA(At, 1, 1); PG8_STAGE(PG8_SB(1, 0), b3, voffB); PG8_STAGE(PG8_SB(1, 1), b3 + hstep, voffB); PG8_STAGE(PG8_SA(1, 0), a3, voffA);
            PG8_WAIT_V(8); PG8_WAIT_L(0); PG8_BAR; PG8_MMA(1, 0, At, B0); PG8_MMA(1, 1, At, B1); PG8_BAR; PG8_SCHED;
            } else {
            PG8_LDB(B0, 0, 0); PG8_SCHED; PG8_LDA(At, 0, 0); PG8_STAGE(PG8_SA(1, 1), a1 + hstep, voffA);
            PG8_WAIT_L(8); PG8_BAR; PG8_WAIT_L(0); PG8_MMA(0, 0, At, B0); PG8_BAR; PG8_SCHED;
            PG8_LDB(B1, 0, 1); PG8_STAGE(PG8_SB(0, 0), b2, voffB);
            PG8_BAR; PG8_WAIT_L(0); PG8_MMA(0, 1, At, B1); PG8_BAR;
            PG8_LDA(At, 0, 1); PG8_STAGE(PG8_SA(0, 0), a2, voffA);
            PG8_BAR; PG8_WAIT_L(0); PG8_MMA(1, 0, At, B0); PG8_BAR; PG8_SCHED;
            PG8_STAGE(PG8_SB(0, 1), b2 + hstep, voffB);
            PG8_WAIT_V(6); PG8_BAR; PG8_MMA(1, 1, At, B1); PG8_BAR;
            PG8_LDB(B0, 1, 0); PG8_SCHED; PG8_LDA(At, 1, 0); PG8_STAGE(PG8_SA(0, 1), a2 + hstep, voffA);
            PG8_WAIT_L(8); PG8_BAR; PG8_WAIT_L(0); PG8_MMA(0, 0, At, B0); PG8_BAR; PG8_SCHED;
            PG8_LDB(B1, 1, 1); PG8_STAGE(PG8_SB(1, 0), b3, voffB);
            PG8_BAR; PG8_WAIT_L(0); PG8_MMA(0, 1, At, B1); PG8_BAR;
            PG8_LDA(At, 1, 1); PG8_STAGE(PG8_SA(1, 0), a3, voffA);
            PG8_BAR; PG8_WAIT_L(0); PG8_MMA(1, 0, At, B0); PG8_BAR; PG8_SCHED;
            PG8_STAGE(PG8_SB(1, 1), b3 + hstep, voffB);
            PG8_WAIT_V(6); PG8_BAR; PG8_MMA(1, 1, At, B1); PG8_BAR;
            }
        }
        if constexpr (ALIGN_EPI) { if (wr == 0) PG8_BAR; }
        if constexpr (!Epi::AFTER_DRAIN) { E(acc, cur, wr, wc, fr, fq); S.done(cur); }
        if (!has_next) break;
#pragma unroll
        for (int a = 0; a < 2; ++a)
#pragma unroll
            for (int b = 0; b < 2; ++b)
#pragma unroll
                for (int m = 0; m < 4; ++m)
#pragma unroll
                    for (int n = 0; n < 2; ++n) acc[a][b][m][n] = (f32x4){0.f, 0.f, 0.f, 0.f};
        cur = nxt; cA = nA; cB = nB; ++ui;
        if constexpr (ALIGN_EPI) { if (wr == 1) PG8_BAR; }
    }
    PG8_WAIT_V(0);
    if constexpr (!ALIGN_EPI) { if (wr == 0) PG8_BAR; }
    PG8_BAR;
    if constexpr (Epi::AFTER_DRAIN) { E.fused(acc, cur, wr, wc, fr, fq, lds, wid, lane); S.done(cur); }
#undef PG8_SA
#undef PG8_SB
#undef PG8_STAGE
#undef PG8_LDA
#undef PG8_LDB
#undef PG8_MMA
#undef PG8_WAIT_V
#undef PG8_WAIT_L
#undef PG8_BAR
#undef PG8_SCHED
}
}

__device__ __forceinline__ int opq_tid() { int t = threadIdx.x; asm volatile("" : "+v"(t)); return t; }
#define MFMA32(a, b, c) __builtin_amdgcn_mfma_f32_32x32x16_bf16((a), (b), (c), 0, 0, 0)
__device__ __forceinline__ int crow(int r, int hi) { return (r & 3) + 8 * (r >> 2) + 4 * hi; }
__device__ __forceinline__ float wave_sum(float v) {
#pragma unroll
    for (int o = 1; o < 64; o <<= 1) v += __shfl_xor(v, o);
    return v;
}
__device__ __forceinline__ f32x16 zero16() { f32x16 z;
#pragma unroll
    for (int i = 0; i < 16; ++i) z[i] = 0.f;
    return z; }

__device__ __forceinline__ void p0_mod_gemv(LAS unsigned char* lds, const float* c, const float* ada_w, const float* ada_b, const float* kv_ada_w, const float* kv_ada_b, float* mod, float* kvmod) {
    LAS float* cact = (LAS float*)lds;
    LAS float* red = (LAS float*)(lds + 32768);
    const int tid = opq_tid();
    for (int i = tid; i < 8192; i += 512) { const float v = c[i]; cact[i] = v / (1.0f + expf(-v)); }
    __syncthreads();
    const int cg4 = tid & 15, kg = tid >> 4;
    for (int u = blockIdx.x; u < 416; u += gridDim.x) {
        const float* W; const float* bias; float* out; int N, cb;
        if (u < 384) { const int l = u / 96; cb = (u % 96) * 64; W = ada_w + (size_t)l * 1024 * 6144; N = 6144; bias = ada_b + l * 6144; out = mod + (size_t)l * 8 * 6144; }
        else { cb = (u - 384) * 64; W = kv_ada_w; N = 2048; bias = kv_ada_b; out = kvmod; }
        f32x4 acc[8];
#pragma unroll
        for (int b = 0; b < 8; ++b) acc[b] = (f32x4){0.f, 0.f, 0.f, 0.f};
        const float* wp = W + (size_t)(kg * 32) * N + cb + 4 * cg4;
#pragma unroll 4
        for (int kk = 0; kk < 32; ++kk) {
            const f32x4 w = *(const f32x4*)(wp + (size_t)kk * N);
#pragma unroll
            for (int b = 0; b < 8; ++b) acc[b] += w * cact[b * 1024 + kg * 32 + kk];
        }
#pragma unroll
        for (int b = 0; b < 8; ++b) *(LAS f32x4*)(red + (kg * 8 + b) * 64 + 4 * cg4) = acc[b];
        __syncthreads();
        { const int b = tid >> 6, col = tid & 63; float s = bias[cb + col];
#pragma unroll 8
          for (int g = 0; g < 32; ++g) s += red[(g * 8 + b) * 64 + col];
          out[(size_t)b * N + cb + col] = s; }
        __syncthreads();
    }
}


__device__ __forceinline__ void gemv8(LAS unsigned char* lds, const float* in, int K, const float* W, int N, float* out, int act) {
    LAS float* cact = (LAS float*)lds;
    LAS float* red = (LAS float*)(lds + 32768);
    const int tid = opq_tid();
    const int cg4 = tid & 15, kg = tid >> 4;
    for (int u = blockIdx.x; u < N / 64; u += gridDim.x) {
        f32x4 acc[8];
#pragma unroll
        for (int b = 0; b < 8; ++b) acc[b] = (f32x4){0.f, 0.f, 0.f, 0.f};
        for (int kc = 0; kc < K; kc += 1024) {
            __syncthreads();
            for (int i = tid; i < 8192; i += 512) cact[i] = in[(size_t)(i >> 10) * K + kc + (i & 1023)];
            __syncthreads();
            const float* wp = W + (size_t)(kc + kg * 32) * N + u * 64 + 4 * cg4;
#pragma unroll 4
            for (int kk = 0; kk < 32; ++kk) {
                const f32x4 w = *(const f32x4*)(wp + (size_t)kk * N);
#pragma unroll
                for (int b = 0; b < 8; ++b) acc[b] += w * cact[b * 1024 + kg * 32 + kk];
            }
        }
#pragma unroll
        for (int b = 0; b < 8; ++b) *(LAS f32x4*)(red + (kg * 8 + b) * 64 + 4 * cg4) = acc[b];
        __syncthreads();
        { const int b = tid >> 6, col = tid & 63; float s = 0.f;
#pragma unroll 8
          for (int g = 0; g < 32; ++g) s += red[(g * 8 + b) * 64 + col];
          if (act == 1) { s = fmaxf(s, 0.f); s = s * s; }
          out[(size_t)b * N + u * 64 + col] = s; }
        __syncthreads();
    }
}

__device__ __forceinline__ void transpose_item(const float* W, int K, int N, bf16_t* WT, LAS float* scr, int item, int lane) {
    const int nblk = N / 32, kb = item / nblk, nb = item % nblk, k0 = 64 * kb, n0 = 32 * nb;
#pragma unroll 8
    for (int i = 0; i < 32; ++i) { const int kk = 2 * i + (lane >> 5); scr[kk * 33 + (lane & 31)] = W[(size_t)(k0 + kk) * N + n0 + (lane & 31)]; }
    asm volatile("s_waitcnt lgkmcnt(0)" ::: "memory");
    const int c = lane & 7;
#pragma unroll
    for (int j = 0; j < 4; ++j) { const int n = (lane >> 3) + 8 * j; const LAS float* s = scr + (8 * c) * 33 + n;
        u32x4 o; o.x = pk2(s[0 * 33], s[1 * 33]); o.y = pk2(s[2 * 33], s[3 * 33]); o.z = pk2(s[4 * 33], s[5 * 33]); o.w = pk2(s[6 * 33], s[7 * 33]);
        *(u32x4*)(WT + (size_t)(n0 + n) * K + k0 + 8 * c) = o; }
    asm volatile("s_waitcnt lgkmcnt(0)" ::: "memory");
}
struct WSpec { const float* W; int K, N; size_t off; };
__device__ __forceinline__ void convert_weights(LAS unsigned char* lds, bf16_t* wbuf, const WSpec& a, const WSpec& b, const WSpec& c, const WSpec& d, const WSpec& e, int nmat) {
    const int tid = opq_tid(); const int lane = tid & 63, wave = tid >> 6;
    LAS float* scr = (LAS float*)(lds + wave * 16384);
    const int gw = blockIdx.x * 8 + wave, NGW = gridDim.x * 8;
    const int ia = (a.K / 64) * (a.N / 32), ib = (b.K / 64) * (b.N / 32), ic = (c.K / 64) * (c.N / 32), id = (d.K / 64) * (d.N / 32), ie = nmat > 4 ? (e.K / 64) * (e.N / 32) : 0;
    const int total = ia + ib + ic + id + ie;
    for (int it = gw; it < total; it += NGW) {
        int r = it;
        if (r < ia) { transpose_item(a.W, a.K, a.N, wbuf + a.off, scr, r, lane); continue; } r -= ia;
        if (r < ib) { transpose_item(b.W, b.K, b.N, wbuf + b.off, scr, r, lane); continue; } r -= ib;
        if (r < ic) { transpose_item(c.W, c.K, c.N, wbuf + c.off, scr, r, lane); continue; } r -= ic;
        if (r < id) { transpose_item(d.W, d.K, d.N, wbuf + d.off, scr, r, lane); continue; } r -= id;
        transpose_item(e.W, e.K, e.N, wbuf + e.off, scr, r, lane);
    }
}

__device__ __forceinline__ void rope_tables(const int* pos, float* rcos, float* rsin, float* dcos, float* dsin) {
    const int gt = blockIdx.x * 512 + opq_tid(), NT = gridDim.x * 512;
    for (int idx = gt; idx < MTOK * 128; idx += NT) {
        const int tok = idx >> 7, j = idx & 127;
        const float inv = (float)exp2(-(double)(2 * j) * (13.287712379549449 / 256.0));
        const float ang = (float)pos[tok] * inv;
        double rv = (double)ang * 0.15915494309189535; rv -= rint(rv);
        const float fr = (float)rv;
        rcos[idx] = __builtin_amdgcn_cosf(fr); rsin[idx] = __builtin_amdgcn_sinf(fr);
    }
    for (int idx = gt; idx < MTOK * 8; idx += NT) {
        const int tok = idx >> 3, j = idx & 7;
        const float inv = (float)exp2(-(double)(2 * j) * (18.931568569324174 / 16.0));
        const float ang = (float)pos[tok] * inv;
        double rv = (double)ang * 0.15915494309189535; rv -= rint(rv);
        const float fr = (float)rv;
        dcos[idx] = __builtin_amdgcn_cosf(fr); dsin[idx] = __builtin_amdgcn_sinf(fr);
    }
}

__device__ __forceinline__ void row_phase(const float* xin, float* xout, const float* y, const float* gy, const float* gate, int gate_bs,
                                          int nout, const float* g0, const float* sc0, const float* sh0, int bs0, bf16_t* d0,
                                          const float* g1, const float* sc1, const float* sh1, int bs1, bf16_t* d1, const float* ysh, float* h0s) {
    const int tid = opq_tid(); const int lane = tid & 63, gw = blockIdx.x * 8 + (tid >> 6), NGW = gridDim.x * 8;
    for (int row = gw; row < MTOK; row += NGW) {
        const int b = row >> 11;
        f32x4 xv[4];
#pragma unroll
        for (int j = 0; j < 4; ++j) xv[j] = *(const f32x4*)(xin + (size_t)row * 1024 + 4 * lane + 256 * j);
        if (y) {
            f32x4 yv[4]; float s = 0.f;
            const float* yrow = (ysh && (row & 2047) == 0) ? (ysh + (size_t)b * 1024) : (y + (size_t)row * 1024);
#pragma unroll
            for (int j = 0; j < 4; ++j) { yv[j] = *(const f32x4*)(yrow + 4 * lane + 256 * j); s += (yv[j][0] * yv[j][0] + yv[j][1] * yv[j][1]) + (yv[j][2] * yv[j][2] + yv[j][3] * yv[j][3]); }
            const float rstd = rsqrtf(wave_sum(s) * (1.0f / 1024.0f) + EPS);
#pragma unroll
            for (int j = 0; j < 4; ++j) { const int col = 4 * lane + 256 * j;
                const f32x4 gg = *(const f32x4*)(gy + col), ga = *(const f32x4*)(gate + (size_t)b * gate_bs + col);
                xv[j] += (ga + 1.0f) * (yv[j] * rstd * gg);
                *(f32x4*)(xout + (size_t)row * 1024 + col) = xv[j]; }
        }
        if (nout > 0) {
            float s = 0.f;
#pragma unroll
            for (int j = 0; j < 4; ++j) s += (xv[j][0] * xv[j][0] + xv[j][1] * xv[j][1]) + (xv[j][2] * xv[j][2] + xv[j][3] * xv[j][3]);
            const float rstd = rsqrtf(wave_sum(s) * (1.0f / 1024.0f) + EPS);
#pragma unroll
            for (int j = 0; j < 4; ++j) { const int col = 4 * lane + 256 * j;
                const f32x4 gg = *(const f32x4*)(g0 + col), sc = *(const f32x4*)(sc0 + (size_t)b * bs0 + col), sh = *(const f32x4*)(sh0 + (size_t)b * bs0 + col);
                const f32x4 h = (xv[j] * rstd * gg) * (sc + 1.0f) + sh;
                u32x2 w; w.x = pk2(h[0], h[1]); w.y = pk2(h[2], h[3]);
                *(u32x2*)(d0 + (size_t)row * 1024 + col) = w;
                if (h0s && (row & 2047) == 0) *(f32x4*)(h0s + (size_t)b * 1024 + col) = h; }
            if (nout > 1) {
#pragma unroll
                for (int j = 0; j < 4; ++j) { const int col = 4 * lane + 256 * j;
                    const f32x4 gg = *(const f32x4*)(g1 + col), sc = *(const f32x4*)(sc1 + (size_t)b * bs1 + col), sh = *(const f32x4*)(sh1 + (size_t)b * bs1 + col);
                    const f32x4 h = (xv[j] * rstd * gg) * (sc + 1.0f) + sh;
                    u32x2 w; w.x = pk2(h[0], h[1]); w.y = pk2(h[2], h[3]);
                    *(u32x2*)(d1 + (size_t)row * 1024 + col) = w; }
            }
        }
    }
}

__device__ __forceinline__ void gate_phase(bf16_t* o, const bf16_t* g, const float* proj0, float* gated0) {
    const int tid = opq_tid(); const int lane = tid & 63, gw = blockIdx.x * 8 + (tid >> 6), NGW = gridDim.x * 8;
    if (gw < 32) {
        const int b = gw >> 2, h = gw & 3; const float* pr = proj0 + (size_t)b * 6144;
        const f32x4 qv = *(const f32x4*)(pr + h * 256 + 4 * lane), kv = *(const f32x4*)(pr + 1024 + h * 256 + 4 * lane);
        const float s00 = wave_sum((qv[0] * kv[0] + qv[1] * kv[1]) + (qv[2] * kv[2] + qv[3] * kv[3])) * 0.0625f;
        const f32x4 v0 = *(const f32x4*)(pr + 2048 + h * 512 + 8 * lane), v1 = *(const f32x4*)(pr + 2048 + h * 512 + 8 * lane + 4);
        const f32x4 g0 = *(const f32x4*)(pr + 4096 + h * 512 + 8 * lane), g1 = *(const f32x4*)(pr + 4096 + h * 512 + 8 * lane + 4);
        const f32x4 o0 = v0 * s00, o1 = v1 * s00;
        const float ss = wave_sum((o0[0] * o0[0] + o0[1] * o0[1]) + (o0[2] * o0[2] + o0[3] * o0[3]) + (o1[0] * o1[0] + o1[1] * o1[1]) + (o1[2] * o1[2] + o1[3] * o1[3]));
        const float rstd = rsqrtf(ss * (1.0f / 512.0f) + EPS);
        f32x4 r0, r1;
#pragma unroll
        for (int i = 0; i < 4; ++i) { r0[i] = (g0[i] / (1.0f + expf(-g0[i]))) * (o0[i] * rstd); r1[i] = (g1[i] / (1.0f + expf(-g1[i]))) * (o1[i] * rstd); }
        *(f32x4*)(gated0 + (size_t)b * 2048 + h * 512 + 8 * lane) = r0; *(f32x4*)(gated0 + (size_t)b * 2048 + h * 512 + 8 * lane + 4) = r1;
    }
    for (int it = gw; it < MTOK * 4; it += NGW) {
        const size_t off = (size_t)it * 512 + 8 * lane;
        const u32x4 ov = *(const u32x4*)(o + off), gv = *(const u32x4*)(g + off);
        float of[8], gf[8];
#pragma unroll
        for (int i = 0; i < 4; ++i) { of[2 * i] = __uint_as_float(ov[i] << 16); of[2 * i + 1] = __uint_as_float(ov[i] & 0xffff0000u);
                                      gf[2 * i] = __uint_as_float(gv[i] << 16); gf[2 * i + 1] = __uint_as_float(gv[i] & 0xffff0000u); }
        float s = 0.f;
#pragma unroll
        for (int i = 0; i < 8; ++i) s += of[i] * of[i];
        const float rstd = rsqrtf(wave_sum(s) * (1.0f / 512.0f) + EPS);
        float r[8];
#pragma unroll
        for (int i = 0; i < 8; ++i) r[i] = (gf[i] / (1.0f + __expf(-gf[i]))) * (of[i] * rstd);
        u32x4 w; w.x = pk2(r[0], r[1]); w.y = pk2(r[2], r[3]); w.z = pk2(r[4], r[5]); w.w = pk2(r[6], r[7]);
        *(u32x4*)(o + off) = w;
    }
}

constexpr int P_LD = 136, R_LD = 264;
__device__ __forceinline__ void ret_scan(LAS unsigned char* lds, const bf16_t* q, const bf16_t* k, const bf16_t* kzT, const bf16_t* vT, bf16_t* o) {
    LAS bf16_t* Pl = (LAS bf16_t*)lds;
    LAS bf16_t* Rl = (LAS bf16_t*)(lds + 128 * P_LD * 2);
    const int tid = opq_tid(); const int lane = tid & 63, wid = __builtin_amdgcn_readfirstlane(tid >> 6), l31 = lane & 31, hi = lane >> 5;
    for (int unit = blockIdx.x; unit < 256; unit += gridDim.x) {
        const int b = unit >> 5, h = (unit >> 3) & 3, es = unit & 7;
        const float lg = __log2f(1.0f - exp2f(-5.0f - (float)h));
        const float decay = exp2f(128.0f * lg);
        f32x16 Rt[2]; Rt[0] = zero16(); Rt[1] = zero16();
        const bf16_t* vTb = vT + ((size_t)(b * 4 + h) * 512 + es * 64) * 2048;
        const bf16_t* kzb = kzT + ((size_t)(b * 4 + h) * 256 + 32 * wid + l31) * 2048;
        for (int n = 0; n < 16; ++n) {
            const int t0 = b * 2048 + n * 128;
#pragma unroll
            for (int eb = 0; eb < 2; ++eb)
#pragma unroll
                for (int r = 0; r < 16; ++r) Rl[(32 * eb + crow(r, hi)) * R_LD + 32 * wid + l31] = f2bf(Rt[eb][r]);
            {
                const int cb = wid >> 1;
                const bf16_t* qa = q + (size_t)(t0 + 32 * cb + l31) * 1024 + h * 256 + 8 * hi;
#pragma unroll
                for (int mt = 0; mt < 2; ++mt) {
                    const int mb = 2 * (wid & 1) + mt;
                    f32x16 acc = zero16();
                    if (mb <= cb) {
                        const bf16_t* kb = k + (size_t)(t0 + 32 * mb + l31) * 1024 + h * 256 + 8 * hi;
#pragma unroll
                        for (int ks = 0; ks < 16; ++ks) acc = MFMA32(*(const bf16x8*)(qa + 16 * ks), *(const bf16x8*)(kb + 16 * ks), acc);
                    }
#pragma unroll
                    for (int r = 0; r < 16; ++r) {
                        const int c = 32 * cb + crow(r, hi), m = 32 * mb + l31, df = c - m;
                        const float v = (df >= 0) ? acc[r] * exp2f((float)df * lg) : 0.f;
                        Pl[c * P_LD + m] = f2bf(v);
                    }
                }
            }
            __syncthreads();
            {
                const int cb = wid >> 1, eb = wid & 1;
                const bf16_t* qa = q + (size_t)(t0 + 32 * cb + l31) * 1024 + h * 256 + 8 * hi;
                f32x16 acc = zero16();
#pragma unroll
                for (int ks = 0; ks < 16; ++ks) acc = MFMA32(*(const bf16x8*)(qa + 16 * ks), *(const LAS bf16x8*)(Rl + (32 * eb + l31) * R_LD + 16 * ks + 8 * hi), acc);
#pragma unroll
                for (int r = 0; r < 16; ++r) acc[r] *= exp2f((float)(32 * cb + crow(r, hi) + 1) * lg);
                const bf16_t* vb = vTb + (size_t)(32 * eb + l31) * 2048 + n * 128 + 8 * hi;
                for (int ks = 0; ks < 2 * (cb + 1); ++ks) acc = MFMA32(*(const LAS bf16x8*)(Pl + (32 * cb + l31) * P_LD + 16 * ks + 8 * hi), *(const bf16x8*)(vb + 16 * ks), acc);
                bf16_t* op = o + (size_t)(t0 + 32 * cb) * 2048 + h * 512 + es * 64 + 32 * eb + l31;
#pragma unroll
                for (int r = 0; r < 16; ++r) op[(size_t)crow(r, hi) * 2048] = f2bf(acc[r]);
            }
#pragma unroll
            for (int eb = 0; eb < 2; ++eb) {
                const bf16_t* va = vTb + (size_t)(32 * eb + l31) * 2048 + n * 128 + 8 * hi;
                f32x16 acc = Rt[eb] * decay;
#pragma unroll
                for (int ks = 0; ks < 8; ++ks) acc = MFMA32(*(const bf16x8*)(va + 16 * ks), *(const bf16x8*)(kzb + n * 128 + 16 * ks + 8 * hi), acc);
                Rt[eb] = acc;
            }
            __syncthreads();
        }
    }
}

__device__ __forceinline__ void diff_attn(LAS unsigned char* lds, const bf16_t* qb_, const bf16_t* ksh, const bf16_t* vTsh, bf16_t* aout,
                                          const float* lam, const float* subg, float linit) {
    LAS float* xch = (LAS float*)lds;
    const int tid = opq_tid(); const int lane = tid & 63, wid = __builtin_amdgcn_readfirstlane(tid >> 6), l31 = lane & 31, hi = lane >> 5, grp = wid >> 2, wq = wid & 3;
    float lam_full;
    { const float p1 = lam[lane] * lam[64 + lane], p2 = lam[128 + lane] * lam[192 + lane];
      lam_full = expf(wave_sum(p1)) - expf(wave_sum(p2)) + linit; }
    const int pi_l = 16 * (((l31 & 3) + 4 * (l31 >> 3)) >> 3) + 8 * ((l31 >> 2) & 1) + (((l31 & 3) + 4 * (l31 >> 3)) & 7);
    for (int u = blockIdx.x; u < 1024; u += gridDim.x) {
        const int vv = u & 255, ii = u >> 8, bh = vv >> 2, s4 = vv & 3;
        const int qblk = (ii == 0) ? s4 : (ii == 1) ? 7 - s4 : (ii == 2) ? 8 + s4 : 15 - s4;
        const int b = bh >> 3, H = bh & 7, head = 2 * H + grp;
        const int qs0 = qblk * 128 + 32 * wq, myq = qs0 + l31;
        bf16x8 qf[4];
        { const bf16_t* qp = qb_ + (size_t)(b * 2048 + myq) * 1024 + head * 64 + 8 * hi;
#pragma unroll
          for (int ks = 0; ks < 4; ++ks) qf[ks] = *(const bf16x8*)(qp + 16 * ks); }
        f32x16 OT[4];
#pragma unroll
        for (int e = 0; e < 4; ++e) OT[e] = zero16();
        float m_run = -1e30f, l_run = 0.f;
        const int ntiles = qblk * 4 + wq + 1;
        const bf16_t* kbase = ksh + (size_t)(b * 2048 + pi_l) * 1024 + head * 64 + 8 * hi;
        const bf16_t* vbase = vTsh + ((size_t)(b * 8 + H) * 128 + l31) * 2048 + 8 * hi;
        for (int t = 0; t < ntiles; ++t) {
            const int kv0 = 32 * t;
            f32x16 acc = zero16();
            { const bf16_t* kp = kbase + (size_t)kv0 * 1024;
#pragma unroll
              for (int ks = 0; ks < 4; ++ks) acc = MFMA32(*(const bf16x8*)(kp + 16 * ks), qf[ks], acc); }
            if (t == ntiles - 1) {
#pragma unroll
                for (int r = 0; r < 16; ++r) { const int kv = kv0 + 16 * (r >> 3) + 8 * hi + (r & 7); if (kv > myq) acc[r] = -INFINITY; }
            }
            float rm = acc[0];
#pragma unroll
            for (int r = 1; r < 16; ++r) rm = fmaxf(rm, acc[r]);
            rm = fmaxf(rm, __shfl_xor(rm, 32));
            const float m_new = fmaxf(m_run, rm);
            const float alpha = __builtin_amdgcn_exp2f(m_run - m_new);
            float rs = 0.f;
#pragma unroll
            for (int r = 0; r < 16; ++r) { acc[r] = __builtin_amdgcn_exp2f(acc[r] - m_new); rs += acc[r]; }
            rs += __shfl_xor(rs, 32);
            l_run = l_run * alpha + rs; m_run = m_new;
#pragma unroll
            for (int e = 0; e < 4; ++e) OT[e] *= alpha;
            bf16x8 pf[2];
#pragma unroll
            for (int kk = 0; kk < 2; ++kk) { u32x4 w; w.x = pk2(acc[8 * kk], acc[8 * kk + 1]); w.y = pk2(acc[8 * kk + 2], acc[8 * kk + 3]); w.z = pk2(acc[8 * kk + 4], acc[8 * kk + 5]); w.w = pk2(acc[8 * kk + 6], acc[8 * kk + 7]);
                                             pf[kk] = __builtin_bit_cast(bf16x8, w); }
            const bf16_t* vp = vbase + kv0;
#pragma unroll
            for (int e = 0; e < 4; ++e)
#pragma unroll
                for (int kk = 0; kk < 2; ++kk) OT[e] = MFMA32(*(const bf16x8*)(vp + (size_t)(32 * e) * 2048 + 16 * kk), pf[kk], OT[e]);
        }
        const float inv = 1.0f / l_run;
        if (grp == 1) {
            const float f = inv * lam_full;
#pragma unroll
            for (int e = 0; e < 4; ++e)
#pragma unroll
                for (int r = 0; r < 16; ++r) xch[(wq * 64 + e * 16 + r) * 64 + lane] = OT[e][r] * f;
        }
        __syncthreads();
        if (grp == 0) {
            float ss = 0.f;
#pragma unroll
            for (int e = 0; e < 4; ++e)
#pragma unroll
                for (int r = 0; r < 16; ++r) { const float v = OT[e][r] * inv - xch[(wq * 64 + e * 16 + r) * 64 + lane]; OT[e][r] = v; ss += v * v; }
            ss += __shfl_xor(ss, 32);
            const float rstd = rsqrtf(ss * (1.0f / 128.0f) + EPS) * (1.0f - linit);
            bf16_t* op = aout + (size_t)(b * 2048 + myq) * 1024 + H * 128;
#pragma unroll
            for (int e = 0; e < 4; ++e)
#pragma unroll
                for (int a = 0; a < 4; ++a) {
                    const int e0 = 32 * e + 8 * a + 4 * hi;
                    const f32x4 gg = *(const f32x4*)(subg + e0);
                    u32x2 w; w.x = pk2(OT[e][4 * a] * rstd * gg[0], OT[e][4 * a + 1] * rstd * gg[1]); w.y = pk2(OT[e][4 * a + 2] * rstd * gg[2], OT[e][4 * a + 3] * rstd * gg[3]);
                    *(u32x2*)(op + e0) = w;
                }
        }
        __syncthreads();
    }
}

#define XB_TMO      128
#define XB_XCNT(j)  (256  + 64 * (j))
#define XB_XSUB(j)  (1280 + 64 * (j))
#define XB_XGEN(j)  (2304 + 64 * (j))
#define XB_TOP      3328
#define XB_TOPGEN   3392
#define XCD_BAR_WORDS 3456
#define XB_SPIN_CAP (1u << 18)

__device__ __forceinline__ unsigned xb_ld(unsigned* p)              { return __hip_atomic_load(p, __ATOMIC_RELAXED, __HIP_MEMORY_SCOPE_AGENT); }
__device__ __forceinline__ unsigned xb_add(unsigned* p, unsigned v) { return __hip_atomic_fetch_add(p, v, __ATOMIC_RELAXED, __HIP_MEMORY_SCOPE_AGENT); }
__device__ __forceinline__ unsigned xb_xcc_id() { return (unsigned)__builtin_amdgcn_s_getreg((3 << 11) | 20) & 0xFu; }
#define XB_SPIN(cond, bar) do { unsigned _sp = 0; while (cond) { __builtin_amdgcn_s_sleep(1); \
    if ((++_sp & 255u) == 0u) { if (xb_ld(&(bar)[XB_TMO])) break; if (_sp > XB_SPIN_CAP) { atomicAdd(&(bar)[XB_TMO], 1u); break; } } } } while (0)

struct XcdBarrier {
    unsigned* bar; unsigned x;
    volatile LAS unsigned* st;
};

__device__ __forceinline__ XcdBarrier xcd_barrier_post(unsigned* bar, volatile LAS unsigned* st) {
    XcdBarrier b; b.bar = bar; b.x = xb_xcc_id(); b.st = st;
    if (threadIdx.x == 0) (void)xb_add(&bar[XB_XCNT(b.x)], 1u);
    return b;
}
__device__ __forceinline__ void xcd_barrier_complete(unsigned* bar, unsigned x, unsigned& nloc, unsigned& nx) {
    const unsigned G = gridDim.x * gridDim.y * gridDim.z;
    unsigned sum, cnt, mine, sp = 0u;
    for (;;) {
        sum = 0u; cnt = 0u; mine = 0u;
#pragma unroll
        for (unsigned j = 0; j < 16; ++j) { const unsigned c = xb_ld(&bar[XB_XCNT(j)]); sum += c; cnt += (c > 0u) ? 1u : 0u; mine = (j == x) ? c : mine; }
        if (sum == G) break;
        __builtin_amdgcn_s_sleep(1);
        if ((++sp & 255u) == 0u) { if (xb_ld(&bar[XB_TMO])) break; if (sp > XB_SPIN_CAP) { atomicAdd(&bar[XB_TMO], 1u); break; } }
    }
    nloc = mine > 0u ? mine : 1u; nx = cnt > 0u ? cnt : 1u;
}

__device__ __forceinline__ void xcd_barrier(const XcdBarrier& b) {
    asm volatile("s_waitcnt vmcnt(0)" ::: "memory");
    __syncthreads();
    if (threadIdx.x == 0) {
        unsigned* bar = b.bar;
        __builtin_amdgcn_s_waitcnt(0);
        unsigned nloc = b.st[0], nx = b.st[1];
        if (nloc == 0u) { xcd_barrier_complete(bar, b.x, nloc, nx); b.st[0] = nloc; b.st[1] = nx; }
        const unsigned old = xb_add(&bar[XB_XSUB(b.x)], 1u);
        const unsigned gen = old / nloc;
        if (old + 1u == (gen + 1u) * nloc) {
            __builtin_amdgcn_fence(__ATOMIC_RELEASE, "agent");
            asm volatile("s_waitcnt vmcnt(0)" ::: "memory");
            const unsigned og = xb_add(&bar[XB_TOP], 1u);
            const unsigned tg = og / nx;
            if (og + 1u == (tg + 1u) * nx) xb_add(&bar[XB_TOPGEN], 1u);
            else XB_SPIN(xb_ld(&bar[XB_TOPGEN]) == tg, bar);
            __builtin_amdgcn_fence(__ATOMIC_ACQUIRE, "agent");
            xb_add(&bar[XB_XGEN(b.x)], 1u);
            asm volatile("s_waitcnt vmcnt(0)" ::: "memory");
        } else {
            XB_SPIN(xb_ld(&bar[XB_XGEN(b.x)]) == gen, bar);
            __builtin_amdgcn_fence(__ATOMIC_ACQUIRE, "agent");
            asm volatile("s_waitcnt vmcnt(0)" ::: "memory");
        }
    }
    __syncthreads();
}

struct Params {
    const float *x, *c; const int* pos;
    const float *norm_g, *ada_w, *ada_b, *ret_w_in, *ret_w_out, *kv_norm_g, *kv_ada_w, *kv_ada_b, *kv_w, *diff_w_q, *diff_w_o, *diff_lam, *diff_subln_g, *mlp_w1, *mlp_w2;
    float* out; unsigned char* ws; float linit2, linit3, pad0, pad1;
};
constexpr int LDS_BYTES = 147456;
#ifndef REP_ATT
#define REP_ATT 1
#endif
#ifndef REP_RET
#define REP_RET 1
#endif
#ifndef REP_GEMM
#define REP_GEMM 1
#endif
#ifndef REP_ROW0
#define REP_ROW0 1
#endif

__device__ __forceinline__ void convert_layer(LAS unsigned char* lds, const Params& p, int l) {
    bf16_t* wbuf = (bf16_t*)(p.ws + WS_W);
    if (l < 2) {
        WSpec a{p.ret_w_in + (size_t)l * 1024 * 6144, 1024, 6144, WO_RET_IN}, b{p.ret_w_out + (size_t)l * 2048 * 1024, 2048, 1024, WO_RET_OUT},
              c{p.mlp_w1 + (size_t)l * 1024 * 4096, 1024, 4096, WO_RET_W1}, d{p.mlp_w2 + (size_t)l * 4096 * 1024, 4096, 1024, WO_RET_W2};
        convert_weights(lds, wbuf, a, b, c, d, d, 4);
    } else {
        const int j = l - 2;
        WSpec a{p.diff_w_q + (size_t)j * 1024 * 1024, 1024, 1024, WO_DF_Q}, b{p.diff_w_o + (size_t)j * 1024 * 1024, 1024, 1024, WO_DF_O},
              c{p.mlp_w1 + (size_t)l * 1024 * 4096, 1024, 4096, WO_DF_W1}, d{p.mlp_w2 + (size_t)l * 4096 * 1024, 4096, 1024, WO_DF_W2},
              e{p.kv_w, 1024, 2048, WO_DF_KV};
        convert_weights(lds, wbuf, a, b, c, d, e, l == 2 ? 5 : 4);
    }
}

__global__ void __launch_bounds__(512, 2) yoco_fwd(Params p) {
    extern __shared__ __attribute__((aligned(16))) unsigned char lds_raw[];
    LAS unsigned char* lds = (LAS unsigned char*)lds_raw;
    cg::grid_group grid = cg::this_grid();
    unsigned char* ws = p.ws;
    float* mod = (float*)(ws + WS_MOD); float* kvmod = (float*)(ws + WS_KVMOD);
    float* rcos = (float*)(ws + WS_RCOS); float* rsin = (float*)(ws + WS_RSIN); float* dcos = (float*)(ws + WS_DCOS); float* dsin = (float*)(ws + WS_DSIN);
    bf16_t* wbuf = (bf16_t*)(ws + WS_W); bf16_t* hbuf = (bf16_t*)(ws + WS_H);
    bf16_t* bufA = (bf16_t*)(ws + WS_A); bf16_t* bufB = (bf16_t*)(ws + WS_B);
    bf16_t* ubuf = (bf16_t*)(ws + WS_R);
    bf16_t* gbuf = (bf16_t*)(ws + WS_R); bf16_t* obuf = (bf16_t*)(ws + WS_R + 64 * MiB);
    bf16_t* qbuf = (bf16_t*)(ws + WS_R); bf16_t* aout = (bf16_t*)(ws + WS_R + 32 * MiB); bf16_t* hkv = (bf16_t*)(ws + WS_R + 64 * MiB);
    bf16_t* kzT = (bf16_t*)(ws + WS_KZT); bf16_t* vT = (bf16_t*)(ws + WS_VT);
    float* ybuf = (float*)(ws + WS_Y);
    float* h0s = (float*)(ws + WS_KVMOD + 131072); float* proj0 = (float*)(ws + WS_KVMOD + 196608); float* gated0 = (float*)(ws + WS_KVMOD + 393216);
    float* y0s = (float*)(ws + WS_KVMOD + 458752); float* u0s = (float*)(ws + WS_KVMOD + 524288);
    const int G = gridDim.x, bx = blockIdx.x;
    unsigned* barw = (unsigned*)(ws + WS_KVMOD + 786432);
    volatile LAS unsigned* bst = (volatile LAS unsigned*)(lds + 131072 + 64);
    if (threadIdx.x < 2) bst[threadIdx.x] = 0u;
    if (bx == 0) for (int i = threadIdx.x; i < XCD_BAR_WORDS; i += 512) barw[i] = 0u;
    __syncthreads();
#define GSYNC() do { asm volatile("s_waitcnt vmcnt(0) lgkmcnt(0)" ::: "memory"); grid.sync(); } while (0)

    p0_mod_gemv(lds, p.c, p.ada_w, p.ada_b, p.kv_ada_w, p.kv_ada_b, mod, kvmod);
    __syncthreads();
    convert_layer(lds, p, 0);
    rope_tables(p.pos, rcos, rsin, dcos, dsin);
    GSYNC();
    (void)xcd_barrier_post(barw, bst);
#undef GSYNC
#define GSYNC() do { XcdBarrier xb_; xb_.bar = (unsigned*)(p.ws + WS_KVMOD + 786432); xb_.x = xb_xcc_id(); xb_.st = (volatile LAS unsigned*)(lds + 131072 + 64); xcd_barrier(xb_); } while (0)
    for (int rep = 0; rep < REP_ROW0; ++rep)
    row_phase(p.x, nullptr, nullptr, nullptr, nullptr, 0, 1, p.norm_g, mod + 1024, mod, 6144, hbuf, nullptr, nullptr, nullptr, 0, nullptr, nullptr, h0s);
    GSYNC();

#pragma unroll
    for (int l = 0; l < 4; ++l) {
        const float* ng = p.norm_g + (size_t)l * 4 * 1024;
        const float* modl = mod + (size_t)l * 8 * 6144;
        const float* xcur = (l == 0) ? p.x : p.out;
        const bf16_t* mixA; const bf16_t* mixB; int mixK;
        if (l < 2) {
            {
                pg8::Gemm g{hbuf, wbuf + WO_RET_IN, MTOK, 6144, 1024}; pg8::StaticOrder S; S.init(MTOK, 6144, G, bx);
                pg8::EpiRetProj E{bufA, bufB, kzT, vT, gbuf, rcos, rsin};
#ifndef NO_G1
                for (int rep = 0; rep < REP_GEMM; ++rep) pg8::gemm_phase<pg8::EpiRetProj, pg8::StaticOrder, true, true>(lds, g, S, E);
#endif
            }
            gemv8(lds, h0s, 1024, p.ret_w_in + (size_t)l * 1024 * 6144, 6144, proj0, 0);
            GSYNC();
#ifndef NO_RET
            for (int rep = 0; rep < REP_RET; ++rep)
            ret_scan(lds, bufA, bufB, kzT, vT, obuf);
#endif
            GSYNC();
            gate_phase(obuf, gbuf, proj0, gated0);
            GSYNC();
            mixA = obuf; mixB = wbuf + WO_RET_OUT; mixK = 2048;
        } else {
            {
                pg8::Gemm g{hbuf, wbuf + WO_DF_Q, MTOK, 1024, 1024}; pg8::StaticOrder S; S.init(MTOK, 1024, G, bx);
                pg8::EpiRope64<false> E{qbuf, nullptr, dcos, dsin, 0.125f * 1.4426950408889634f};
#ifndef NO_GQ
                for (int rep = 0; rep < REP_GEMM; ++rep) pg8::gemm_phase<pg8::EpiRope64<false>, pg8::StaticOrder, true, true>(lds, g, S, E);
#endif
            }
            if (l == 2) {
                pg8::Gemm g{hkv, wbuf + WO_DF_KV, MTOK, 2048, 1024}; pg8::StaticOrder S; S.init(MTOK, 2048, G, bx);
                pg8::EpiRope64<true> E{bufA, bufB, dcos, dsin, 1.0f};
#ifndef NO_GKV
                for (int rep = 0; rep < REP_GEMM; ++rep) pg8::gemm_phase<pg8::EpiRope64<true>, pg8::StaticOrder, true, true>(lds, g, S, E);
#endif
            }
            GSYNC();
#ifndef NO_ATT
            for (int rep = 0; rep < REP_ATT; ++rep)
            diff_attn(lds, qbuf, bufA, bufB, aout, p.diff_lam + (size_t)(l - 2) * 256, p.diff_subln_g + (size_t)(l - 2) * 128, (l == 2) ? p.linit2 : p.linit3);
#endif
            GSYNC();
            mixA = aout; mixB = wbuf + WO_DF_O; mixK = 1024;
        }
        {
            pg8::Gemm g{mixA, mixB, MTOK, 1024, mixK}; pg8::StaticOrder S; S.init(MTOK, 1024, G, bx);
            pg8::EpiF32 E{ybuf, 1024};
#ifndef NO_GF
            for (int rep = 0; rep < REP_GEMM; ++rep) pg8::gemm_phase<pg8::EpiF32, pg8::StaticOrder, true, true>(lds, g, S, E);
#endif
        }
        if (l < 2) gemv8(lds, gated0, 2048, p.ret_w_out + (size_t)l * 2048 * 1024, 1024, y0s, 0);
        GSYNC();
        row_phase(xcur, p.out, ybuf, ng + 1024, modl + 2048, 6144, 1, ng + 2048, modl + 4096, modl + 3072, 6144, hbuf, nullptr, nullptr, nullptr, 0, nullptr, (l < 2) ? y0s : nullptr, (l < 2) ? h0s : nullptr);
        GSYNC();
        {
            pg8::Gemm g{hbuf, wbuf + (l < 2 ? WO_RET_W1 : WO_DF_W1), MTOK, 4096, 1024}; pg8::StaticOrder S; S.init(MTOK, 4096, G, bx);
            pg8::EpiRelu2 E{ubuf, 4096};
#ifndef NO_GR
            for (int rep = 0; rep < REP_GEMM; ++rep) pg8::gemm_phase<pg8::EpiRelu2, pg8::StaticOrder, true, true>(lds, g, S, E);
#endif
        }
        if (l < 2) gemv8(lds, h0s, 1024, p.mlp_w1 + (size_t)l * 1024 * 4096, 4096, u0s, 1);
        GSYNC();
        {
            pg8::Gemm g{ubuf, wbuf + (l < 2 ? WO_RET_W2 : WO_DF_W2), MTOK, 1024, 4096}; pg8::StaticOrder S; S.init(MTOK, 1024, G, bx);
            pg8::EpiF32 E{ybuf, 1024};
#ifndef NO_GF
            for (int rep = 0; rep < REP_GEMM; ++rep) pg8::gemm_phase<pg8::EpiF32, pg8::StaticOrder, true, true>(lds, g, S, E);
#endif
        }
        if (l < 2) gemv8(lds, u0s, 4096, p.mlp_w2 + (size_t)l * 4096 * 1024, 1024, y0s, 0);
        GSYNC();
        if (l < 3) {
            const float* ngn = p.norm_g + (size_t)(l + 1) * 4 * 1024; const float* modn = mod + (size_t)(l + 1) * 8 * 6144;
            row_phase(p.out, p.out, ybuf, ng + 3072, modl + 5120, 6144, (l == 1) ? 2 : 1, ngn, modn + 1024, modn, 6144, hbuf,
                      p.kv_norm_g, kvmod + 1024, kvmod, 2048, hkv, (l < 2) ? y0s : nullptr, (l == 0) ? h0s : nullptr);
            __syncthreads();
            convert_layer(lds, p, l + 1);
            GSYNC();
        } else {
            row_phase(p.out, p.out, ybuf, ng + 3072, modl + 5120, 6144, 0, nullptr, nullptr, nullptr, 0, nullptr, nullptr, nullptr, nullptr, 0, nullptr, nullptr, nullptr);
        }
    }
}

extern "C" void kernel_launch(void* const* d_in, const int* in_sizes, int n_in, void* d_out, int out_size, void* d_ws, size_t ws_size, hipStream_t stream) {
    static int grid_blocks = 0;
    if (!grid_blocks) {
        int dev = 0, cus = 0, per_cu = 0;
        hipGetDevice(&dev);
        hipDeviceGetAttribute(&cus, hipDeviceAttributeMultiprocessorCount, dev);
        hipFuncSetAttribute((const void*)yoco_fwd, hipFuncAttributeMaxDynamicSharedMemorySize, LDS_BYTES);
        if (hipOccupancyMaxActiveBlocksPerMultiprocessor(&per_cu, (const void*)yoco_fwd, 512, LDS_BYTES) != hipSuccess || per_cu < 1) per_cu = 1;
        (void)hipGetLastError();
        if (cus < 1) cus = 256;
        grid_blocks = cus * per_cu;
    }
    Params p{};
    p.x = (const float*)d_in[0]; p.c = (const float*)d_in[1]; p.pos = (const int*)d_in[2];
    p.norm_g = (const float*)d_in[3]; p.ada_w = (const float*)d_in[4]; p.ada_b = (const float*)d_in[5];
    p.ret_w_in = (const float*)d_in[6]; p.ret_w_out = (const float*)d_in[7]; p.kv_norm_g = (const float*)d_in[8];
    p.kv_ada_w = (const float*)d_in[9]; p.kv_ada_b = (const float*)d_in[10]; p.kv_w = (const float*)d_in[11];
    p.diff_w_q = (const float*)d_in[12]; p.diff_w_o = (const float*)d_in[13]; p.diff_lam = (const float*)d_in[14];
    p.diff_subln_g = (const float*)d_in[15]; p.mlp_w1 = (const float*)d_in[16]; p.mlp_w2 = (const float*)d_in[17];
    p.out = (float*)d_out; p.ws = (unsigned char*)d_ws;
    p.linit2 = (float)(0.8 - 0.6 * exp(-0.3 * 2.0)); p.linit3 = (float)(0.8 - 0.6 * exp(-0.3 * 3.0));
    void* args[] = {&p};
    hipError_t e = hipLaunchCooperativeKernel((const void*)yoco_fwd, dim3(grid_blocks), dim3(512), args, LDS_BYTES, stream);
    if (e != hipSuccess) fprintf(stderr, "cooperative launch failed: %s (grid %d)\n", hipGetErrorString(e), grid_blocks);
}
```

```cpp
#include <hip/hip_runtime.h>
#include <hip/hip_cooperative_groups.h>
#include <cstdio>
#include <cstdint>
#include <cmath>
namespace cg = cooperative_groups;

#define LAS __attribute__((address_space(3)))
typedef unsigned short bf16_t;
typedef short bf16x8 __attribute__((ext_vector_type(8)));
typedef float f32x4 __attribute__((ext_vector_type(4)));
typedef float f32x16 __attribute__((ext_vector_type(16)));
typedef unsigned u32x4 __attribute__((ext_vector_type(4)));
typedef unsigned u32x2 __attribute__((ext_vector_type(2)));
typedef float f32x2_t __attribute__((ext_vector_type(2)));
typedef __bf16 bf16x2_t __attribute__((ext_vector_type(2)));

__device__ __forceinline__ unsigned pk2(float lo, float hi) { f32x2_t v = {lo, hi}; bf16x2_t b = __builtin_convertvector(v, bf16x2_t); return __builtin_bit_cast(unsigned, b); }
__device__ __forceinline__ bf16_t f2bf(float x) { return (bf16_t)(pk2(x, 0.f) & 0xffffu); }
__device__ __forceinline__ u32x4 pk8(f32x4 a, f32x4 b) { u32x4 w; w.x = pk2(a[0], a[1]); w.y = pk2(a[2], a[3]); w.z = pk2(b[0], b[1]); w.w = pk2(b[2], b[3]); return w; }
__device__ __forceinline__ float bf2f(unsigned short h) { return __uint_as_float(((unsigned)h) << 16); }

constexpr int DM = 1024, NB = 8, SEQ = 2048, MTOK = NB * SEQ, DFF = 4096;
constexpr float EPS = 1e-6f;
constexpr size_t MiB = 1u << 20;
constexpr size_t WS_MOD = 0, WS_KVMOD = 1 * MiB, WS_RCOS = 2 * MiB, WS_RSIN = 10 * MiB, WS_DCOS = 18 * MiB, WS_DSIN = 19 * MiB;
constexpr size_t WS_W = 20 * MiB;
constexpr size_t WS_H = 52 * MiB;
constexpr size_t WS_A = 84 * MiB;
constexpr size_t WS_B = 116 * MiB;
constexpr size_t WS_R = 148 * MiB;
constexpr size_t WS_KZT = 276 * MiB;
constexpr size_t WS_VT = 308 * MiB;
constexpr size_t WS_Y = 276 * MiB;
constexpr size_t WO_RET_IN = 0, WO_RET_OUT = 6291456, WO_RET_W1 = 8388608, WO_RET_W2 = 12582912;
constexpr size_t WO_DF_Q = 0, WO_DF_O = 1048576, WO_DF_W1 = 2097152, WO_DF_W2 = 6291456, WO_DF_KV = 10485760;

namespace pg8 {
#define PG8_LAS __attribute__((address_space(3)))
constexpr int BM = 256, BK = 64, HALF = 128, HTB = HALF * BK * 2, STAGE_BYTES = 8 * HTB, NXCD = 8, WGM = 8;
__host__ __device__ __forceinline__ int lds_byte(int r, int c) { const int st = (r >> 4) * 2 + (c >> 5), rr = r & 15, cc = c & 31, ob = rr * 64 + cc * 2; return st * 1024 + (ob ^ (((ob >> 9) & 1) << 5)); }
__host__ __device__ __forceinline__ void stage_rc(int b, int& R, int& C) { const int st = b / 1024, sb = b % 1024, swz = sb ^ (((sb >> 9) & 1) << 5); R = (st >> 1) * 16 + swz / 64; C = (st & 1) * 32 + (swz % 64) / 2; }
__host__ __device__ __forceinline__ int perm32(int rho) { const int n = rho >> 4, i = rho & 15; return 8 * (i >> 2) + 4 * n + (i & 3); }
struct Unit { int pm, pn; };
struct Gemm { const bf16_t* A; const bf16_t* Bt; int M, N, K; };
struct StaticOrder {
    int nM, nN, nwg, G, c;
    __host__ __device__ void init(int M, int N, int G_, int c_) { nM = M / BM; nN = N / BM; nwg = nM * nN; G = G_; c = c_; }
    __host__ __device__ bool next(int i, Unit& u) const {
        const long L = (long)i * G + c; if (L >= nwg) return false;
        int wgid = (int)L; { const int q = nwg / NXCD, r = nwg % NXCD, xcd = wgid % NXCD, off = wgid / NXCD; wgid = (xcd < r ? xcd * (q + 1) : r * (q + 1) + (xcd - r) * q) + off; }
        const int nig = WGM * nN, gid = wgid / nig, fm = gid * WGM, gsz = (nM - fm) < WGM ? (nM - fm) : WGM;
        u.pm = fm + ((wgid % nig) % gsz); u.pn = (wgid % nig) / gsz; return true;
    }
    __device__ __forceinline__ void a_ready(const Unit&) const {}
    __device__ __forceinline__ void done(const Unit&) const {}
};

struct EpiF32 {
    static constexpr bool PERM = false, AFTER_DRAIN = false;
    float* Y; int ldc;
    __device__ __forceinline__ void operator()(const f32x4 (&acc)[2][2][4][2], const Unit& u, int wr, int wc, int fr, int fq) const {
        int row0 = u.pm * BM + wr * 64 + fr, col0 = u.pn * BM + wc * 32 + 4 * fq;
        asm volatile("" : "+v"(row0), "+v"(col0));
#pragma unroll
        for (int ai = 0; ai < 2; ++ai)
#pragma unroll
            for (int m = 0; m < 4; ++m) { float* rp = Y + (size_t)(row0 + ai * HALF + m * 16) * ldc + col0;
#pragma unroll
                for (int bj = 0; bj < 2; ++bj)
#pragma unroll
                    for (int n = 0; n < 2; ++n) *(f32x4*)(rp + bj * HALF + n * 16) = acc[ai][bj][m][n]; }
    }
};
struct EpiRelu2 {
    static constexpr bool PERM = true, AFTER_DRAIN = false;
    bf16_t* O; int ldc;
    __device__ __forceinline__ void operator()(const f32x4 (&acc)[2][2][4][2], const Unit& u, int wr, int wc, int fr, int fq) const {
        const int row0 = u.pm * BM + wr * 64 + fr, col0 = u.pn * BM + wc * 32 + 8 * fq;
#pragma unroll
        for (int ai = 0; ai < 2; ++ai)
#pragma unroll
            for (int m = 0; m < 4; ++m) { bf16_t* rp = O + (size_t)(row0 + ai * HALF + m * 16) * ldc + col0;
#pragma unroll
                for (int bj = 0; bj < 2; ++bj) { f32x4 v0 = acc[ai][bj][m][0], v1 = acc[ai][bj][m][1];
#pragma unroll
                    for (int i = 0; i < 4; ++i) { float a = fmaxf(v0[i], 0.f), b = fmaxf(v1[i], 0.f); v0[i] = a * a; v1[i] = b * b; }
                    *(u32x4*)(rp + bj * HALF) = pk8(v0, v1); } }
    }
};
struct EpiRetProj {
    static constexpr bool PERM = true, AFTER_DRAIN = false;
    bf16_t *q, *k, *kzT, *vT, *g; const float *rcos, *rsin;
    __device__ __forceinline__ void operator()(const f32x4 (&acc)[2][2][4][2], const Unit& u, int wr, int wc, int fr, int fq) const {
        const int pn = u.pn, rbase = u.pm * BM + wr * 64 + fr, cl = wc * 32 + 8 * fq;
        if (pn < 8) {
            const int head = pn & 3; const bool isk = pn >= 4;
            const float lg = __log2f(1.0f - exp2f(-5.0f - (float)head));
            bf16_t* dst = isk ? k : q; const float sc = isk ? 0.0625f : 1.0f;
#pragma unroll
            for (int ai = 0; ai < 2; ++ai)
#pragma unroll
                for (int m = 0; m < 4; ++m) {
                    const int row = rbase + ai * HALF + m * 16;
                    const f32x4 c0 = *(const f32x4*)(rcos + (size_t)row * 128 + cl), c1 = *(const f32x4*)(rcos + (size_t)row * 128 + cl + 4);
                    const f32x4 s0 = *(const f32x4*)(rsin + (size_t)row * 128 + cl), s1 = *(const f32x4*)(rsin + (size_t)row * 128 + cl + 4);
                    const f32x4 a0 = acc[ai][0][m][0], a1 = acc[ai][0][m][1], b0 = acc[ai][1][m][0], b1 = acc[ai][1][m][1];
                    f32x4 o10 = (a0 * c0 - b0 * s0) * sc, o11 = (a1 * c1 - b1 * s1) * sc, o20 = (b0 * c0 + a0 * s0) * sc, o21 = (b1 * c1 + a1 * s1) * sc;
                    bf16_t* rp = dst + (size_t)row * 1024 + head * 256 + cl;
                    *(u32x4*)(rp) = pk8(o10, o11); *(u32x4*)(rp + 128) = pk8(o20, o21);
                    if (isk) {
                        const float zeta = exp2f((float)(127 - (row & 127)) * lg);
                        bf16_t* tb = kzT + ((size_t)((row >> 11) * 4 + head) * 256 + cl) * 2048 + (row & 2047);
#pragma unroll
                        for (int i = 0; i < 4; ++i) { tb[(size_t)i * 2048] = f2bf(o10[i] * zeta); tb[(size_t)(4 + i) * 2048] = f2bf(o11[i] * zeta);
                                                      tb[(size_t)(128 + i) * 2048] = f2bf(o20[i] * zeta); tb[(size_t)(132 + i) * 2048] = f2bf(o21[i] * zeta); }
                    }
                }
        } else if (pn < 16) {
            const int head = (pn - 8) >> 1, e0 = ((pn - 8) & 1) * 256 + cl;
#pragma unroll
            for (int ai = 0; ai < 2; ++ai)
#pragma unroll
                for (int m = 0; m < 4; ++m) {
                    const int row = rbase + ai * HALF + m * 16;
                    bf16_t* tb = vT + ((size_t)((row >> 11) * 4 + head) * 512 + e0) * 2048 + (row & 2047);
#pragma unroll
                    for (int bj = 0; bj < 2; ++bj)
#pragma unroll
                        for (int n = 0; n < 2; ++n)
#pragma unroll
                            for (int i = 0; i < 4; ++i) tb[(size_t)(bj * 128 + 4 * n + i) * 2048] = f2bf(acc[ai][bj][m][n][i]);
                }
        } else {
            const int col0 = (pn - 16) * 256 + cl;
#pragma unroll
            for (int ai = 0; ai < 2; ++ai)
#pragma unroll
                for (int m = 0; m < 4; ++m) { bf16_t* rp = g + (size_t)(rbase + ai * HALF + m * 16) * 2048 + col0;
#pragma unroll
                    for (int bj = 0; bj < 2; ++bj) *(u32x4*)(rp + bj * HALF) = pk8(acc[ai][bj][m][0], acc[ai][bj][m][1]); }
        }
    }
};
template <bool KV> struct EpiRope64 {
    static constexpr bool PERM = true, AFTER_DRAIN = false;
    bf16_t* dst; bf16_t* vT; const float *dcos, *dsin; float scale;
    __device__ __forceinline__ void operator()(const f32x4 (&acc)[2][2][4][2], const Unit& u, int wr, int wc, int fr, int fq) const {
        const int pn = u.pn, rbase = u.pm * BM + wr * 64 + fr, cl = wc * 32 + 8 * fq;
        if (!KV || pn < 4) {
            const bool dorope = ((wc & 1) == 0) && (fq < 2);
#pragma unroll
            for (int ai = 0; ai < 2; ++ai)
#pragma unroll
                for (int m = 0; m < 4; ++m) {
                    const int row = rbase + ai * HALF + m * 16;
                    const f32x4 c0 = *(const f32x4*)(dcos + (size_t)row * 8), c1 = *(const f32x4*)(dcos + (size_t)row * 8 + 4);
                    const f32x4 s0 = *(const f32x4*)(dsin + (size_t)row * 8), s1 = *(const f32x4*)(dsin + (size_t)row * 8 + 4);
                    bf16_t* rp = dst + (size_t)row * 1024 + pn * 256 + cl;
#pragma unroll
                    for (int bj = 0; bj < 2; ++bj) {
                        f32x4 v[2];
#pragma unroll
                        for (int n = 0; n < 2; ++n) {
                            const f32x4 x = acc[ai][bj][m][n]; f32x4 oth;
#pragma unroll
                            for (int i = 0; i < 4; ++i) oth[i] = __shfl_xor(x[i], 16);
                            const f32x4 cs = n ? c1 : c0, sn = n ? s1 : s0;
                            const f32x4 rot = (fq == 0) ? (x * cs - oth * sn) : (x * cs + oth * sn);
                            v[n] = (dorope ? rot : x) * scale;
                        }
                        *(u32x4*)(rp + bj * HALF) = pk8(v[0], v[1]);
                    }
                }
        } else {
#pragma unroll
            for (int ai = 0; ai < 2; ++ai)
#pragma unroll
                for (int m = 0; m < 4; ++m) {
                    const int row = rbase + ai * HALF + m * 16;
#pragma unroll
                    for (int bj = 0; bj < 2; ++bj) {
                        const int H = 2 * (pn - 4) + bj;
                        bf16_t* tb = vT + ((size_t)((row >> 11) * 8 + H) * 128 + cl) * 2048 + (row & 2047);
#pragma unroll
                        for (int n = 0; n < 2; ++n)
#pragma unroll
                            for (int i = 0; i < 4; ++i) tb[(size_t)(4 * n + i) * 2048] = f2bf(acc[ai][bj][m][n][i]);
                    }
                }
        }
    }
};

template <class Epi, class Sched, bool ALIGN_EPI = false, bool SP2 = false>
__device__ __forceinline__ void gemm_phase(PG8_LAS unsigned char* lds, const Gemm g, const Sched& S, const Epi& E) {
    int tid_o = threadIdx.x; asm volatile("" : "+v"(tid_o));
    const int tid = tid_o, wid = __builtin_amdgcn_readfirstlane(tid >> 6), lane = tid & 63, wr = wid >> 2, wc = wid & 3, fr = lane & 15, fq = lane >> 4;
    const int K = g.K, nt = K / BK;
    unsigned voffA[2], voffB[2];
#pragma unroll
    for (int i = 0; i < 2; ++i) { int R, C; stage_rc(tid * 16 + i * 8192, R, C); const int Rb = Epi::PERM ? ((R & ~31) + perm32(R & 31)) : R;
        voffA[i] = (unsigned)(R * K + C) * 2u; voffB[i] = (unsigned)(Rb * K + C) * 2u; }
    const size_t kstep = (size_t)(BK * 2);
    const size_t hstep = (size_t)HALF * K * 2;
    const size_t tstep = 2 * hstep;
    const unsigned ldsw = (unsigned)wid * 1024u;
    const int aoff = lds_byte(wr * 64 + fr, fq * 8), boff = lds_byte(wc * 32 + fr, fq * 8);
#define PG8_SA(b, h) (((b) * 2 + (h)) * HTB)
#define PG8_SB(b, h) ((4 + (b) * 2 + (h)) * HTB)
#define PG8_STAGE(bufoff, gbase, voff) do { _Pragma("unroll") for (int _i = 0; _i < 2; ++_i) \
        __builtin_amdgcn_global_load_lds((const unsigned*)((const char*)(gbase) + (voff)[_i]), (PG8_LAS unsigned*)(lds + (bufoff) + ldsw + _i * 8192), 16, 0, 0); } while (0)
#define PG8_LDA(dst, b, h) do { _Pragma("unroll") for (int m = 0; m < 4; ++m) _Pragma("unroll") for (int k = 0; k < 2; ++k) dst[m][k] = *(const PG8_LAS bf16x8*)(lds + PG8_SA(b, h) + aoff + m * 2048 + k * 1024); } while (0)
#define PG8_LDB(dst, b, h) do { _Pragma("unroll") for (int n = 0; n < 2; ++n) _Pragma("unroll") for (int k = 0; k < 2; ++k) dst[n][k] = *(const PG8_LAS bf16x8*)(lds + PG8_SB(b, h) + boff + n * 2048 + k * 1024); } while (0)
#define PG8_MMA(ai, bj, At, Bt) do { __builtin_amdgcn_s_setprio(1); _Pragma("unroll") for (int m = 0; m < 4; ++m) _Pragma("unroll") for (int n = 0; n < 2; ++n) _Pragma("unroll") for (int k = 0; k < 2; ++k) \
        acc[ai][bj][m][n] = __builtin_amdgcn_mfma_f32_16x16x32_bf16(Bt[n][k], At[m][k], acc[ai][bj][m][n], 0, 0, 0); __builtin_amdgcn_s_setprio(0); } while (0)
#define PG8_WAIT_V(n) asm volatile("s_waitcnt vmcnt(" #n ")" ::: "memory")
#define PG8_WAIT_L(n) asm volatile("s_waitcnt lgkmcnt(" #n ")" ::: "memory")
#define PG8_BAR __builtin_amdgcn_s_barrier()
#define PG8_SCHED __builtin_amdgcn_sched_barrier(0)
    Unit cur, nxt; int ui = 0;
    if (!S.next(0, cur)) return;
    f32x4 acc[2][2][4][2];
#pragma unroll
    for (int a = 0; a < 2; ++a)
#pragma unroll
        for (int b = 0; b < 2; ++b)
#pragma unroll
            for (int m = 0; m < 4; ++m)
#pragma unroll
                for (int n = 0; n < 2; ++n) acc[a][b][m][n] = (f32x4){0.f, 0.f, 0.f, 0.f};
    bf16x8 At[4][2], B0[2][2], B1[2][2];
    const char* cA = (const char*)g.A + (size_t)cur.pm * tstep; const char* cB = (const char*)g.Bt + (size_t)cur.pn * tstep;
    S.a_ready(cur);
    if constexpr (SP2) {
        PG8_STAGE(PG8_SB(0, 0), cB, voffB); PG8_STAGE(PG8_SB(0, 1), cB + hstep, voffB); PG8_STAGE(PG8_SA(0, 0), cA, voffA); PG8_STAGE(PG8_SA(0, 1), cA + hstep, voffA);
        if (wr == 1) PG8_BAR;
        PG8_WAIT_V(2); PG8_BAR;
        PG8_STAGE(PG8_SB(1, 0), cB + kstep, voffB); PG8_STAGE(PG8_SA(1, 0), cA + kstep, voffA); PG8_STAGE(PG8_SB(1, 1), cB + hstep + kstep, voffB);
        PG8_WAIT_V(6); PG8_BAR;
    } else {
        PG8_STAGE(PG8_SB(0, 0), cB, voffB); PG8_STAGE(PG8_SA(0, 0), cA, voffA); PG8_STAGE(PG8_SB(0, 1), cB + hstep, voffB); PG8_STAGE(PG8_SA(0, 1), cA + hstep, voffA);
        if (wr == 1) PG8_BAR;
        PG8_WAIT_V(4); PG8_BAR;
        PG8_STAGE(PG8_SB(1, 0), cB + kstep, voffB); PG8_STAGE(PG8_SA(1, 0), cA + kstep, voffA); PG8_STAGE(PG8_SB(1, 1), cB + hstep + kstep, voffB);
        PG8_WAIT_V(6); PG8_BAR;
    }
    for (;;) {
        const bool has_next = S.next(ui + 1, nxt);
        const char* nA = has_next ? (const char*)g.A + (size_t)nxt.pm * tstep : cA; const char* nB = has_next ? (const char*)g.Bt + (size_t)nxt.pn * tstep : cB;
        for (int t = 0; t < nt; t += 2) {
            const bool last = (t == nt - 2);
            const char* a1 = cA + (size_t)(t + 1) * kstep;
            const char* a2 = last ? nA : cA + (size_t)(t + 2) * kstep; const char* b2 = last ? nB : cB + (size_t)(t + 2) * kstep;
            const char* a3 = a2 + kstep; const char* b3 = b2 + kstep;
            if (last && has_next) S.a_ready(nxt);
            if constexpr (SP2) {
            PG8_LDB(B0, 0, 0); PG8_LDB(B1, 0, 1); PG8_SCHED; PG8_LDA(At, 0, 0); PG8_STAGE(PG8_SA(1, 1), a1 + hstep, voffA);
            PG8_WAIT_V(8); PG8_WAIT_L(0); PG8_BAR; PG8_MMA(0, 0, At, B0); PG8_MMA(0, 1, At, B1); PG8_BAR; PG8_SCHED;
            PG8_LDA(At, 0, 1); PG8_STAGE(PG8_SB(0, 0), b2, voffB); PG8_STAGE(PG8_SB(0, 1), b2 + hstep, voffB); PG8_STAGE(PG8_SA(0, 0), a2, voffA);
            PG8_WAIT_V(8); PG8_WAIT_L(0); PG8_BAR; PG8_MMA(1, 0, At, B0); PG8_MMA(1, 1, At, B1); PG8_BAR; PG8_SCHED;
            PG8_LDB(B0, 1, 0); PG8_LDB(B1, 1, 1); PG8_SCHED; PG8_LDA(At, 1, 0); PG8_STAGE(PG8_SA(0, 1), a2 + hstep, voffA);
            PG8_WAIT_V(8); PG8_WAIT_L(0); PG8_BAR; PG8_MMA(0, 0, At, B0); PG8_MMA(0, 1, At, B1); PG8_BAR; PG8_SCHED;
            PG8_LDA(At, 1, 1); PG8_STAGE(PG8_SB(1, 0), b3, voffB); PG8_STAGE(PG8_SB(1, 1), b3 + hstep, voffB); PG8_STAGE(PG8_SA(1, 0), a3, voffA);
            PG8_WAIT_V(8); PG8_WAIT_L(0); PG8_BAR; PG8_MMA(1, 0, At, B0); PG8_MMA(1, 1, At, B1); PG8_BAR; PG8_SCHED;
            } else {
            PG8_LDB(B0, 0, 0); PG8_SCHED; PG8_LDA(At, 0, 0); PG8_STAGE(PG8_SA(1, 1), a1 + hstep, voffA);
            PG8_WAIT_L(8); PG8_BAR; PG8_WAIT_L(0); PG8_MMA(0, 0, At, B0); PG8_BAR; PG8_SCHED;
            PG8_LDB(B1, 0, 1); PG8_STAGE(PG8_SB(0, 0), b2, voffB);
            PG8_BAR; PG8_WAIT_L(0); PG8_MMA(0, 1, At, B1); PG8_BAR;
            PG8_LDA(At, 0, 1); PG8_STAGE(PG8_SA(0, 0), a2, voffA);
            PG8_BAR; PG8_WAIT_L(0); PG8_MMA(1, 0, At, B0); PG8_BAR; PG8_SCHED;
            PG8_STAGE(PG8_SB(0, 1), b2 + hstep, voffB);
            PG8_WAIT_V(6); PG8_BAR; PG8_MMA(1, 1, At, B1); PG8_BAR;
            PG8_LDB(B0, 1, 0); PG8_SCHED; PG8_LDA(At, 1, 0); PG8_STAGE(PG8_SA(0, 1), a2 + hstep, voffA);
            PG8_WAIT_L(8); PG8_BAR; PG8_WAIT_L(0); PG8_MMA(0, 0, At, B0); PG8_BAR; PG8_SCHED;
            PG8_LDB(B1, 1, 1); PG8_STAGE(PG8_SB(1, 0), b3, voffB);
            PG8_BAR; PG8_WAIT_L(0); PG8_MMA(0, 1, At, B1); PG8_BAR;
            PG8_LDA(At, 1, 1); PG8_STAGE(PG8_SA(1, 0), a3, voffA);
            PG8_BAR; PG8_WAIT_L(0); PG8_MMA(1, 0, At, B0); PG8_BAR; PG8_SCHED;
            PG8_STAGE(PG8_SB(1, 1), b3 + hstep, voffB);
            PG8_WAIT_V(6); PG8_BAR; PG8_MMA(1, 1, At, B1); PG8_BAR;
            }
        }
        if constexpr (ALIGN_EPI) { if (wr == 0) PG8_BAR; }
        if constexpr (!Epi::AFTER_DRAIN) { E(acc, cur, wr, wc, fr, fq); S.done(cur); }
        if (!has_next) break;
#pragma unroll
        for (int a = 0; a < 2; ++a)
#pragma unroll
            for (int b = 0; b < 2; ++b)
#pragma unroll
                for (int m = 0; m < 4; ++m)
#pragma unroll
                    for (int n = 0; n < 2; ++n) acc[a][b][m][n] = (f32x4){0.f, 0.f, 0.f, 0.f};
        cur = nxt; cA = nA; cB = nB; ++ui;
        if constexpr (ALIGN_EPI) { if (wr == 1) PG8_BAR; }
    }
    PG8_WAIT_V(0);
    if constexpr (!ALIGN_EPI) { if (wr == 0) PG8_BAR; }
    PG8_BAR;
    if constexpr (Epi::AFTER_DRAIN) { E.fused(acc, cur, wr, wc, fr, fq, lds, wid, lane); S.done(cur); }
#undef PG8_SA
#undef PG8_SB
#undef PG8_STAGE
#undef PG8_LDA
#undef PG8_LDB
#undef PG8_MMA
#undef PG8_WAIT_V
#undef PG8_WAIT_L
#undef PG8_BAR
#undef PG8_SCHED
}
}

__device__ __forceinline__ int opq_tid() { int t = threadIdx.x; asm volatile("" : "+v"(t)); return t; }
#define MFMA32(a, b, c) __builtin_amdgcn_mfma_f32_32x32x16_bf16((a), (b), (c), 0, 0, 0)
__device__ __forceinline__ int crow(int r, int hi) { return (r & 3) + 8 * (r >> 2) + 4 * hi; }
__device__ __forceinline__ float wave_sum(float v) {
#pragma unroll
    for (int o = 1; o < 64; o <<= 1) v += __shfl_xor(v, o);
    return v;
}
__device__ __forceinline__ f32x16 zero16() { f32x16 z;
#pragma unroll
    for (int i = 0; i < 16; ++i) z[i] = 0.f;
    return z; }

__device__ __forceinline__ void p0_mod_gemv(LAS unsigned char* lds, const float* c, const float* ada_w, const float* ada_b, const float* kv_ada_w, const float* kv_ada_b, float* mod, float* kvmod) {
    LAS float* cact = (LAS float*)lds;
    LAS float* red = (LAS float*)(lds + 32768);
    const int tid = opq_tid();
    for (int i = tid; i < 8192; i += 512) { const float v = c[i]; cact[i] = v / (1.0f + expf(-v)); }
    __syncthreads();
    const int cg4 = tid & 15, kg = tid >> 4;
    for (int u = blockIdx.x; u < 416; u += gridDim.x) {
        const float* W; const float* bias; float* out; int N, cb;
        if (u < 384) { const int l = u / 96; cb = (u % 96) * 64; W = ada_w + (size_t)l * 1024 * 6144; N = 6144; bias = ada_b + l * 6144; out = mod + (size_t)l * 8 * 6144; }
        else { cb = (u - 384) * 64; W = kv_ada_w; N = 2048; bias = kv_ada_b; out = kvmod; }
        f32x4 acc[8];
#pragma unroll
        for (int b = 0; b < 8; ++b) acc[b] = (f32x4){0.f, 0.f, 0.f, 0.f};
        const float* wp = W + (size_t)(kg * 32) * N + cb + 4 * cg4;
#pragma unroll 8
        for (int kk = 0; kk < 32; ++kk) {
            const f32x4 w = *(const f32x4*)(wp + (size_t)kk * N);
#pragma unroll
            for (int b = 0; b < 8; ++b) acc[b] += w * cact[b * 1024 + kg * 32 + kk];
        }
#pragma unroll
        for (int b = 0; b < 8; ++b) *(LAS f32x4*)(red + (kg * 8 + b) * 64 + 4 * cg4) = acc[b];
        __syncthreads();
        { const int b = tid >> 6, col = tid & 63; float s = bias[cb + col];
#pragma unroll 8
          for (int g = 0; g < 32; ++g) s += red[(g * 8 + b) * 64 + col];
          out[(size_t)b * N + cb + col] = s; }
        __syncthreads();
    }
}


__device__ __forceinline__ void gemv8(LAS unsigned char* lds, const float* in, int K, const float* W, int N, float* out, int act) {
    LAS float* cact = (LAS float*)lds;
    LAS float* red = (LAS float*)(lds + 32768);
    const int tid = opq_tid();
    const int cg4 = tid & 15, kg = tid >> 4;
    for (int u = blockIdx.x; u < N / 64; u += gridDim.x) {
        f32x4 acc[8];
#pragma unroll
        for (int b = 0; b < 8; ++b) acc[b] = (f32x4){0.f, 0.f, 0.f, 0.f};
        for (int kc = 0; kc < K; kc += 1024) {
            __syncthreads();
            for (int i = tid; i < 8192; i += 512) cact[i] = in[(size_t)(i >> 10) * K + kc + (i & 1023)];
            __syncthreads();
            const float* wp = W + (size_t)(kc + kg * 32) * N + u * 64 + 4 * cg4;
#pragma unroll 8
            for (int kk = 0; kk < 32; ++kk) {
                const f32x4 w = *(const f32x4*)(wp + (size_t)kk * N);
#pragma unroll
                for (int b = 0; b < 8; ++b) acc[b] += w * cact[b * 1024 + kg * 32 + kk];
            }
        }
#pragma unroll
        for (int b = 0; b < 8; ++b) *(LAS f32x4*)(red + (kg * 8 + b) * 64 + 4 * cg4) = acc[b];
        __syncthreads();
        { const int b = tid >> 6, col = tid & 63; float s = 0.f;
#pragma unroll 8
          for (int g = 0; g < 32; ++g) s += red[(g * 8 + b) * 64 + col];
          if (act == 1) { s = fmaxf(s, 0.f); s = s * s; }
          out[(size_t)b * N + u * 64 + col] = s; }
        __syncthreads();
    }
}

__device__ __forceinline__ void transpose_item(const float* W, int K, int N, bf16_t* WT, LAS float* scr, int item, int lane) {
    const int nblk = N / 32, kb = item / nblk, nb = item % nblk, k0 = 64 * kb, n0 = 32 * nb;
#pragma unroll 8
    for (int i = 0; i < 32; ++i) { const int kk = 2 * i + (lane >> 5); scr[kk * 33 + (lane & 31)] = W[(size_t)(k0 + kk) * N + n0 + (lane & 31)]; }
    asm volatile("s_waitcnt lgkmcnt(0)" ::: "memory");
    const int c = lane & 7;
#pragma unroll
    for (int j = 0; j < 4; ++j) { const int n = (lane >> 3) + 8 * j; const LAS float* s = scr + (8 * c) * 33 + n;
        u32x4 o; o.x = pk2(s[0 * 33], s[1 * 33]); o.y = pk2(s[2 * 33], s[3 * 33]); o.z = pk2(s[4 * 33], s[5 * 33]); o.w = pk2(s[6 * 33], s[7 * 33]);
        *(u32x4*)(WT + (size_t)(n0 + n) * K + k0 + 8 * c) = o; }
    asm volatile("s_waitcnt lgkmcnt(0)" ::: "memory");
}
struct WSpec { const float* W; int K, N; size_t off; };
__device__ __forceinline__ void convert_weights(LAS unsigned char* lds, bf16_t* wbuf, const WSpec& a, const WSpec& b, const WSpec& c, const WSpec& d, const WSpec& e, int nmat) {
    const int tid = opq_tid(); const int lane = tid & 63, wave = tid >> 6;
    LAS float* scr = (LAS float*)(lds + wave * 16384);
    const int gw = blockIdx.x * 8 + wave, NGW = gridDim.x * 8;
    const int ia = (a.K / 64) * (a.N / 32), ib = (b.K / 64) * (b.N / 32), ic = (c.K / 64) * (c.N / 32), id = (d.K / 64) * (d.N / 32), ie = nmat > 4 ? (e.K / 64) * (e.N / 32) : 0;
    const int total = ia + ib + ic + id + ie;
    for (int it = gw; it < total; it += NGW) {
        int r = it;
        if (r < ia) { transpose_item(a.W, a.K, a.N, wbuf + a.off, scr, r, lane); continue; } r -= ia;
        if (r < ib) { transpose_item(b.W, b.K, b.N, wbuf + b.off, scr, r, lane); continue; } r -= ib;
        if (r < ic) { transpose_item(c.W, c.K, c.N, wbuf + c.off, scr, r, lane); continue; } r -= ic;
        if (r < id) { transpose_item(d.W, d.K, d.N, wbuf + d.off, scr, r, lane); continue; } r -= id;
        transpose_item(e.W, e.K, e.N, wbuf + e.off, scr, r, lane);
    }
}

__device__ __forceinline__ void rope_tables(const int* pos, float* rcos, float* rsin, float* dcos, float* dsin) {
    const int gt = blockIdx.x * 512 + opq_tid(), NT = gridDim.x * 512;
    for (int idx = gt; idx < MTOK * 128; idx += NT) {
        const int tok = idx >> 7, j = idx & 127;
        const float inv = (float)exp2(-(double)(2 * j) * (13.287712379549449 / 256.0));
        const float ang = (float)pos[tok] * inv;
        double rv = (double)ang * 0.15915494309189535; rv -= rint(rv);
        const float fr = (float)rv;
        rcos[idx] = __builtin_amdgcn_cosf(fr); rsin[idx] = __builtin_amdgcn_sinf(fr);
    }
    for (int idx = gt; idx < MTOK * 8; idx += NT) {
        const int tok = idx >> 3, j = idx & 7;
        const float inv = (float)exp2(-(double)(2 * j) * (18.931568569324174 / 16.0));
        const float ang = (float)pos[tok] * inv;
        double rv = (double)ang * 0.15915494309189535; rv -= rint(rv);
        const float fr = (float)rv;
        dcos[idx] = __builtin_amdgcn_cosf(fr); dsin[idx] = __builtin_amdgcn_sinf(fr);
    }
}

__device__ __forceinline__ void row_phase(const float* xin, float* xout, const float* y, const float* gy, const float* gate, int gate_bs,
                                          int nout, const float* g0, const float* sc0, const float* sh0, int bs0, bf16_t* d0,
                                          const float* g1, const float* sc1, const float* sh1, int bs1, bf16_t* d1, const float* ysh, float* h0s) {
    const int tid = opq_tid(); const int lane = tid & 63, gw = blockIdx.x * 8 + (tid >> 6), NGW = gridDim.x * 8;
    for (int row0 = gw; row0 < MTOK; row0 += 2 * NGW) {
        f32x4 xv[2][4], yv[2][4];
#pragma unroll
        for (int k = 0; k < 2; ++k) { const int row = row0 + k * NGW; if (row < MTOK) { const int b = row >> 11;
#pragma unroll
            for (int j = 0; j < 4; ++j) xv[k][j] = *(const f32x4*)(xin + (size_t)row * 1024 + 4 * lane + 256 * j);
            if (y) { const float* yrow = (ysh && (row & 2047) == 0) ? (ysh + (size_t)b * 1024) : (y + (size_t)row * 1024);
#pragma unroll
                for (int j = 0; j < 4; ++j) yv[k][j] = *(const f32x4*)(yrow + 4 * lane + 256 * j); } } }
#pragma unroll
        for (int k = 0; k < 2; ++k) { const int row = row0 + k * NGW; if (row < MTOK) { const int b = row >> 11;
            if (y) {
                float s = 0.f;
#pragma unroll
                for (int j = 0; j < 4; ++j) s += (yv[k][j][0] * yv[k][j][0] + yv[k][j][1] * yv[k][j][1]) + (yv[k][j][2] * yv[k][j][2] + yv[k][j][3] * yv[k][j][3]);
                const float rstd = rsqrtf(wave_sum(s) * (1.0f / 1024.0f) + EPS);
#pragma unroll
                for (int j = 0; j < 4; ++j) { const int col = 4 * lane + 256 * j;
                    const f32x4 gg = *(const f32x4*)(gy + col), ga = *(const f32x4*)(gate + (size_t)b * gate_bs + col);
                    xv[k][j] += (ga + 1.0f) * (yv[k][j] * rstd * gg);
                    *(f32x4*)(xout + (size_t)row * 1024 + col) = xv[k][j]; }
            }
            if (nout > 0) {
                float s = 0.f;
#pragma unroll
                for (int j = 0; j < 4; ++j) s += (xv[k][j][0] * xv[k][j][0] + xv[k][j][1] * xv[k][j][1]) + (xv[k][j][2] * xv[k][j][2] + xv[k][j][3] * xv[k][j][3]);
                const float rstd = rsqrtf(wave_sum(s) * (1.0f / 1024.0f) + EPS);
#pragma unroll
                for (int j = 0; j < 4; ++j) { const int col = 4 * lane + 256 * j;
                    const f32x4 gg = *(const f32x4*)(g0 + col), sc = *(const f32x4*)(sc0 + (size_t)b * bs0 + col), sh = *(const f32x4*)(sh0 + (size_t)b * bs0 + col);
                    const f32x4 h = (xv[k][j] * rstd * gg) * (sc + 1.0f) + sh;
                    u32x2 w; w.x = pk2(h[0], h[1]); w.y = pk2(h[2], h[3]);
                    *(u32x2*)(d0 + (size_t)row * 1024 + col) = w;
                    if (h0s && (row & 2047) == 0) *(f32x4*)(h0s + (size_t)b * 1024 + col) = h; }
                if (nout > 1) {
#pragma unroll
                    for (int j = 0; j < 4; ++j) { const int col = 4 * lane + 256 * j;
                        const f32x4 gg = *(const f32x4*)(g1 + col), sc = *(const f32x4*)(sc1 + (size_t)b * bs1 + col), sh = *(const f32x4*)(sh1 + (size_t)b * bs1 + col);
                        const f32x4 h = (xv[k][j] * rstd * gg) * (sc + 1.0f) + sh;
                        u32x2 w; w.x = pk2(h[0], h[1]); w.y = pk2(h[2], h[3]);
                        *(u32x2*)(d1 + (size_t)row * 1024 + col) = w; }
                }
            }
        } }
    }
}

__device__ __forceinline__ void gate_phase(bf16_t* o, const bf16_t* g, const float* proj0, float* gated0) {
    const int tid = opq_tid(); const int lane = tid & 63, gw = blockIdx.x * 8 + (tid >> 6), NGW = gridDim.x * 8;
    if (gw < 32) {
        const int b = gw >> 2, h = gw & 3; const float* pr = proj0 + (size_t)b * 6144;
        const f32x4 qv = *(const f32x4*)(pr + h * 256 + 4 * lane), kv = *(const f32x4*)(pr + 1024 + h * 256 + 4 * lane);
        const float s00 = wave_sum((qv[0] * kv[0] + qv[1] * kv[1]) + (qv[2] * kv[2] + qv[3] * kv[3])) * 0.0625f;
        const f32x4 v0 = *(const f32x4*)(pr + 2048 + h * 512 + 8 * lane), v1 = *(const f32x4*)(pr + 2048 + h * 512 + 8 * lane + 4);
        const f32x4 g0 = *(const f32x4*)(pr + 4096 + h * 512 + 8 * lane), g1 = *(const f32x4*)(pr + 4096 + h * 512 + 8 * lane + 4);
        const f32x4 o0 = v0 * s00, o1 = v1 * s00;
        const float ss = wave_sum((o0[0] * o0[0] + o0[1] * o0[1]) + (o0[2] * o0[2] + o0[3] * o0[3]) + (o1[0] * o1[0] + o1[1] * o1[1]) + (o1[2] * o1[2] + o1[3] * o1[3]));
        const float rstd = rsqrtf(ss * (1.0f / 512.0f) + EPS);
        f32x4 r0, r1;
#pragma unroll
        for (int i = 0; i < 4; ++i) { r0[i] = (g0[i] / (1.0f + expf(-g0[i]))) * (o0[i] * rstd); r1[i] = (g1[i] / (1.0f + expf(-g1[i]))) * (o1[i] * rstd); }
        *(f32x4*)(gated0 + (size_t)b * 2048 + h * 512 + 8 * lane) = r0; *(f32x4*)(gated0 + (size_t)b * 2048 + h * 512 + 8 * lane + 4) = r1;
    }
    for (int it0 = gw; it0 < MTOK * 4; it0 += 4 * NGW) {
        u32x4 ov[4], gv[4];
#pragma unroll
        for (int k = 0; k < 4; ++k) { const int it = it0 + k * NGW; if (it < MTOK * 4) { const size_t off = (size_t)it * 512 + 8 * lane; ov[k] = *(const u32x4*)(o + off); gv[k] = *(const u32x4*)(g + off); } }
#pragma unroll
        for (int k = 0; k < 4; ++k) { const int it = it0 + k * NGW; if (it < MTOK * 4) {
            const size_t off = (size_t)it * 512 + 8 * lane;
            float of[8], gf[8];
#pragma unroll
            for (int i = 0; i < 4; ++i) { of[2 * i] = __uint_as_float(ov[k][i] << 16); of[2 * i + 1] = __uint_as_float(ov[k][i] & 0xffff0000u);
                                          gf[2 * i] = __uint_as_float(gv[k][i] << 16); gf[2 * i + 1] = __uint_as_float(gv[k][i] & 0xffff0000u); }
            float ss = 0.f;
#pragma unroll
            for (int i = 0; i < 8; ++i) ss += of[i] * of[i];
            const float rstd = rsqrtf(wave_sum(ss) * (1.0f / 512.0f) + EPS);
            float r[8];
#pragma unroll
            for (int i = 0; i < 8; ++i) r[i] = (gf[i] / (1.0f + __expf(-gf[i]))) * (of[i] * rstd);
            u32x4 w; w.x = pk2(r[0], r[1]); w.y = pk2(r[2], r[3]); w.z = pk2(r[4], r[5]); w.w = pk2(r[6], r[7]);
            *(u32x4*)(o + off) = w; } }
    }
}

constexpr int P_LD = 136, R_LD = 264;
__device__ __forceinline__ void ret_scan(LAS unsigned char* lds, const bf16_t* q, const bf16_t* k, const bf16_t* kzT, const bf16_t* vT, bf16_t* o) {
    LAS bf16_t* Pl = (LAS bf16_t*)lds;
    LAS bf16_t* Rl = (LAS bf16_t*)(lds + 128 * P_LD * 2);
    const int tid = opq_tid(); const int lane = tid & 63, wid = __builtin_amdgcn_readfirstlane(tid >> 6), l31 = lane & 31, hi = lane >> 5;
    for (int unit = blockIdx.x; unit < 256; unit += gridDim.x) {
        const int b = unit >> 5, h = (unit >> 3) & 3, es = unit & 7;
        const float lg = __log2f(1.0f - exp2f(-5.0f - (float)h));
        const float decay = exp2f(128.0f * lg);
        f32x16 Rt[2]; Rt[0] = zero16(); Rt[1] = zero16();
        const bf16_t* vTb = vT + ((size_t)(b * 4 + h) * 512 + es * 64) * 2048;
        const bf16_t* kzb = kzT + ((size_t)(b * 4 + h) * 256 + 32 * wid + l31) * 2048;
        for (int n = 0; n < 16; ++n) {
            const int t0 = b * 2048 + n * 128;
#pragma unroll
            for (int eb = 0; eb < 2; ++eb)
#pragma unroll
                for (int r = 0; r < 16; ++r) Rl[(32 * eb + crow(r, hi)) * R_LD + 32 * wid + l31] = f2bf(Rt[eb][r]);
            {
                const int cb = wid >> 1;
                const bf16_t* qa = q + (size_t)(t0 + 32 * cb + l31) * 1024 + h * 256 + 8 * hi;
#pragma unroll
                for (int mt = 0; mt < 2; ++mt) {
                    const int mb = 2 * (wid & 1) + mt;
                    f32x16 acc = zero16();
                    if (mb <= cb) {
                        const bf16_t* kb = k + (size_t)(t0 + 32 * mb + l31) * 1024 + h * 256 + 8 * hi;
#pragma unroll
                        for (int ks = 0; ks < 16; ++ks) acc = MFMA32(*(const bf16x8*)(qa + 16 * ks), *(const bf16x8*)(kb + 16 * ks), acc);
                    }
#pragma unroll
                    for (int r = 0; r < 16; ++r) {
                        const int c = 32 * cb + crow(r, hi), m = 32 * mb + l31, df = c - m;
                        const float v = (df >= 0) ? acc[r] * exp2f((float)df * lg) : 0.f;
                        Pl[c * P_LD + m] = f2bf(v);
                    }
                }
            }
            __syncthreads();
            {
                const int cb = wid >> 1, eb = wid & 1;
                const bf16_t* qa = q + (size_t)(t0 + 32 * cb + l31) * 1024 + h * 256 + 8 * hi;
                f32x16 acc = zero16();
#pragma unroll
                for (int ks = 0; ks < 16; ++ks) acc = MFMA32(*(const bf16x8*)(qa + 16 * ks), *(const LAS bf16x8*)(Rl + (32 * eb + l31) * R_LD + 16 * ks + 8 * hi), acc);
#pragma unroll
                for (int r = 0; r < 16; ++r) acc[r] *= exp2f((float)(32 * cb + crow(r, hi) + 1) * lg);
                const bf16_t* vb = vTb + (size_t)(32 * eb + l31) * 2048 + n * 128 + 8 * hi;
                for (int ks = 0; ks < 2 * (cb + 1); ++ks) acc = MFMA32(*(const LAS bf16x8*)(Pl + (32 * cb + l31) * P_LD + 16 * ks + 8 * hi), *(const bf16x8*)(vb + 16 * ks), acc);
                bf16_t* op = o + (size_t)(t0 + 32 * cb) * 2048 + h * 512 + es * 64 + 32 * eb + l31;
#pragma unroll
                for (int r = 0; r < 16; ++r) op[(size_t)crow(r, hi) * 2048] = f2bf(acc[r]);
            }
#pragma unroll
            for (int eb = 0; eb < 2; ++eb) {
                const bf16_t* va = vTb + (size_t)(32 * eb + l31) * 2048 + n * 128 + 8 * hi;
                f32x16 acc = Rt[eb] * decay;
#pragma unroll
                for (int ks = 0; ks < 8; ++ks) acc = MFMA32(*(const bf16x8*)(va + 16 * ks), *(const bf16x8*)(kzb + n * 128 + 16 * ks + 8 * hi), acc);
                Rt[eb] = acc;
            }
            __syncthreads();
        }
    }
}

__device__ __forceinline__ void diff_attn(LAS unsigned char* lds, const bf16_t* qb_, const bf16_t* ksh, const bf16_t* vTsh, bf16_t* aout,
                                          const float* lam, const float* subg, float linit) {
    LAS float* xch = (LAS float*)lds;
    const int tid = opq_tid(); const int lane = tid & 63, wid = __builtin_amdgcn_readfirstlane(tid >> 6), l31 = lane & 31, hi = lane >> 5, grp = wid >> 2, wq = wid & 3;
    float lam_full;
    { const float p1 = lam[lane] * lam[64 + lane], p2 = lam[128 + lane] * lam[192 + lane];
      lam_full = expf(wave_sum(p1)) - expf(wave_sum(p2)) + linit; }
    const int pi_l = 16 * (((l31 & 3) + 4 * (l31 >> 3)) >> 3) + 8 * ((l31 >> 2) & 1) + (((l31 & 3) + 4 * (l31 >> 3)) & 7);
    for (int u = blockIdx.x; u < 1024; u += gridDim.x) {
        const int vv = u & 255, ii = u >> 8, bh = vv >> 2, s4 = vv & 3;
        const int qblk = (ii == 0) ? s4 : (ii == 1) ? 7 - s4 : (ii == 2) ? 8 + s4 : 15 - s4;
        const int b = bh >> 3, H = bh & 7, head = 2 * H + grp;
        const int qs0 = qblk * 128 + 32 * wq, myq = qs0 + l31;
        bf16x8 qf[4];
        { const bf16_t* qp = qb_ + (size_t)(b * 2048 + myq) * 1024 + head * 64 + 8 * hi;
#pragma unroll
          for (int ks = 0; ks < 4; ++ks) qf[ks] = *(const bf16x8*)(qp + 16 * ks); }
        f32x16 OT[4];
#pragma unroll
        for (int e = 0; e < 4; ++e) OT[e] = zero16();
        float m_run = -1e30f, l_run = 0.f;
        const int ntiles = qblk * 4 + wq + 1;
        const bf16_t* kbase = ksh + (size_t)(b * 2048 + pi_l) * 1024 + head * 64 + 8 * hi;
        const bf16_t* vbase = vTsh + ((size_t)(b * 8 + H) * 128 + l31) * 2048 + 8 * hi;
        for (int t = 0; t < ntiles; ++t) {
            const int kv0 = 32 * t;
            f32x16 acc = zero16();
            { const bf16_t* kp = kbase + (size_t)kv0 * 1024;
#pragma unroll
              for (int ks = 0; ks < 4; ++ks) acc = MFMA32(*(const bf16x8*)(kp + 16 * ks), qf[ks], acc); }
            if (t == ntiles - 1) {
#pragma unroll
                for (int r = 0; r < 16; ++r) { const int kv = kv0 + 16 * (r >> 3) + 8 * hi + (r & 7); if (kv > myq) acc[r] = -INFINITY; }
            }
            float rm = acc[0];
#pragma unroll
            for (int r = 1; r < 16; ++r) rm = fmaxf(rm, acc[r]);
            rm = fmaxf(rm, __shfl_xor(rm, 32));
            const float m_new = fmaxf(m_run, rm);
            const float alpha = __builtin_amdgcn_exp2f(m_run - m_new);
            float rs = 0.f;
#pragma unroll
            for (int r = 0; r < 16; ++r) { acc[r] = __builtin_amdgcn_exp2f(acc[r] - m_new); rs += acc[r]; }
            rs += __shfl_xor(rs, 32);
            l_run = l_run * alpha + rs; m_run = m_new;
#pragma unroll
            for (int e = 0; e < 4; ++e) OT[e] *= alpha;
            bf16x8 pf[2];
#pragma unroll
            for (int kk = 0; kk < 2; ++kk) { u32x4 w; w.x = pk2(acc[8 * kk], acc[8 * kk + 1]); w.y = pk2(acc[8 * kk + 2], acc[8 * kk + 3]); w.z = pk2(acc[8 * kk + 4], acc[8 * kk + 5]); w.w = pk2(acc[8 * kk + 6], acc[8 * kk + 7]);
                                             pf[kk] = __builtin_bit_cast(bf16x8, w); }
            const bf16_t* vp = vbase + kv0;
#pragma unroll
            for (int e = 0; e < 4; ++e)
#pragma unroll
                for (int kk = 0; kk < 2; ++kk) OT[e] = MFMA32(*(const bf16x8*)(vp + (size_t)(32 * e) * 2048 + 16 * kk), pf[kk], OT[e]);
        }
        const float inv = 1.0f / l_run;
        if (grp == 1) {
            const float f = inv * lam_full;
#pragma unroll
            for (int e = 0; e < 4; ++e)
#pragma unroll
                for (int r = 0; r < 16; ++r) xch[(wq * 64 + e * 16 + r) * 64 + lane] = OT[e][r] * f;
        }
        __syncthreads();
        if (grp == 0) {
            float ss = 0.f;
#pragma unroll
            for (int e = 0; e < 4; ++e)
#pragma unroll
                for (int r = 0; r < 16; ++r) { const float v = OT[e][r] * inv - xch[(wq * 64 + e * 16 + r) * 64 + lane]; OT[e][r] = v; ss += v * v; }
            ss += __shfl_xor(ss, 32);
            const float rstd = rsqrtf(ss * (1.0f / 128.0f) + EPS) * (1.0f - linit);
            bf16_t* op = aout + (size_t)(b * 2048 + myq) * 1024 + H * 128;
#pragma unroll
            for (int e = 0; e < 4; ++e)
#pragma unroll
                for (int a = 0; a < 4; ++a) {
                    const int e0 = 32 * e + 8 * a + 4 * hi;
                    const f32x4 gg = *(const f32x4*)(subg + e0);
                    u32x2 w; w.x = pk2(OT[e][4 * a] * rstd * gg[0], OT[e][4 * a + 1] * rstd * gg[1]); w.y = pk2(OT[e][4 * a + 2] * rstd * gg[2], OT[e][4 * a + 3] * rstd * gg[3]);
                    *(u32x2*)(op + e0) = w;
                }
        }
        __syncthreads();
    }
}

#define XB_TMO      128
#define XB_XCNT(j)  (256  + 64 * (j))
#define XB_XSUB(j)  (1280 + 64 * (j))
#define XB_XGEN(j)  (2304 + 64 * (j))
#define XB_TOP      3328
#define XB_TOPGEN   3392
#define XCD_BAR_WORDS 3456
#define XB_SPIN_CAP (1u << 18)

__device__ __forceinline__ unsigned xb_ld(unsigned* p)              { return __hip_atomic_load(p, __ATOMIC_RELAXED, __HIP_MEMORY_SCOPE_AGENT); }
__device__ __forceinline__ unsigned xb_add(unsigned* p, unsigned v) { return __hip_atomic_fetch_add(p, v, __ATOMIC_RELAXED, __HIP_MEMORY_SCOPE_AGENT); }
__device__ __forceinline__ unsigned xb_xcc_id() { return (unsigned)__builtin_amdgcn_s_getreg((3 << 11) | 20) & 0xFu; }
#define XB_SPIN(cond, bar) do { unsigned _sp = 0; while (cond) { __builtin_amdgcn_s_sleep(1); \
    if ((++_sp & 255u) == 0u) { if (xb_ld(&(bar)[XB_TMO])) break; if (_sp > XB_SPIN_CAP) { atomicAdd(&(bar)[XB_TMO], 1u); break; } } } } while (0)

struct XcdBarrier {
    unsigned* bar; unsigned x;
    volatile LAS unsigned* st;
};

__device__ __forceinline__ XcdBarrier xcd_barrier_post(unsigned* bar, volatile LAS unsigned* st) {
    XcdBarrier b; b.bar = bar; b.x = xb_xcc_id(); b.st = st;
    if (threadIdx.x == 0) (void)xb_add(&bar[XB_XCNT(b.x)], 1u);
    return b;
}
__device__ __forceinline__ void xcd_barrier_complete(unsigned* bar, unsigned x, unsigned& nloc, unsigned& nx) {
    const unsigned G = gridDim.x * gridDim.y * gridDim.z;
    unsigned sum, cnt, mine, sp = 0u;
    for (;;) {
        sum = 0u; cnt = 0u; mine = 0u;
#pragma unroll
        for (unsigned j = 0; j < 16; ++j) { const unsigned c = xb_ld(&bar[XB_XCNT(j)]); sum += c; cnt += (c > 0u) ? 1u : 0u; mine = (j == x) ? c : mine; }
        if (sum == G) break;
        __builtin_amdgcn_s_sleep(1);
        if ((++sp & 255u) == 0u) { if (xb_ld(&bar[XB_TMO])) break; if (sp > XB_SPIN_CAP) { atomicAdd(&bar[XB_TMO], 1u); break; } }
    }
    nloc = mine > 0u ? mine : 1u; nx = cnt > 0u ? cnt : 1u;
}

__device__ __forceinline__ void xcd_barrier(const XcdBarrier& b) {
    asm volatile("s_waitcnt vmcnt(0)" ::: "memory");
    __syncthreads();
    if (threadIdx.x == 0) {
        unsigned* bar = b.bar;
        __builtin_amdgcn_s_waitcnt(0);
        unsigned nloc = b.st[0], nx = b.st[1];
        if (nloc == 0u) { xcd_barrier_complete(bar, b.x, nloc, nx); b.st[0] = nloc; b.st[1] = nx; }
        const unsigned old = xb_add(&bar[XB_XSUB(b.x)], 1u);
        const unsigned gen = old / nloc;
        if (old + 1u == (gen + 1u) * nloc) {
            __builtin_amdgcn_fence(__ATOMIC_RELEASE, "agent");
            asm volatile("s_waitcnt vmcnt(0)" ::: "memory");
            const unsigned og = xb_add(&bar[XB_TOP], 1u);
            const unsigned tg = og / nx;
            if (og + 1u == (tg + 1u) * nx) xb_add(&bar[XB_TOPGEN], 1u);
            else XB_SPIN(xb_ld(&bar[XB_TOPGEN]) == tg, bar);
            __builtin_amdgcn_fence(__ATOMIC_ACQUIRE, "agent");
            xb_add(&bar[XB_XGEN(b.x)], 1u);
            asm volatile("s_waitcnt vmcnt(0)" ::: "memory");
        } else {
            XB_SPIN(xb_ld(&bar[XB_XGEN(b.x)]) == gen, bar);
            __builtin_amdgcn_fence(__ATOMIC_ACQUIRE, "agent");
            asm volatile("s_waitcnt vmcnt(0)" ::: "memory");
        }
    }
    __syncthreads();
}

struct Params {
    const float *x, *c; const int* pos;
    const float *norm_g, *ada_w, *ada_b, *ret_w_in, *ret_w_out, *kv_norm_g, *kv_ada_w, *kv_ada_b, *kv_w, *diff_w_q, *diff_w_o, *diff_lam, *diff_subln_g, *mlp_w1, *mlp_w2;
    float* out; unsigned char* ws; float linit2, linit3, pad0, pad1;
};
constexpr int LDS_BYTES = 147456;
#ifndef REP_ATT
#define REP_ATT 1
#endif
#ifndef REP_RET
#define REP_RET 1
#endif
#ifndef REP_GEMM
#define REP_GEMM 1
#endif
#ifndef REP_ROW0
#define REP_ROW0 1
#endif

constexpr int PTAB_OFF = 131072 + 128;
enum { PT_X = 0, PT_C, PT_POS, PT_NORMG, PT_ADAW, PT_ADAB, PT_RWIN, PT_RWOUT, PT_KVNG, PT_KVAW, PT_KVAB, PT_KVW, PT_DWQ, PT_DWO, PT_DLAM, PT_DSG, PT_W1, PT_W2, PT_OUT, PT_WS, PT_N };
__device__ __forceinline__ unsigned long long ptab_get(LAS unsigned char* lds, int i) {
    volatile LAS unsigned* t = (volatile LAS unsigned*)(lds + PTAB_OFF) + 2 * i;
    const unsigned lo = __builtin_amdgcn_readfirstlane(t[0]), hi = __builtin_amdgcn_readfirstlane(t[1]);
    return ((unsigned long long)hi << 32) | lo;
}
#define PIN_(i, T) ((T)ptab_get(lds, (i)))
#define WSP(T, off) ((T)(ptab_get(lds, PT_WS) + (unsigned long long)(off)))

__device__ __forceinline__ void convert_layer(LAS unsigned char* lds, int l) {
    bf16_t* wbuf = WSP(bf16_t*, WS_W);
    const float* w1 = PIN_(PT_W1, const float*) + (size_t)l * 1024 * 4096; const float* w2 = PIN_(PT_W2, const float*) + (size_t)l * 4096 * 1024;
    if (l < 2) {
        WSpec a{PIN_(PT_RWIN, const float*) + (size_t)l * 1024 * 6144, 1024, 6144, WO_RET_IN}, b{PIN_(PT_RWOUT, const float*) + (size_t)l * 2048 * 1024, 2048, 1024, WO_RET_OUT},
              c{w1, 1024, 4096, WO_RET_W1}, d{w2, 4096, 1024, WO_RET_W2};
        convert_weights(lds, wbuf, a, b, c, d, d, 4);
    } else {
        const int j = l - 2;
        WSpec a{PIN_(PT_DWQ, const float*) + (size_t)j * 1024 * 1024, 1024, 1024, WO_DF_Q}, b{PIN_(PT_DWO, const float*) + (size_t)j * 1024 * 1024, 1024, 1024, WO_DF_O},
              c{w1, 1024, 4096, WO_DF_W1}, d{w2, 4096, 1024, WO_DF_W2}, e{PIN_(PT_KVW, const float*), 1024, 2048, WO_DF_KV};
        convert_weights(lds, wbuf, a, b, c, d, e, l == 2 ? 5 : 4);
    }
}

constexpr size_t WS_H0S = WS_KVMOD + 131072, WS_PROJ0 = WS_KVMOD + 196608, WS_GATED0 = WS_KVMOD + 393216, WS_Y0S = WS_KVMOD + 458752, WS_U0S = WS_KVMOD + 524288, WS_BARW = WS_KVMOD + 786432;

__global__ void __launch_bounds__(512, 2) yoco_fwd(Params p) {
    extern __shared__ __attribute__((aligned(16))) unsigned char lds_raw[];
    LAS unsigned char* lds = (LAS unsigned char*)lds_raw;
    cg::grid_group grid = cg::this_grid();
    const int G = gridDim.x, bx = blockIdx.x;
    {
        volatile LAS unsigned* bst = (volatile LAS unsigned*)(lds + 131072 + 64);
        if (threadIdx.x < 2) bst[threadIdx.x] = 0u;
        if (threadIdx.x == 0) {
            LAS unsigned long long* t = (LAS unsigned long long*)(lds + PTAB_OFF);
            t[PT_X] = (unsigned long long)p.x; t[PT_C] = (unsigned long long)p.c; t[PT_POS] = (unsigned long long)p.pos; t[PT_NORMG] = (unsigned long long)p.norm_g;
            t[PT_ADAW] = (unsigned long long)p.ada_w; t[PT_ADAB] = (unsigned long long)p.ada_b; t[PT_RWIN] = (unsigned long long)p.ret_w_in; t[PT_RWOUT] = (unsigned long long)p.ret_w_out;
            t[PT_KVNG] = (unsigned long long)p.kv_norm_g; t[PT_KVAW] = (unsigned long long)p.kv_ada_w; t[PT_KVAB] = (unsigned long long)p.kv_ada_b; t[PT_KVW] = (unsigned long long)p.kv_w;
            t[PT_DWQ] = (unsigned long long)p.diff_w_q; t[PT_DWO] = (unsigned long long)p.diff_w_o; t[PT_DLAM] = (unsigned long long)p.diff_lam; t[PT_DSG] = (unsigned long long)p.diff_subln_g;
            t[PT_W1] = (unsigned long long)p.mlp_w1; t[PT_W2] = (unsigned long long)p.mlp_w2; t[PT_OUT] = (unsigned long long)p.out; t[PT_WS] = (unsigned long long)p.ws;
        }
        if (bx == 0) { unsigned* barw = (unsigned*)(p.ws + WS_BARW); for (int i = threadIdx.x; i < XCD_BAR_WORDS; i += 512) barw[i] = 0u; }
        __syncthreads();
    }
    p0_mod_gemv(lds, PIN_(PT_C, const float*), PIN_(PT_ADAW, const float*), PIN_(PT_ADAB, const float*), PIN_(PT_KVAW, const float*), PIN_(PT_KVAB, const float*), WSP(float*, WS_MOD), WSP(float*, WS_KVMOD));
    __syncthreads();
    convert_layer(lds, 0);
    rope_tables(PIN_(PT_POS, const int*), WSP(float*, WS_RCOS), WSP(float*, WS_RSIN), WSP(float*, WS_DCOS), WSP(float*, WS_DSIN));
    asm volatile("s_waitcnt vmcnt(0) lgkmcnt(0)" ::: "memory"); grid.sync();
    (void)xcd_barrier_post(WSP(unsigned*, WS_BARW), (volatile LAS unsigned*)(lds + 131072 + 64));
#define GSYNC() do { XcdBarrier xb_; xb_.bar = WSP(unsigned*, WS_BARW); xb_.x = xb_xcc_id(); xb_.st = (volatile LAS unsigned*)(lds + 131072 + 64); xcd_barrier(xb_); } while (0)
    { float* mod = WSP(float*, WS_MOD);
      row_phase(PIN_(PT_X, const float*), nullptr, nullptr, nullptr, nullptr, 0, 1, PIN_(PT_NORMG, const float*), mod + 1024, mod, 6144, WSP(bf16_t*, WS_H), nullptr, nullptr, nullptr, 0, nullptr, nullptr, WSP(float*, WS_H0S)); }
    GSYNC();

    for (int l = 0; l < 4; ++l) {
        if (l < 2) {
            {
                bf16_t* wsb = WSP(bf16_t*, 0);
                pg8::Gemm g{(const bf16_t*)((unsigned char*)wsb + WS_H), (const bf16_t*)((unsigned char*)wsb + WS_W) + WO_RET_IN, MTOK, 6144, 1024}; pg8::StaticOrder S; S.init(MTOK, 6144, G, bx);
                pg8::EpiRetProj E{(bf16_t*)((unsigned char*)wsb + WS_A), (bf16_t*)((unsigned char*)wsb + WS_B), (bf16_t*)((unsigned char*)wsb + WS_KZT), (bf16_t*)((unsigned char*)wsb + WS_VT), (bf16_t*)((unsigned char*)wsb + WS_R),
                                  (const float*)((unsigned char*)wsb + WS_RCOS), (const float*)((unsigned char*)wsb + WS_RSIN)};
                for (int rep = 0; rep < REP_GEMM; ++rep) pg8::gemm_phase<pg8::EpiRetProj, pg8::StaticOrder, true, true>(lds, g, S, E);
            }
            gemv8(lds, WSP(const float*, WS_H0S), 1024, PIN_(PT_RWIN, const float*) + (size_t)l * 1024 * 6144, 6144, WSP(float*, WS_PROJ0), 0);
            GSYNC();
            for (int rep = 0; rep < REP_RET; ++rep)
            ret_scan(lds, WSP(const bf16_t*, WS_A), WSP(const bf16_t*, WS_B), WSP(const bf16_t*, WS_KZT), WSP(const bf16_t*, WS_VT), WSP(bf16_t*, WS_R + 64 * MiB));
            GSYNC();
            gate_phase(WSP(bf16_t*, WS_R + 64 * MiB), WSP(const bf16_t*, WS_R), WSP(const float*, WS_PROJ0), WSP(float*, WS_GATED0));
            GSYNC();
        } else {
            {
                unsigned char* wsb = WSP(unsigned char*, 0);
                pg8::Gemm g{(const bf16_t*)(wsb + WS_H), (const bf16_t*)(wsb + WS_W) + WO_DF_Q, MTOK, 1024, 1024}; pg8::StaticOrder S; S.init(MTOK, 1024, G, bx);
                pg8::EpiRope64<false> E{(bf16_t*)(wsb + WS_R), nullptr, (const float*)(wsb + WS_DCOS), (const float*)(wsb + WS_DSIN), 0.125f * 1.4426950408889634f};
                for (int rep = 0; rep < REP_GEMM; ++rep) pg8::gemm_phase<pg8::EpiRope64<false>, pg8::StaticOrder, true, true>(lds, g, S, E);
            }
            if (l == 2) {
                unsigned char* wsb = WSP(unsigned char*, 0);
                pg8::Gemm g{(const bf16_t*)(wsb + WS_R + 64 * MiB), (const bf16_t*)(wsb + WS_W) + WO_DF_KV, MTOK, 2048, 1024}; pg8::StaticOrder S; S.init(MTOK, 2048, G, bx);
                pg8::EpiRope64<true> E{(bf16_t*)(wsb + WS_A), (bf16_t*)(wsb + WS_B), (const float*)(wsb + WS_DCOS), (const float*)(wsb + WS_DSIN), 1.0f};
                for (int rep = 0; rep < REP_GEMM; ++rep) pg8::gemm_phase<pg8::EpiRope64<true>, pg8::StaticOrder, true, true>(lds, g, S, E);
            }
            GSYNC();
            for (int rep = 0; rep < REP_ATT; ++rep)
            diff_attn(lds, WSP(const bf16_t*, WS_R), WSP(const bf16_t*, WS_A), WSP(const bf16_t*, WS_B), WSP(bf16_t*, WS_R + 32 * MiB),
                      PIN_(PT_DLAM, const float*) + (size_t)(l - 2) * 256, PIN_(PT_DSG, const float*) + (size_t)(l - 2) * 128, (l == 2) ? p.linit2 : p.linit3);
            GSYNC();
        }
        {
            unsigned char* wsb = WSP(unsigned char*, 0);
            pg8::Gemm g{(const bf16_t*)(wsb + WS_R + (l < 2 ? 64 * MiB : 32 * MiB)), (const bf16_t*)(wsb + WS_W) + (l < 2 ? WO_RET_OUT : WO_DF_O), MTOK, 1024, (l < 2) ? 2048 : 1024};
            pg8::StaticOrder S; S.init(MTOK, 1024, G, bx);
            pg8::EpiF32 E{(float*)(wsb + WS_Y), 1024};
            for (int rep = 0; rep < REP_GEMM; ++rep) pg8::gemm_phase<pg8::EpiF32, pg8::StaticOrder, true, true>(lds, g, S, E);
        }
        if (l < 2) gemv8(lds, WSP(const float*, WS_GATED0), 2048, PIN_(PT_RWOUT, const float*) + (size_t)l * 2048 * 1024, 1024, WSP(float*, WS_Y0S), 0);
        GSYNC();
        {
            const float* ng = PIN_(PT_NORMG, const float*) + (size_t)l * 4 * 1024; const float* modl = WSP(const float*, WS_MOD) + (size_t)l * 8 * 6144;
            float* outp = PIN_(PT_OUT, float*);
            row_phase((l == 0) ? PIN_(PT_X, const float*) : (const float*)outp, outp, WSP(const float*, WS_Y), ng + 1024, modl + 2048, 6144, 1, ng + 2048, modl + 4096, modl + 3072, 6144, WSP(bf16_t*, WS_H),
                      nullptr, nullptr, nullptr, 0, nullptr, (l < 2) ? WSP(const float*, WS_Y0S) : nullptr, (l < 2) ? WSP(float*, WS_H0S) : nullptr);
        }
        GSYNC();
        {
            unsigned char* wsb = WSP(unsigned char*, 0);
            pg8::Gemm g{(const bf16_t*)(wsb + WS_H), (const bf16_t*)(wsb + WS_W) + (l < 2 ? WO_RET_W1 : WO_DF_W1), MTOK, 4096, 1024}; pg8::StaticOrder S; S.init(MTOK, 4096, G, bx);
            pg8::EpiRelu2 E{(bf16_t*)(wsb + WS_R), 4096};
            for (int rep = 0; rep < REP_GEMM; ++rep) pg8::gemm_phase<pg8::EpiRelu2, pg8::StaticOrder, true, true>(lds, g, S, E);
        }
        if (l < 2) gemv8(lds, WSP(const float*, WS_H0S), 1024, PIN_(PT_W1, const float*) + (size_t)l * 1024 * 4096, 4096, WSP(float*, WS_U0S), 1);
        GSYNC();
        {
            unsigned char* wsb = WSP(unsigned char*, 0);
            pg8::Gemm g{(const bf16_t*)(wsb + WS_R), (const bf16_t*)(wsb + WS_W) + (l < 2 ? WO_RET_W2 : WO_DF_W2), MTOK, 1024, 4096}; pg8::StaticOrder S; S.init(MTOK, 1024, G, bx);
            pg8::EpiF32 E{(float*)(wsb + WS_Y), 1024};
            for (int rep = 0; rep < REP_GEMM; ++rep) pg8::gemm_phase<pg8::EpiF32, pg8::StaticOrder, true, true>(lds, g, S, E);
        }
        if (l < 2) gemv8(lds, WSP(const float*, WS_U0S), 4096, PIN_(PT_W2, const float*) + (size_t)l * 4096 * 1024, 1024, WSP(float*, WS_Y0S), 0);
        GSYNC();
        {
            const float* ng = PIN_(PT_NORMG, const float*) + (size_t)l * 4 * 1024; const float* mod = WSP(const float*, WS_MOD); const float* modl = mod + (size_t)l * 8 * 6144;
            float* outp = PIN_(PT_OUT, float*);
            if (l < 3) {
                const float* ngn = ng + 4 * 1024; const float* modn = modl + 8 * 6144; const float* kvmod = WSP(const float*, WS_KVMOD);
                row_phase(outp, outp, WSP(const float*, WS_Y), ng + 3072, modl + 5120, 6144, (l == 1) ? 2 : 1, ngn, modn + 1024, modn, 6144, WSP(bf16_t*, WS_H),
                          PIN_(PT_KVNG, const float*), kvmod + 1024, kvmod, 2048, WSP(bf16_t*, WS_R + 64 * MiB), (l < 2) ? WSP(const float*, WS_Y0S) : nullptr, (l == 0) ? WSP(float*, WS_H0S) : nullptr);
                __syncthreads();
                convert_layer(lds, l + 1);
                GSYNC();
            } else {
                row_phase(outp, outp, WSP(const float*, WS_Y), ng + 3072, modl + 5120, 6144, 0, nullptr, nullptr, nullptr, 0, nullptr, nullptr, nullptr, nullptr, 0, nullptr, nullptr, nullptr);
            }
        }
    }
}

extern "C" void kernel_launch(void* const* d_in, const int* in_sizes, int n_in, void* d_out, int out_size, void* d_ws, size_t ws_size, hipStream_t stream) {
    static int grid_blocks = 0;
    if (!grid_blocks) {
        int dev = 0, cus = 0, per_cu = 0;
        hipGetDevice(&dev);
        hipDeviceGetAttribute(&cus, hipDeviceAttributeMultiprocessorCount, dev);
        hipFuncSetAttribute((const void*)yoco_fwd, hipFuncAttributeMaxDynamicSharedMemorySize, LDS_BYTES);
        if (hipOccupancyMaxActiveBlocksPerMultiprocessor(&per_cu, (const void*)yoco_fwd, 512, LDS_BYTES) != hipSuccess || per_cu < 1) per_cu = 1;
        (void)hipGetLastError();
        if (cus < 1) cus = 256;
        grid_blocks = cus * per_cu;
    }
    Params p{};
    p.x = (const float*)d_in[0]; p.c = (const float*)d_in[1]; p.pos = (const int*)d_in[2];
    p.norm_g = (const float*)d_in[3]; p.ada_w = (const float*)d_in[4]; p.ada_b = (const float*)d_in[5];
    p.ret_w_in = (const float*)d_in[6]; p.ret_w_out = (const float*)d_in[7]; p.kv_norm_g = (const float*)d_in[8];
    p.kv_ada_w = (const float*)d_in[9]; p.kv_ada_b = (const float*)d_in[10]; p.kv_w = (const float*)d_in[11];
    p.diff_w_q = (const float*)d_in[12]; p.diff_w_o = (const float*)d_in[13]; p.diff_lam = (const float*)d_in[14];
    p.diff_subln_g = (const float*)d_in[15]; p.mlp_w1 = (const float*)d_in[16]; p.mlp_w2 = (const float*)d_in[17];
    p.out = (float*)d_out; p.ws = (unsigned char*)d_ws;
    p.linit2 = (float)(0.8 - 0.6 * exp(-0.3 * 2.0)); p.linit3 = (float)(0.8 - 0.6 * exp(-0.3 * 3.0));
    void* args[] = {&p};
    hipError_t e = hipLaunchCooperativeKernel((const void*)yoco_fwd, dim3(grid_blocks), dim3(512), args, LDS_BYTES, stream);
    if (e != hipSuccess) fprintf(stderr, "cooperative launch failed: %s (grid %d)\n", hipGetErrorString(e), grid_blocks);
}
```

```cpp
#include <hip/hip_runtime.h>
#include <hip/hip_cooperative_groups.h>
#include <cstdio>
#include <cstdint>
#include <cmath>
namespace cg = cooperative_groups;

#define LAS __attribute__((address_space(3)))
typedef unsigned short bf16_t;
typedef short bf16x8 __attribute__((ext_vector_type(8)));
typedef float f32x4 __attribute__((ext_vector_type(4)));
typedef float f32x16 __attribute__((ext_vector_type(16)));
typedef unsigned u32x4 __attribute__((ext_vector_type(4)));
typedef unsigned u32x2 __attribute__((ext_vector_type(2)));
typedef float f32x2_t __attribute__((ext_vector_type(2)));
typedef __bf16 bf16x2_t __attribute__((ext_vector_type(2)));

__device__ __forceinline__ unsigned pk2(float lo, float hi) { f32x2_t v = {lo, hi}; bf16x2_t b = __builtin_convertvector(v, bf16x2_t); return __builtin_bit_cast(unsigned, b); }
__device__ __forceinline__ bf16_t f2bf(float x) { return (bf16_t)(pk2(x, 0.f) & 0xffffu); }
__device__ __forceinline__ u32x4 pk8(f32x4 a, f32x4 b) { u32x4 w; w.x = pk2(a[0], a[1]); w.y = pk2(a[2], a[3]); w.z = pk2(b[0], b[1]); w.w = pk2(b[2], b[3]); return w; }
__device__ __forceinline__ float bf2f(unsigned short h) { return __uint_as_float(((unsigned)h) << 16); }

constexpr int DM = 1024, NB = 8, SEQ = 2048, MTOK = NB * SEQ, DFF = 4096;
constexpr float EPS = 1e-6f;
constexpr size_t MiB = 1u << 20;
constexpr size_t WS_MOD = 0, WS_KVMOD = 1 * MiB, WS_RCOS = 2 * MiB, WS_RSIN = 10 * MiB, WS_DCOS = 18 * MiB, WS_DSIN = 19 * MiB;
constexpr size_t WS_W = 20 * MiB;
constexpr size_t WS_H = 52 * MiB;
constexpr size_t WS_A = 84 * MiB;
constexpr size_t WS_B = 116 * MiB;
constexpr size_t WS_R = 148 * MiB;
constexpr size_t WS_KZT = 276 * MiB;
constexpr size_t WS_VT = 308 * MiB;
constexpr size_t WS_Y = 276 * MiB;
constexpr size_t WO_RET_IN = 0, WO_RET_OUT = 6291456, WO_RET_W1 = 8388608, WO_RET_W2 = 12582912;
constexpr size_t WO_DF_Q = 0, WO_DF_O = 1048576, WO_DF_W1 = 2097152, WO_DF_W2 = 6291456, WO_DF_KV = 10485760;

namespace pg8 {
#define PG8_LAS __attribute__((address_space(3)))
constexpr int BM = 256, BK = 64, HALF = 128, HTB = HALF * BK * 2, STAGE_BYTES = 8 * HTB, NXCD = 8, WGM = 8;
__host__ __device__ __forceinline__ int lds_byte(int r, int c) { const int st = (r >> 4) * 2 + (c >> 5), rr = r & 15, cc = c & 31, ob = rr * 64 + cc * 2; return st * 1024 + (ob ^ (((ob >> 9) & 1) << 5)); }
__host__ __device__ __forceinline__ void stage_rc(int b, int& R, int& C) { const int st = b / 1024, sb = b % 1024, swz = sb ^ (((sb >> 9) & 1) << 5); R = (st >> 1) * 16 + swz / 64; C = (st & 1) * 32 + (swz % 64) / 2; }
__host__ __device__ __forceinline__ int perm32(int rho) { const int n = rho >> 4, i = rho & 15; return 8 * (i >> 2) + 4 * n + (i & 3); }
struct Unit { int pm, pn; };
struct Gemm { const bf16_t* A; const bf16_t* Bt; int M, N, K; };
struct StaticOrder {
    int nM, nN, nwg, G, c;
    __host__ __device__ void init(int M, int N, int G_, int c_) { nM = M / BM; nN = N / BM; nwg = nM * nN; G = G_; c = c_; }
    __host__ __device__ bool next(int i, Unit& u) const {
        const long L = (long)i * G + c; if (L >= nwg) return false;
        int wgid = (int)L; { const int q = nwg / NXCD, r = nwg % NXCD, xcd = wgid % NXCD, off = wgid / NXCD; wgid = (xcd < r ? xcd * (q + 1) : r * (q + 1) + (xcd - r) * q) + off; }
        const int nig = WGM * nN, gid = wgid / nig, fm = gid * WGM, gsz = (nM - fm) < WGM ? (nM - fm) : WGM;
        u.pm = fm + ((wgid % nig) % gsz); u.pn = (wgid % nig) / gsz; return true;
    }
    __device__ __forceinline__ void a_ready(const Unit&) const {}
    __device__ __forceinline__ void done(const Unit&) const {}
};

struct EpiF32 {
    static constexpr bool PERM = false, AFTER_DRAIN = false;
    float* Y; int ldc;
    __device__ __forceinline__ void operator()(const f32x4 (&acc)[2][2][4][2], const Unit& u, int wr, int wc, int fr, int fq) const {
        int row0 = u.pm * BM + wr * 64 + fr, col0 = u.pn * BM + wc * 32 + 4 * fq;
        asm volatile("" : "+v"(row0), "+v"(col0));
#pragma unroll
        for (int ai = 0; ai < 2; ++ai)
#pragma unroll
            for (int m = 0; m < 4; ++m) { float* rp = Y + (size_t)(row0 + ai * HALF + m * 16) * ldc + col0;
#pragma unroll
                for (int bj = 0; bj < 2; ++bj)
#pragma unroll
                    for (int n = 0; n < 2; ++n) *(f32x4*)(rp + bj * HALF + n * 16) = acc[ai][bj][m][n]; }
    }
};
struct EpiRelu2 {
    static constexpr bool PERM = true, AFTER_DRAIN = false;
    bf16_t* O; int ldc;
    __device__ __forceinline__ void operator()(const f32x4 (&acc)[2][2][4][2], const Unit& u, int wr, int wc, int fr, int fq) const {
        const int row0 = u.pm * BM + wr * 64 + fr, col0 = u.pn * BM + wc * 32 + 8 * fq;
#pragma unroll
        for (int ai = 0; ai < 2; ++ai)
#pragma unroll
            for (int m = 0; m < 4; ++m) { bf16_t* rp = O + (size_t)(row0 + ai * HALF + m * 16) * ldc + col0;
#pragma unroll
                for (int bj = 0; bj < 2; ++bj) { f32x4 v0 = acc[ai][bj][m][0], v1 = acc[ai][bj][m][1];
#pragma unroll
                    for (int i = 0; i < 4; ++i) { float a = fmaxf(v0[i], 0.f), b = fmaxf(v1[i], 0.f); v0[i] = a * a; v1[i] = b * b; }
                    *(u32x4*)(rp + bj * HALF) = pk8(v0, v1); } }
    }
};
struct EpiRetProj {
    static constexpr bool PERM = true, AFTER_DRAIN = false;
    bf16_t *q, *k, *kzT, *vT, *g; const float *rcos, *rsin;
    __device__ __forceinline__ void operator()(const f32x4 (&acc)[2][2][4][2], const Unit& u, int wr, int wc, int fr, int fq) const {
        const int pn = u.pn, rbase = u.pm * BM + wr * 64 + fr, cl = wc * 32 + 8 * fq;
        if (pn < 8) {
            const int head = pn & 3; const bool isk = pn >= 4;
            const float lg = __log2f(1.0f - exp2f(-5.0f - (float)head));
            bf16_t* dst = isk ? k : q; const float sc = isk ? 0.0625f : 1.0f;
#pragma unroll
            for (int ai = 0; ai < 2; ++ai)
#pragma unroll
                for (int m = 0; m < 4; ++m) {
                    const int row = rbase + ai * HALF + m * 16;
                    const f32x4 c0 = *(const f32x4*)(rcos + (size_t)row * 128 + cl), c1 = *(const f32x4*)(rcos + (size_t)row * 128 + cl + 4);
                    const f32x4 s0 = *(const f32x4*)(rsin + (size_t)row * 128 + cl), s1 = *(const f32x4*)(rsin + (size_t)row * 128 + cl + 4);
                    const f32x4 a0 = acc[ai][0][m][0], a1 = acc[ai][0][m][1], b0 = acc[ai][1][m][0], b1 = acc[ai][1][m][1];
                    f32x4 o10 = (a0 * c0 - b0 * s0) * sc, o11 = (a1 * c1 - b1 * s1) * sc, o20 = (b0 * c0 + a0 * s0) * sc, o21 = (b1 * c1 + a1 * s1) * sc;
                    bf16_t* rp = dst + (size_t)row * 1024 + head * 256 + cl;
                    *(u32x4*)(rp) = pk8(o10, o11); *(u32x4*)(rp + 128) = pk8(o20, o21);
                    if (isk) {
                        const float zeta = exp2f((float)(127 - (row & 127)) * lg);
                        bf16_t* tb = kzT + ((size_t)((row >> 11) * 4 + head) * 256 + cl) * 2048 + (row & 2047);
#pragma unroll
                        for (int i = 0; i < 4; ++i) { tb[(size_t)i * 2048] = f2bf(o10[i] * zeta); tb[(size_t)(4 + i) * 2048] = f2bf(o11[i] * zeta);
                                                      tb[(size_t)(128 + i) * 2048] = f2bf(o20[i] * zeta); tb[(size_t)(132 + i) * 2048] = f2bf(o21[i] * zeta); }
                    }
                }
        } else if (pn < 16) {
            const int head = (pn - 8) >> 1, e0 = ((pn - 8) & 1) * 256 + cl;
#pragma unroll
            for (int ai = 0; ai < 2; ++ai)
#pragma unroll
                for (int m = 0; m < 4; ++m) {
                    const int row = rbase + ai * HALF + m * 16;
                    bf16_t* tb = vT + ((size_t)((row >> 11) * 4 + head) * 512 + e0) * 2048 + (row & 2047);
#pragma unroll
                    for (int bj = 0; bj < 2; ++bj)
#pragma unroll
                        for (int n = 0; n < 2; ++n)
#pragma unroll
                            for (int i = 0; i < 4; ++i) tb[(size_t)(bj * 128 + 4 * n + i) * 2048] = f2bf(acc[ai][bj][m][n][i]);
                }
        } else {
            const int col0 = (pn - 16) * 256 + cl;
#pragma unroll
            for (int ai = 0; ai < 2; ++ai)
#pragma unroll
                for (int m = 0; m < 4; ++m) { bf16_t* rp = g + (size_t)(rbase + ai * HALF + m * 16) * 2048 + col0;
#pragma unroll
                    for (int bj = 0; bj < 2; ++bj) *(u32x4*)(rp + bj * HALF) = pk8(acc[ai][bj][m][0], acc[ai][bj][m][1]); }
        }
    }
};
template <bool KV> struct EpiRope64 {
    static constexpr bool PERM = true, AFTER_DRAIN = false;
    bf16_t* dst; bf16_t* vT; const float *dcos, *dsin; float scale;
    __device__ __forceinline__ void operator()(const f32x4 (&acc)[2][2][4][2], const Unit& u, int wr, int wc, int fr, int fq) const {
        const int pn = u.pn, rbase = u.pm * BM + wr * 64 + fr, cl = wc * 32 + 8 * fq;
        if (!KV || pn < 4) {
            const bool dorope = ((wc & 1) == 0) && (fq < 2);
#pragma unroll
            for (int ai = 0; ai < 2; ++ai)
#pragma unroll
                for (int m = 0; m < 4; ++m) {
                    const int row = rbase + ai * HALF + m * 16;
                    const f32x4 c0 = *(const f32x4*)(dcos + (size_t)row * 8), c1 = *(const f32x4*)(dcos + (size_t)row * 8 + 4);
                    const f32x4 s0 = *(const f32x4*)(dsin + (size_t)row * 8), s1 = *(const f32x4*)(dsin + (size_t)row * 8 + 4);
                    bf16_t* rp = dst + (size_t)row * 1024 + pn * 256 + cl;
#pragma unroll
                    for (int bj = 0; bj < 2; ++bj) {
                        f32x4 v[2];
#pragma unroll
                        for (int n = 0; n < 2; ++n) {
                            const f32x4 x = acc[ai][bj][m][n]; f32x4 oth;
#pragma unroll
                            for (int i = 0; i < 4; ++i) oth[i] = __shfl_xor(x[i], 16);
                            const f32x4 cs = n ? c1 : c0, sn = n ? s1 : s0;
                            const f32x4 rot = (fq == 0) ? (x * cs - oth * sn) : (x * cs + oth * sn);
                            v[n] = (dorope ? rot : x) * scale;
                        }
                        *(u32x4*)(rp + bj * HALF) = pk8(v[0], v[1]);
                    }
                }
        } else {
#pragma unroll
            for (int ai = 0; ai < 2; ++ai)
#pragma unroll
                for (int m = 0; m < 4; ++m) {
                    const int row = rbase + ai * HALF + m * 16;
#pragma unroll
                    for (int bj = 0; bj < 2; ++bj) {
                        const int H = 2 * (pn - 4) + bj;
                        bf16_t* tb = vT + ((size_t)((row >> 11) * 8 + H) * 128 + cl) * 2048 + (row & 2047);
#pragma unroll
                        for (int n = 0; n < 2; ++n)
#pragma unroll
                            for (int i = 0; i < 4; ++i) tb[(size_t)(4 * n + i) * 2048] = f2bf(acc[ai][bj][m][n][i]);
                    }
                }
        }
    }
};

template <class Epi, class Sched, bool ALIGN_EPI = false, bool SP2 = false>
__device__ __forceinline__ void gemm_phase(PG8_LAS unsigned char* lds, const Gemm g, const Sched& S, const Epi& E) {
    int tid_o = threadIdx.x; asm volatile("" : "+v"(tid_o));
    const int tid = tid_o, wid = __builtin_amdgcn_readfirstlane(tid >> 6), lane = tid & 63, wr = wid >> 2, wc = wid & 3, fr = lane & 15, fq = lane >> 4;
    const int K = g.K, nt = K / BK;
    unsigned voffA[2], voffB[2];
#pragma unroll
    for (int i = 0; i < 2; ++i) { int R, C; stage_rc(tid * 16 + i * 8192, R, C); const int Rb = Epi::PERM ? ((R & ~31) + perm32(R & 31)) : R;
        voffA[i] = (unsigned)(R * K + C) * 2u; voffB[i] = (unsigned)(Rb * K + C) * 2u; }
    const size_t kstep = (size_t)(BK * 2);
    const size_t hstep = (size_t)HALF * K * 2;
    const size_t tstep = 2 * hstep;
    const unsigned ldsw = (unsigned)wid * 1024u;
    const int aoff = lds_byte(wr * 64 + fr, fq * 8), boff = lds_byte(wc * 32 + fr, fq * 8);
#define PG8_SA(b, h) (((b) * 2 + (h)) * HTB)
#define PG8_SB(b, h) ((4 + (b) * 2 + (h)) * HTB)
#define PG8_STAGE(bufoff, gbase, voff) do { _Pragma("unroll") for (int _i = 0; _i < 2; ++_i) \
        __builtin_amdgcn_global_load_lds((const unsigned*)((const char*)(gbase) + (voff)[_i]), (PG8_LAS unsigned*)(lds + (bufoff) + ldsw + _i * 8192), 16, 0, 0); } while (0)
#define PG8_LDA(dst, b, h) do { _Pragma("unroll") for (int m = 0; m < 4; ++m) _Pragma("unroll") for (int k = 0; k < 2; ++k) dst[m][k] = *(const PG8_LAS bf16x8*)(lds + PG8_SA(b, h) + aoff + m * 2048 + k * 1024); } while (0)
#define PG8_LDB(dst, b, h) do { _Pragma("unroll") for (int n = 0; n < 2; ++n) _Pragma("unroll") for (int k = 0; k < 2; ++k) dst[n][k] = *(const PG8_LAS bf16x8*)(lds + PG8_SB(b, h) + boff + n * 2048 + k * 1024); } while (0)
#define PG8_MMA(ai, bj, At, Bt) do { __builtin_amdgcn_s_setprio(1); _Pragma("unroll") for (int m = 0; m < 4; ++m) _Pragma("unroll") for (int n = 0; n < 2; ++n) _Pragma("unroll") for (int k = 0; k < 2; ++k) \
        acc[ai][bj][m][n] = __builtin_amdgcn_mfma_f32_16x16x32_bf16(Bt[n][k], At[m][k], acc[ai][bj][m][n], 0, 0, 0); __builtin_amdgcn_s_setprio(0); } while (0)
#define PG8_WAIT_V(n) asm volatile("s_waitcnt vmcnt(" #n ")" ::: "memory")
#define PG8_WAIT_L(n) asm volatile("s_waitcnt lgkmcnt(" #n ")" ::: "memory")
#define PG8_BAR __builtin_amdgcn_s_barrier()
#define PG8_SCHED __builtin_amdgcn_sched_barrier(0)
    Unit cur, nxt; int ui = 0;
    if (!S.next(0, cur)) return;
    f32x4 acc[2][2][4][2];
#pragma unroll
    for (int a = 0; a < 2; ++a)
#pragma unroll
        for (int b = 0; b < 2; ++b)
#pragma unroll
            for (int m = 0; m < 4; ++m)
#pragma unroll
                for (int n = 0; n < 2; ++n) acc[a][b][m][n] = (f32x4){0.f, 0.f, 0.f, 0.f};
    bf16x8 At[4][2], B0[2][2], B1[2][2];
    const char* cA = (const char*)g.A + (size_t)cur.pm * tstep; const char* cB = (const char*)g.Bt + (size_t)cur.pn * tstep;
    S.a_ready(cur);
    if constexpr (SP2) {
        PG8_STAGE(PG8_SB(0, 0), cB, voffB); PG8_STAGE(PG8_SB(0, 1), cB + hstep, voffB); PG8_STAGE(PG8_SA(0, 0), cA, voffA); PG8_STAGE(PG8_SA(0, 1), cA + hstep, voffA);
        if (wr == 1) PG8_BAR;
        PG8_WAIT_V(2); PG8_BAR;
        PG8_STAGE(PG8_SB(1, 0), cB + kstep, voffB); PG8_STAGE(PG8_SA(1, 0), cA + kstep, voffA); PG8_STAGE(PG8_SB(1, 1), cB + hstep + kstep, voffB);
        PG8_WAIT_V(6); PG8_BAR;
    } else {
        PG8_STAGE(PG8_SB(0, 0), cB, voffB); PG8_STAGE(PG8_SA(0, 0), cA, voffA); PG8_STAGE(PG8_SB(0, 1), cB + hstep, voffB); PG8_STAGE(PG8_SA(0, 1), cA + hstep, voffA);
        if (wr == 1) PG8_BAR;
        PG8_WAIT_V(4); PG8_BAR;
        PG8_STAGE(PG8_SB(1, 0), cB + kstep, voffB); PG8_STAGE(PG8_SA(1, 0), cA + kstep, voffA); PG8_STAGE(PG8_SB(1, 1), cB + hstep + kstep, voffB);
        PG8_WAIT_V(6); PG8_BAR;
    }
    for (;;) {
        const bool has_next = S.next(ui + 1, nxt);
        const char* nA = has_next ? (const char*)g.A + (size_t)nxt.pm * tstep : cA; const char* nB = has_next ? (const char*)g.Bt + (size_t)nxt.pn * tstep : cB;
        for (int t = 0; t < nt; t += 2) {
            const bool last = (t == nt - 2);
            const char* a1 = cA + (size_t)(t + 1) * kstep;
            const char* a2 = last ? nA : cA + (size_t)(t + 2) * kstep; const char* b2 = last ? nB : cB + (size_t)(t + 2) * kstep;
            const char* a3 = a2 + kstep; const char* b3 = b2 + kstep;
            if (last && has_next) S.a_ready(nxt);
            if constexpr (SP2) {
            PG8_LDB(B0, 0, 0); PG8_LDB(B1, 0, 1); PG8_SCHED; PG8_LDA(At, 0, 0); PG8_STAGE(PG8_SA(1, 1), a1 + hstep, voffA);
            PG8_WAIT_V(8); PG8_WAIT_L(0); PG8_BAR; PG8_MMA(0, 0, At, B0); PG8_MMA(0, 1, At, B1); PG8_BAR; PG8_SCHED;
            PG8_LDA(At, 0, 1); PG8_STAGE(PG8_SB(0, 0), b2, voffB); PG8_STAGE(PG8_SB(0, 1), b2 + hstep, voffB); PG8_STAGE(PG8_SA(0, 0), a2, voffA);
            PG8_WAIT_V(8); PG8_WAIT_L(0); PG8_BAR; PG8_MMA(1, 0, At, B0); PG8_MMA(1, 1, At, B1); PG8_BAR; PG8_SCHED;
            PG8_LDB(B0, 1, 0); PG8_LDB(B1, 1, 1); PG8_SCHED; PG8_LDA(At, 1, 0); PG8_STAGE(PG8_SA(0, 1), a2 + hstep, voffA);
            PG8_WAIT_V(8); PG8_WAIT_L(0); PG8_BAR; PG8_MMA(0, 0, At, B0); PG8_MMA(0, 1, At, B1); PG8_BAR; PG8_SCHED;
            PG8_LDA(At, 1, 1); PG8_STAGE(PG8_SB(1, 0), b3, voffB); PG8_STAGE(PG8_SB(1, 1), b3 + hstep, voffB); PG8_STAGE(PG8_SA(1, 0), a3, voffA);
            PG8_WAIT_V(8); PG8_WAIT_L(0); PG8_BAR; PG8_MMA(1, 0, At, B0); PG8_MMA(1, 1, At, B1); PG8_BAR; PG8_SCHED;
            } else {
            PG8_LDB(B0, 0, 0); PG8_SCHED; PG8_LDA(At, 0, 0); PG8_STAGE(PG8_SA(1, 1), a1 + hstep, voffA);
            PG8_WAIT_L(8); PG8_BAR; PG8_WAIT_L(0); PG8_MMA(0, 0, At, B0); PG8_BAR; PG8_SCHED;
            PG8_LDB(B1, 0, 1); PG8_STAGE(PG8_SB(0, 0), b2, voffB);
            PG8_BAR; PG8_WAIT_L(0); PG8_MMA(0, 1, At, B1); PG8_BAR;
            PG8_LDA(At, 0, 1); PG8_STAGE(PG8_SA(0, 0), a2, voffA);
            PG8_BAR; PG8_WAIT_L(0); PG8_MMA(1, 0, At, B0); PG8_BAR; PG8_SCHED;
            PG8_STAGE(PG8_SB(0, 1), b2 + hstep, voffB);
            PG8_WAIT_V(6); PG8_BAR; PG8_MMA(1, 1, At, B1); PG8_BAR;
            PG8_LDB(B0, 1, 0); PG8_SCHED; PG8_LDA(At, 1, 0); PG8_STAGE(PG8_SA(0, 1), a2 + hstep, voffA);
            PG8_WAIT_L(8); PG8_BAR; PG8_WAIT_L(0); PG8_MMA(0, 0, At, B0); PG8_BAR; PG8_SCHED;
            PG8_LDB(B1, 1, 1); PG8_STAGE(PG8_SB(1, 0), b3, voffB);
            PG8_BAR; PG8_WAIT_L(0); PG8_MMA(0, 1, At, B1); PG8_BAR;
            PG8_LDA(At, 1, 1); PG8_STAGE(PG8_SA(1, 0), a3, voffA);
            PG8_BAR; PG8_WAIT_L(0); PG8_MMA(1, 0, At, B0); PG8_BAR; PG8_SCHED;
            PG8_STAGE(PG8_SB(1, 1), b3 + hstep, voffB);
            PG8_WAIT_V(6); PG8_BAR; PG8_MMA(1, 1, At, B1); PG8_BAR;
            }
        }
        if constexpr (ALIGN_EPI) { if (wr == 0) PG8_BAR; }
        if constexpr (!Epi::AFTER_DRAIN) { E(acc, cur, wr, wc, fr, fq); S.done(cur); }
        if (!has_next) break;
#pragma unroll
        for (int a = 0; a < 2; ++a)
#pragma unroll
            for (int b = 0; b < 2; ++b)
#pragma unroll
                for (int m = 0; m < 4; ++m)
#pragma unroll
                    for (int n = 0; n < 2; ++n) acc[a][b][m][n] = (f32x4){0.f, 0.f, 0.f, 0.f};
        cur = nxt; cA = nA; cB = nB; ++ui;
        if constexpr (ALIGN_EPI) { if (wr == 1) PG8_BAR; }
    }
    PG8_WAIT_V(0);
    if constexpr (!ALIGN_EPI) { if (wr == 0) PG8_BAR; }
    PG8_BAR;
    if constexpr (Epi::AFTER_DRAIN) { E.fused(acc, cur, wr, wc, fr, fq, lds, wid, lane); S.done(cur); }
#undef PG8_SA
#undef PG8_SB
#undef PG8_STAGE
#undef PG8_LDA
#undef PG8_LDB
#undef PG8_MMA
#undef PG8_WAIT_V
#undef PG8_WAIT_L
#undef PG8_BAR
#undef PG8_SCHED
}
}

__device__ __forceinline__ int opq_tid() { int t = threadIdx.x; asm volatile("" : "+v"(t)); return t; }
#define MFMA32(a, b, c) __builtin_amdgcn_mfma_f32_32x32x16_bf16((a), (b), (c), 0, 0, 0)
__device__ __forceinline__ int crow(int r, int hi) { return (r & 3) + 8 * (r >> 2) + 4 * hi; }
__device__ __forceinline__ float wave_sum(float v) {
#pragma unroll
    for (int o = 1; o < 64; o <<= 1) v += __shfl_xor(v, o);
    return v;
}
__device__ __forceinline__ f32x16 zero16() { f32x16 z;
#pragma unroll
    for (int i = 0; i < 16; ++i) z[i] = 0.f;
    return z; }

__device__ __forceinline__ void p0_mod_gemv(LAS unsigned char* lds, const float* c, const float* ada_w, const float* ada_b, const float* kv_ada_w, const float* kv_ada_b, float* mod, float* kvmod) {
    LAS float* cact = (LAS float*)lds;
    LAS float* red = (LAS float*)(lds + 32768);
    const int tid = opq_tid();
    for (int i = tid; i < 8192; i += 512) { const float v = c[i]; cact[i] = v / (1.0f + expf(-v)); }
    __syncthreads();
    const int cg4 = tid & 15, kg = tid >> 4;
    for (int u = blockIdx.x; u < 416; u += gridDim.x) {
        const float* W; const float* bias; float* out; int N, cb;
        if (u < 384) { const int l = u / 96; cb = (u % 96) * 64; W = ada_w + (size_t)l * 1024 * 6144; N = 6144; bias = ada_b + l * 6144; out = mod + (size_t)l * 8 * 6144; }
        else { cb = (u - 384) * 64; W = kv_ada_w; N = 2048; bias = kv_ada_b; out = kvmod; }
        f32x4 acc[8];
#pragma unroll
        for (int b = 0; b < 8; ++b) acc[b] = (f32x4){0.f, 0.f, 0.f, 0.f};
        const float* wp = W + (size_t)(kg * 32) * N + cb + 4 * cg4;
#pragma unroll 8
        for (int kk = 0; kk < 32; ++kk) {
            const f32x4 w = *(const f32x4*)(wp + (size_t)kk * N);
#pragma unroll
            for (int b = 0; b < 8; ++b) acc[b] += w * cact[b * 1024 + kg * 32 + kk];
        }
#pragma unroll
        for (int b = 0; b < 8; ++b) *(LAS f32x4*)(red + (kg * 8 + b) * 64 + 4 * cg4) = acc[b];
        __syncthreads();
        { const int b = tid >> 6, col = tid & 63; float s = bias[cb + col];
#pragma unroll 8
          for (int g = 0; g < 32; ++g) s += red[(g * 8 + b) * 64 + col];
          out[(size_t)b * N + cb + col] = s; }
        __syncthreads();
    }
}


__device__ __forceinline__ void gemv8(LAS unsigned char* lds, const float* in, int K, const float* W, int N, float* out, int act) {
    LAS float* cact = (LAS float*)lds;
    LAS float* red = (LAS float*)(lds + 32768);
    const int tid = opq_tid();
    const int cg4 = tid & 15, kg = tid >> 4;
    for (int u = blockIdx.x; u < N / 64; u += gridDim.x) {
        f32x4 acc[8];
#pragma unroll
        for (int b = 0; b < 8; ++b) acc[b] = (f32x4){0.f, 0.f, 0.f, 0.f};
        for (int kc = 0; kc < K; kc += 1024) {
            __syncthreads();
            for (int i = tid; i < 8192; i += 512) cact[i] = in[(size_t)(i >> 10) * K + kc + (i & 1023)];
            __syncthreads();
            const float* wp = W + (size_t)(kc + kg * 32) * N + u * 64 + 4 * cg4;
#pragma unroll 8
            for (int kk = 0; kk < 32; ++kk) {
                const f32x4 w = *(const f32x4*)(wp + (size_t)kk * N);
#pragma unroll
                for (int b = 0; b < 8; ++b) acc[b] += w * cact[b * 1024 + kg * 32 + kk];
            }
        }
#pragma unroll
        for (int b = 0; b < 8; ++b) *(LAS f32x4*)(red + (kg * 8 + b) * 64 + 4 * cg4) = acc[b];
        __syncthreads();
        { const int b = tid >> 6, col = tid & 63; float s = 0.f;
#pragma unroll 8
          for (int g = 0; g < 32; ++g) s += red[(g * 8 + b) * 64 + col];
          if (act == 1) { s = fmaxf(s, 0.f); s = s * s; }
          out[(size_t)b * N + u * 64 + col] = s; }
        __syncthreads();
    }
}

__device__ __forceinline__ void transpose_item(const float* W, int K, int N, bf16_t* WT, LAS float* scr, int item, int lane) {
    const int nblk = N / 32, kb = item / nblk, nb = item % nblk, k0 = 64 * kb, n0 = 32 * nb;
#pragma unroll 8
    for (int i = 0; i < 32; ++i) { const int kk = 2 * i + (lane >> 5); scr[kk * 33 + (lane & 31)] = W[(size_t)(k0 + kk) * N + n0 + (lane & 31)]; }
    asm volatile("s_waitcnt lgkmcnt(0)" ::: "memory");
    const int c = lane & 7;
#pragma unroll
    for (int j = 0; j < 4; ++j) { const int n = (lane >> 3) + 8 * j; const LAS float* s = scr + (8 * c) * 33 + n;
        u32x4 o; o.x = pk2(s[0 * 33], s[1 * 33]); o.y = pk2(s[2 * 33], s[3 * 33]); o.z = pk2(s[4 * 33], s[5 * 33]); o.w = pk2(s[6 * 33], s[7 * 33]);
        *(u32x4*)(WT + (size_t)(n0 + n) * K + k0 + 8 * c) = o; }
    asm volatile("s_waitcnt lgkmcnt(0)" ::: "memory");
}
struct WSpec { const float* W; int K, N; size_t off; };
__device__ __forceinline__ void convert_weights(LAS unsigned char* lds, bf16_t* wbuf, const WSpec& a, const WSpec& b, const WSpec& c, const WSpec& d, const WSpec& e, int nmat) {
    const int tid = opq_tid(); const int lane = tid & 63, wave = tid >> 6;
    LAS float* scr = (LAS float*)(lds + wave * 16384);
    const int gw = blockIdx.x * 8 + wave, NGW = gridDim.x * 8;
    const int ia = (a.K / 64) * (a.N / 32), ib = (b.K / 64) * (b.N / 32), ic = (c.K / 64) * (c.N / 32), id = (d.K / 64) * (d.N / 32), ie = nmat > 4 ? (e.K / 64) * (e.N / 32) : 0;
    const int total = ia + ib + ic + id + ie;
    for (int it = gw; it < total; it += NGW) {
        int r = it;
        if (r < ia) { transpose_item(a.W, a.K, a.N, wbuf + a.off, scr, r, lane); continue; } r -= ia;
        if (r < ib) { transpose_item(b.W, b.K, b.N, wbuf + b.off, scr, r, lane); continue; } r -= ib;
        if (r < ic) { transpose_item(c.W, c.K, c.N, wbuf + c.off, scr, r, lane); continue; } r -= ic;
        if (r < id) { transpose_item(d.W, d.K, d.N, wbuf + d.off, scr, r, lane); continue; } r -= id;
        transpose_item(e.W, e.K, e.N, wbuf + e.off, scr, r, lane);
    }
}

__device__ __forceinline__ void rope_tables(const int* pos, float* rcos, float* rsin, float* dcos, float* dsin) {
    const int gt = blockIdx.x * 512 + opq_tid(), NT = gridDim.x * 512;
    for (int idx = gt; idx < MTOK * 128; idx += NT) {
        const int tok = idx >> 7, j = idx & 127;
        const float inv = (float)exp2(-(double)(2 * j) * (13.287712379549449 / 256.0));
        const float ang = (float)pos[tok] * inv;
        double rv = (double)ang * 0.15915494309189535; rv -= rint(rv);
        const float fr = (float)rv;
        rcos[idx] = __builtin_amdgcn_cosf(fr); rsin[idx] = __builtin_amdgcn_sinf(fr);
    }
    for (int idx = gt; idx < MTOK * 8; idx += NT) {
        const int tok = idx >> 3, j = idx & 7;
        const float inv = (float)exp2(-(double)(2 * j) * (18.931568569324174 / 16.0));
        const float ang = (float)pos[tok] * inv;
        double rv = (double)ang * 0.15915494309189535; rv -= rint(rv);
        const float fr = (float)rv;
        dcos[idx] = __builtin_amdgcn_cosf(fr); dsin[idx] = __builtin_amdgcn_sinf(fr);
    }
}

__device__ __forceinline__ void row_phase(const float* xin, float* xout, const float* y, const float* gy, const float* gate, int gate_bs,
                                          int nout, const float* g0, const float* sc0, const float* sh0, int bs0, bf16_t* d0,
                                          const float* g1, const float* sc1, const float* sh1, int bs1, bf16_t* d1, const float* ysh, float* h0s) {
    const int tid = opq_tid(); const int lane = tid & 63, gw = blockIdx.x * 8 + (tid >> 6), NGW = gridDim.x * 8;
    for (int row = gw; row < MTOK; row += NGW) {
        const int b = row >> 11;
        f32x4 xv[4];
#pragma unroll
        for (int j = 0; j < 4; ++j) xv[j] = *(const f32x4*)(xin + (size_t)row * 1024 + 4 * lane + 256 * j);
        if (y) {
            f32x4 yv[4]; float s = 0.f;
            const float* yrow = (ysh && (row & 2047) == 0) ? (ysh + (size_t)b * 1024) : (y + (size_t)row * 1024);
#pragma unroll
            for (int j = 0; j < 4; ++j) { yv[j] = *(const f32x4*)(yrow + 4 * lane + 256 * j); s += (yv[j][0] * yv[j][0] + yv[j][1] * yv[j][1]) + (yv[j][2] * yv[j][2] + yv[j][3] * yv[j][3]); }
            const float rstd = rsqrtf(wave_sum(s) * (1.0f / 1024.0f) + EPS);
#pragma unroll
            for (int j = 0; j < 4; ++j) { const int col = 4 * lane + 256 * j;
                const f32x4 gg = *(const f32x4*)(gy + col), ga = *(const f32x4*)(gate + (size_t)b * gate_bs + col);
                xv[j] += (ga + 1.0f) * (yv[j] * rstd * gg);
                *(f32x4*)(xout + (size_t)row * 1024 + col) = xv[j]; }
        }
        if (nout > 0) {
            float s = 0.f;
#pragma unroll
            for (int j = 0; j < 4; ++j) s += (xv[j][0] * xv[j][0] + xv[j][1] * xv[j][1]) + (xv[j][2] * xv[j][2] + xv[j][3] * xv[j][3]);
            const float rstd = rsqrtf(wave_sum(s) * (1.0f / 1024.0f) + EPS);
#pragma unroll
            for (int j = 0; j < 4; ++j) { const int col = 4 * lane + 256 * j;
                const f32x4 gg = *(const f32x4*)(g0 + col), sc = *(const f32x4*)(sc0 + (size_t)b * bs0 + col), sh = *(const f32x4*)(sh0 + (size_t)b * bs0 + col);
                const f32x4 h = (xv[j] * rstd * gg) * (sc + 1.0f) + sh;
                u32x2 w; w.x = pk2(h[0], h[1]); w.y = pk2(h[2], h[3]);
                *(u32x2*)(d0 + (size_t)row * 1024 + col) = w;
                if (h0s && (row & 2047) == 0) *(f32x4*)(h0s + (size_t)b * 1024 + col) = h; }
            if (nout > 1) {
#pragma unroll
                for (int j = 0; j < 4; ++j) { const int col = 4 * lane + 256 * j;
                    const f32x4 gg = *(const f32x4*)(g1 + col), sc = *(const f32x4*)(sc1 + (size_t)b * bs1 + col), sh = *(const f32x4*)(sh1 + (size_t)b * bs1 + col);
                    const f32x4 h = (xv[j] * rstd * gg) * (sc + 1.0f) + sh;
                    u32x2 w; w.x = pk2(h[0], h[1]); w.y = pk2(h[2], h[3]);
                    *(u32x2*)(d1 + (size_t)row * 1024 + col) = w; }
            }
        }
    }
}

__device__ __forceinline__ void gate_phase(bf16_t* o, const bf16_t* g, const float* proj0, float* gated0) {
    const int tid = opq_tid(); const int lane = tid & 63, gw = blockIdx.x * 8 + (tid >> 6), NGW = gridDim.x * 8;
    if (gw < 32) {
        const int b = gw >> 2, h = gw & 3; const float* pr = proj0 + (size_t)b * 6144;
        const f32x4 qv = *(const f32x4*)(pr + h * 256 + 4 * lane), kv = *(const f32x4*)(pr + 1024 + h * 256 + 4 * lane);
        const float s00 = wave_sum((qv[0] * kv[0] + qv[1] * kv[1]) + (qv[2] * kv[2] + qv[3] * kv[3])) * 0.0625f;
        const f32x4 v0 = *(const f32x4*)(pr + 2048 + h * 512 + 8 * lane), v1 = *(const f32x4*)(pr + 2048 + h * 512 + 8 * lane + 4);
        const f32x4 g0 = *(const f32x4*)(pr + 4096 + h * 512 + 8 * lane), g1 = *(const f32x4*)(pr + 4096 + h * 512 + 8 * lane + 4);
        const f32x4 o0 = v0 * s00, o1 = v1 * s00;
        const float ss = wave_sum((o0[0] * o0[0] + o0[1] * o0[1]) + (o0[2] * o0[2] + o0[3] * o0[3]) + (o1[0] * o1[0] + o1[1] * o1[1]) + (o1[2] * o1[2] + o1[3] * o1[3]));
        const float rstd = rsqrtf(ss * (1.0f / 512.0f) + EPS);
        f32x4 r0, r1;
#pragma unroll
        for (int i = 0; i < 4; ++i) { r0[i] = (g0[i] / (1.0f + expf(-g0[i]))) * (o0[i] * rstd); r1[i] = (g1[i] / (1.0f + expf(-g1[i]))) * (o1[i] * rstd); }
        *(f32x4*)(gated0 + (size_t)b * 2048 + h * 512 + 8 * lane) = r0; *(f32x4*)(gated0 + (size_t)b * 2048 + h * 512 + 8 * lane + 4) = r1;
    }
    for (int it = gw; it < MTOK * 4; it += NGW) {
        const size_t off = (size_t)it * 512 + 8 * lane;
        const u32x4 ov = *(const u32x4*)(o + off), gv = *(const u32x4*)(g + off);
        float of[8], gf[8];
#pragma unroll
        for (int i = 0; i < 4; ++i) { of[2 * i] = __uint_as_float(ov[i] << 16); of[2 * i + 1] = __uint_as_float(ov[i] & 0xffff0000u);
                                      gf[2 * i] = __uint_as_float(gv[i] << 16); gf[2 * i + 1] = __uint_as_float(gv[i] & 0xffff0000u); }
        float s = 0.f;
#pragma unroll
        for (int i = 0; i < 8; ++i) s += of[i] * of[i];
        const float rstd = rsqrtf(wave_sum(s) * (1.0f / 512.0f) + EPS);
        float r[8];
#pragma unroll
        for (int i = 0; i < 8; ++i) r[i] = (gf[i] / (1.0f + __expf(-gf[i]))) * (of[i] * rstd);
        u32x4 w; w.x = pk2(r[0], r[1]); w.y = pk2(r[2], r[3]); w.z = pk2(r[4], r[5]); w.w = pk2(r[6], r[7]);
        *(u32x4*)(o + off) = w;
    }
}

constexpr int P_LD = 136, R_LD = 264;
__device__ __forceinline__ void ret_scan(LAS unsigned char* lds, const bf16_t* q, const bf16_t* k, const bf16_t* kzT, const bf16_t* vT, bf16_t* o) {
    LAS bf16_t* Pl = (LAS bf16_t*)lds;
    LAS bf16_t* Rl = (LAS bf16_t*)(lds + 128 * P_LD * 2);
    const int tid = opq_tid(); const int lane = tid & 63, wid = __builtin_amdgcn_readfirstlane(tid >> 6), l31 = lane & 31, hi = lane >> 5;
    for (int unit = blockIdx.x; unit < 256; unit += gridDim.x) {
        const int b = unit >> 5, h = (unit >> 3) & 3, es = unit & 7;
        const float lg = __log2f(1.0f - exp2f(-5.0f - (float)h));
        const float decay = exp2f(128.0f * lg);
        f32x16 Rt[2]; Rt[0] = zero16(); Rt[1] = zero16();
        const bf16_t* vTb = vT + ((size_t)(b * 4 + h) * 512 + es * 64) * 2048;
        const bf16_t* kzb = kzT + ((size_t)(b * 4 + h) * 256 + 32 * wid + l31) * 2048;
        for (int n = 0; n < 16; ++n) {
            const int t0 = b * 2048 + n * 128;
#pragma unroll
            for (int eb = 0; eb < 2; ++eb)
#pragma unroll
                for (int r = 0; r < 16; ++r) Rl[(32 * eb + crow(r, hi)) * R_LD + 32 * wid + l31] = f2bf(Rt[eb][r]);
            {
                const int cb = wid >> 1;
                const bf16_t* qa = q + (size_t)(t0 + 32 * cb + l31) * 1024 + h * 256 + 8 * hi;
#pragma unroll
                for (int mt = 0; mt < 2; ++mt) {
                    const int mb = 2 * (wid & 1) + mt;
                    f32x16 acc = zero16();
                    if (mb <= cb) {
                        const bf16_t* kb = k + (size_t)(t0 + 32 * mb + l31) * 1024 + h * 256 + 8 * hi;
#pragma unroll
                        for (int ks = 0; ks < 16; ++ks) acc = MFMA32(*(const bf16x8*)(qa + 16 * ks), *(const bf16x8*)(kb + 16 * ks), acc);
                    }
#pragma unroll
                    for (int r = 0; r < 16; ++r) {
                        const int c = 32 * cb + crow(r, hi), m = 32 * mb + l31, df = c - m;
                        const float v = (df >= 0) ? acc[r] * exp2f((float)df * lg) : 0.f;
                        Pl[c * P_LD + m] = f2bf(v);
                    }
                }
            }
            __syncthreads();
            {
                const int cb = wid >> 1, eb = wid & 1;
                const bf16_t* qa = q + (size_t)(t0 + 32 * cb + l31) * 1024 + h * 256 + 8 * hi;
                f32x16 acc = zero16();
#pragma unroll
                for (int ks = 0; ks < 16; ++ks) acc = MFMA32(*(const bf16x8*)(qa + 16 * ks), *(const LAS bf16x8*)(Rl + (32 * eb + l31) * R_LD + 16 * ks + 8 * hi), acc);
#pragma unroll
                for (int r = 0; r < 16; ++r) acc[r] *= exp2f((float)(32 * cb + crow(r, hi) + 1) * lg);
                const bf16_t* vb = vTb + (size_t)(32 * eb + l31) * 2048 + n * 128 + 8 * hi;
                for (int ks = 0; ks < 2 * (cb + 1); ++ks) acc = MFMA32(*(const LAS bf16x8*)(Pl + (32 * cb + l31) * P_LD + 16 * ks + 8 * hi), *(const bf16x8*)(vb + 16 * ks), acc);
                bf16_t* op = o + (size_t)(t0 + 32 * cb) * 2048 + h * 512 + es * 64 + 32 * eb + l31;
#pragma unroll
                for (int r = 0; r < 16; ++r) op[(size_t)crow(r, hi) * 2048] = f2bf(acc[r]);
            }
#pragma unroll
            for (int eb = 0; eb < 2; ++eb) {
                const bf16_t* va = vTb + (size_t)(32 * eb + l31) * 2048 + n * 128 + 8 * hi;
                f32x16 acc = Rt[eb] * decay;
#pragma unroll
                for (int ks = 0; ks < 8; ++ks) acc = MFMA32(*(const bf16x8*)(va + 16 * ks), *(const bf16x8*)(kzb + n * 128 + 16 * ks + 8 * hi), acc);
                Rt[eb] = acc;
            }
            __syncthreads();
        }
    }
}

constexpr int AT_LD = 72;
constexpr int AT_KBYTES = 2 * 64 * AT_LD * 2, AT_VBYTES = 128 * AT_LD * 2, AT_BUF = AT_KBYTES + AT_VBYTES;
__device__ __forceinline__ void diff_attn(LAS unsigned char* lds, const bf16_t* qb_, const bf16_t* ksh, const bf16_t* vTsh, bf16_t* aout,
                                          const float* lam, const float* subg, float linit) {
    LAS float* xch = (LAS float*)lds;
    const int tid = opq_tid(); const int lane = tid & 63, wid = __builtin_amdgcn_readfirstlane(tid >> 6), l31 = lane & 31, hi = lane >> 5, grp = wid >> 2, wq = wid & 3;
    float lam_full;
    { const float p1 = lam[lane] * lam[64 + lane], p2 = lam[128 + lane] * lam[192 + lane];
      lam_full = expf(wave_sum(p1)) - expf(wave_sum(p2)) + linit; }
    const int pi_l = 16 * (((l31 & 3) + 4 * (l31 >> 3)) >> 3) + 8 * ((l31 >> 2) & 1) + (((l31 & 3) + 4 * (l31 >> 3)) & 7);
    const int kg0 = tid >> 9, kr0 = (tid >> 3) & 63, kc = tid & 7;
    for (int u = blockIdx.x; u < 1024; u += gridDim.x) {
        const int vv = u & 255, ii = u >> 8, bh = vv >> 2, s4 = vv & 3;
        const int qblk = (ii == 0) ? s4 : (ii == 1) ? 7 - s4 : (ii == 2) ? 8 + s4 : 15 - s4;
        const int b = bh >> 3, H = bh & 7, head = 2 * H + grp;
        const int qs0 = qblk * 128 + 32 * wq, myq = qs0 + l31;
        bf16x8 qf[4];
        { const bf16_t* qp = qb_ + (size_t)(b * 2048 + myq) * 1024 + head * 64 + 8 * hi;
#pragma unroll
          for (int ks = 0; ks < 4; ++ks) qf[ks] = *(const bf16x8*)(qp + 16 * ks); }
        f32x16 OT[4];
#pragma unroll
        for (int e = 0; e < 4; ++e) OT[e] = zero16();
        float m_run = -1e30f, l_run = 0.f;
        const int T_blk = 2 * qblk + 2, tmax_w = 2 * qblk + (wq >> 1);
        const bf16_t* ksrc0 = ksh + (size_t)(b * 2048 + kr0) * 1024 + (2 * H) * 64 + kc * 8;
        const bf16_t* vsrc0 = vTsh + ((size_t)(b * 8 + H) * 128 + (tid >> 3)) * 2048 + kc * 8;
        const int kdst = (kr0 * AT_LD + kc * 8) * 2, vdst = AT_KBYTES + ((tid >> 3) * AT_LD + kc * 8) * 2;
        u32x4 stg[4];
        stg[0] = *(const u32x4*)(ksrc0); stg[1] = *(const u32x4*)(ksrc0 + 64); stg[2] = *(const u32x4*)(vsrc0); stg[3] = *(const u32x4*)(vsrc0 + (size_t)64 * 2048);
        *(LAS u32x4*)(lds + kdst) = stg[0]; *(LAS u32x4*)(lds + kdst + 64 * AT_LD * 2) = stg[1];
        *(LAS u32x4*)(lds + vdst) = stg[2]; *(LAS u32x4*)(lds + vdst + 64 * AT_LD * 2) = stg[3];
        __syncthreads();
        for (int t = 0; t < T_blk; ++t) {
            const int kv0 = 64 * t;
            const bool more = (t + 1 < T_blk);
            if (more) { const bf16_t* kn = ksrc0 + (size_t)(kv0 + 64) * 1024; const bf16_t* vn = vsrc0 + kv0 + 64;
                        stg[0] = *(const u32x4*)(kn); stg[1] = *(const u32x4*)(kn + 64); stg[2] = *(const u32x4*)(vn); stg[3] = *(const u32x4*)(vn + (size_t)64 * 2048); }
            if (t <= tmax_w) {
                LAS unsigned char* buf = lds + (t & 1) * AT_BUF;
                const LAS bf16_t* Kl = (const LAS bf16_t*)buf + (grp * 64 + pi_l) * AT_LD + 8 * hi;
                const LAS bf16_t* Vl = (const LAS bf16_t*)(buf + AT_KBYTES) + l31 * AT_LD + 8 * hi;
                f32x16 acc[2];
#pragma unroll
                for (int j = 0; j < 2; ++j) { acc[j] = zero16();
#pragma unroll
                    for (int ks = 0; ks < 4; ++ks) acc[j] = MFMA32(*(const LAS bf16x8*)(Kl + (32 * j) * AT_LD + 16 * ks), qf[ks], acc[j]); }
                if (t == tmax_w) {
#pragma unroll
                    for (int j = 0; j < 2; ++j)
#pragma unroll
                        for (int r = 0; r < 16; ++r) { const int kv = kv0 + 32 * j + 16 * (r >> 3) + 8 * hi + (r & 7); if (kv > myq) acc[j][r] = -INFINITY; }
                }
                float rm = fmaxf(acc[0][0], acc[1][0]);
#pragma unroll
                for (int r = 1; r < 16; ++r) rm = fmaxf(rm, fmaxf(acc[0][r], acc[1][r]));
                rm = fmaxf(rm, __shfl_xor(rm, 32));
                const float m_new = fmaxf(m_run, rm);
                const float alpha = __builtin_amdgcn_exp2f(m_run - m_new);
                float rs = 0.f;
#pragma unroll
                for (int j = 0; j < 2; ++j)
#pragma unroll
                    for (int r = 0; r < 16; ++r) { acc[j][r] = __builtin_amdgcn_exp2f(acc[j][r] - m_new); rs += acc[j][r]; }
                rs += __shfl_xor(rs, 32);
                l_run = l_run * alpha + rs; m_run = m_new;
#pragma unroll
                for (int e = 0; e < 4; ++e) OT[e] *= alpha;
                bf16x8 pf[4];
#pragma unroll
                for (int j = 0; j < 2; ++j)
#pragma unroll
                    for (int kk = 0; kk < 2; ++kk) { u32x4 w; w.x = pk2(acc[j][8 * kk], acc[j][8 * kk + 1]); w.y = pk2(acc[j][8 * kk + 2], acc[j][8 * kk + 3]);
                                                     w.z = pk2(acc[j][8 * kk + 4], acc[j][8 * kk + 5]); w.w = pk2(acc[j][8 * kk + 6], acc[j][8 * kk + 7]);
                                                     pf[2 * j + kk] = __builtin_bit_cast(bf16x8, w); }
#pragma unroll
                for (int e = 0; e < 4; ++e)
#pragma unroll
                    for (int c = 0; c < 4; ++c) OT[e] = MFMA32(*(const LAS bf16x8*)(Vl + (32 * e) * AT_LD + 16 * c), pf[c], OT[e]);
            }
            if (more) { LAS unsigned char* nb = lds + ((t + 1) & 1) * AT_BUF;
                        *(LAS u32x4*)(nb + kdst) = stg[0]; *(LAS u32x4*)(nb + kdst + 64 * AT_LD * 2) = stg[1];
                        *(LAS u32x4*)(nb + vdst) = stg[2]; *(LAS u32x4*)(nb + vdst + 64 * AT_LD * 2) = stg[3]; }
            __syncthreads();
        }
        const float inv = 1.0f / l_run;
        if (grp == 1) {
            const float f = inv * lam_full;
#pragma unroll
            for (int e = 0; e < 4; ++e)
#pragma unroll
                for (int r = 0; r < 16; ++r) xch[(wq * 64 + e * 16 + r) * 64 + lane] = OT[e][r] * f;
        }
        __syncthreads();
        if (grp == 0) {
            float ss = 0.f;
#pragma unroll
            for (int e = 0; e < 4; ++e)
#pragma unroll
                for (int r = 0; r < 16; ++r) { const float v = OT[e][r] * inv - xch[(wq * 64 + e * 16 + r) * 64 + lane]; OT[e][r] = v; ss += v * v; }
            ss += __shfl_xor(ss, 32);
            const float rstd = rsqrtf(ss * (1.0f / 128.0f) + EPS) * (1.0f - linit);
            bf16_t* op = aout + (size_t)(b * 2048 + myq) * 1024 + H * 128;
#pragma unroll
            for (int e = 0; e < 4; ++e)
#pragma unroll
                for (int a = 0; a < 4; ++a) {
                    const int e0 = 32 * e + 8 * a + 4 * hi;
                    const f32x4 gg = *(const f32x4*)(subg + e0);
                    u32x2 w; w.x = pk2(OT[e][4 * a] * rstd * gg[0], OT[e][4 * a + 1] * rstd * gg[1]); w.y = pk2(OT[e][4 * a + 2] * rstd * gg[2], OT[e][4 * a + 3] * rstd * gg[3]);
                    *(u32x2*)(op + e0) = w;
                }
        }
        __syncthreads();
    }
}

#define XB_TMO      128
#define XB_XCNT(j)  (256  + 64 * (j))
#define XB_XSUB(j)  (1280 + 64 * (j))
#define XB_XGEN(j)  (2304 + 64 * (j))
#define XB_TOP      3328
#define XB_TOPGEN   3392
#define XCD_BAR_WORDS 3456
#define XB_SPIN_CAP (1u << 18)

__device__ __forceinline__ unsigned xb_ld(unsigned* p)              { return __hip_atomic_load(p, __ATOMIC_RELAXED, __HIP_MEMORY_SCOPE_AGENT); }
__device__ __forceinline__ unsigned xb_add(unsigned* p, unsigned v) { return __hip_atomic_fetch_add(p, v, __ATOMIC_RELAXED, __HIP_MEMORY_SCOPE_AGENT); }
__device__ __forceinline__ unsigned xb_xcc_id() { return (unsigned)__builtin_amdgcn_s_getreg((3 << 11) | 20) & 0xFu; }
#define XB_SPIN(cond, bar) do { unsigned _sp = 0; while (cond) { __builtin_amdgcn_s_sleep(1); \
    if ((++_sp & 255u) == 0u) { if (xb_ld(&(bar)[XB_TMO])) break; if (_sp > XB_SPIN_CAP) { atomicAdd(&(bar)[XB_TMO], 1u); break; } } } } while (0)

struct XcdBarrier {
    unsigned* bar; unsigned x;
    volatile LAS unsigned* st;
};

__device__ __forceinline__ XcdBarrier xcd_barrier_post(unsigned* bar, volatile LAS unsigned* st) {
    XcdBarrier b; b.bar = bar; b.x = xb_xcc_id(); b.st = st;
    if (threadIdx.x == 0) (void)xb_add(&bar[XB_XCNT(b.x)], 1u);
    return b;
}
__device__ __forceinline__ void xcd_barrier_complete(unsigned* bar, unsigned x, unsigned& nloc, unsigned& nx) {
    const unsigned G = gridDim.x * gridDim.y * gridDim.z;
    unsigned sum, cnt, mine, sp = 0u;
    for (;;) {
        sum = 0u; cnt = 0u; mine = 0u;
#pragma unroll
        for (unsigned j = 0; j < 16; ++j) { const unsigned c = xb_ld(&bar[XB_XCNT(j)]); sum += c; cnt += (c > 0u) ? 1u : 0u; mine = (j == x) ? c : mine; }
        if (sum == G) break;
        __builtin_amdgcn_s_sleep(1);
        if ((++sp & 255u) == 0u) { if (xb_ld(&bar[XB_TMO])) break; if (sp > XB_SPIN_CAP) { atomicAdd(&bar[XB_TMO], 1u); break; } }
    }
    nloc = mine > 0u ? mine : 1u; nx = cnt > 0u ? cnt : 1u;
}

__device__ __forceinline__ void xcd_barrier(const XcdBarrier& b) {
    asm volatile("s_waitcnt vmcnt(0)" ::: "memory");
    __syncthreads();
    if (threadIdx.x == 0) {
        unsigned* bar = b.bar;
        __builtin_amdgcn_s_waitcnt(0);
        unsigned nloc = b.st[0], nx = b.st[1];
        if (nloc == 0u) { xcd_barrier_complete(bar, b.x, nloc, nx); b.st[0] = nloc; b.st[1] = nx; }
        const unsigned old = xb_add(&bar[XB_XSUB(b.x)], 1u);
        const unsigned gen = old / nloc;
        if (old + 1u == (gen + 1u) * nloc) {
            __builtin_amdgcn_fence(__ATOMIC_RELEASE, "agent");
            asm volatile("s_waitcnt vmcnt(0)" ::: "memory");
            const unsigned og = xb_add(&bar[XB_TOP], 1u);
            const unsigned tg = og / nx;
            if (og + 1u == (tg + 1u) * nx) xb_add(&bar[XB_TOPGEN], 1u);
            else XB_SPIN(xb_ld(&bar[XB_TOPGEN]) == tg, bar);
            __builtin_amdgcn_fence(__ATOMIC_ACQUIRE, "agent");
            xb_add(&bar[XB_XGEN(b.x)], 1u);
            asm volatile("s_waitcnt vmcnt(0)" ::: "memory");
        } else {
            XB_SPIN(xb_ld(&bar[XB_XGEN(b.x)]) == gen, bar);
            __builtin_amdgcn_fence(__ATOMIC_ACQUIRE, "agent");
            asm volatile("s_waitcnt vmcnt(0)" ::: "memory");
        }
    }
    __syncthreads();
}

struct Params {
    const float *x, *c; const int* pos;
    const float *norm_g, *ada_w, *ada_b, *ret_w_in, *ret_w_out, *kv_norm_g, *kv_ada_w, *kv_ada_b, *kv_w, *diff_w_q, *diff_w_o, *diff_lam, *diff_subln_g, *mlp_w1, *mlp_w2;
    float* out; unsigned char* ws; float linit2, linit3, pad0, pad1;
};
constexpr int LDS_BYTES = 147456;
#ifndef REP_ATT
#define REP_ATT 1
#endif
#ifndef REP_RET
#define REP_RET 1
#endif
#ifndef REP_GEMM
#define REP_GEMM 1
#endif
#ifndef REP_ROW0
#define REP_ROW0 1
#endif

constexpr int PTAB_OFF = 131072 + 128;
enum { PT_X = 0, PT_C, PT_POS, PT_NORMG, PT_ADAW, PT_ADAB, PT_RWIN, PT_RWOUT, PT_KVNG, PT_KVAW, PT_KVAB, PT_KVW, PT_DWQ, PT_DWO, PT_DLAM, PT_DSG, PT_W1, PT_W2, PT_OUT, PT_WS, PT_N };
__device__ __forceinline__ unsigned long long ptab_get(LAS unsigned char* lds, int i) {
    volatile LAS unsigned* t = (volatile LAS unsigned*)(lds + PTAB_OFF) + 2 * i;
    const unsigned lo = __builtin_amdgcn_readfirstlane(t[0]), hi = __builtin_amdgcn_readfirstlane(t[1]);
    return ((unsigned long long)hi << 32) | lo;
}
#define PIN_(i, T) ((T)ptab_get(lds, (i)))
#define WSP(T, off) ((T)(ptab_get(lds, PT_WS) + (unsigned long long)(off)))

__device__ __forceinline__ void convert_layer(LAS unsigned char* lds, int l) {
    bf16_t* wbuf = WSP(bf16_t*, WS_W);
    const float* w1 = PIN_(PT_W1, const float*) + (size_t)l * 1024 * 4096; const float* w2 = PIN_(PT_W2, const float*) + (size_t)l * 4096 * 1024;
    if (l < 2) {
        WSpec a{PIN_(PT_RWIN, const float*) + (size_t)l * 1024 * 6144, 1024, 6144, WO_RET_IN}, b{PIN_(PT_RWOUT, const float*) + (size_t)l * 2048 * 1024, 2048, 1024, WO_RET_OUT},
              c{w1, 1024, 4096, WO_RET_W1}, d{w2, 4096, 1024, WO_RET_W2};
        convert_weights(lds, wbuf, a, b, c, d, d, 4);
    } else {
        const int j = l - 2;
        WSpec a{PIN_(PT_DWQ, const float*) + (size_t)j * 1024 * 1024, 1024, 1024, WO_DF_Q}, b{PIN_(PT_DWO, const float*) + (size_t)j * 1024 * 1024, 1024, 1024, WO_DF_O},
              c{w1, 1024, 4096, WO_DF_W1}, d{w2, 4096, 1024, WO_DF_W2}, e{PIN_(PT_KVW, const float*), 1024, 2048, WO_DF_KV};
        convert_weights(lds, wbuf, a, b, c, d, e, l == 2 ? 5 : 4);
    }
}

constexpr size_t WS_H0S = WS_KVMOD + 131072, WS_PROJ0 = WS_KVMOD + 196608, WS_GATED0 = WS_KVMOD + 393216, WS_Y0S = WS_KVMOD + 458752, WS_U0S = WS_KVMOD + 524288, WS_BARW = WS_KVMOD + 786432;

__global__ void __launch_bounds__(512, 2) yoco_fwd(Params p) {
    extern __shared__ __attribute__((aligned(16))) unsigned char lds_raw[];
    LAS unsigned char* lds = (LAS unsigned char*)lds_raw;
    cg::grid_group grid = cg::this_grid();
    const int G = gridDim.x, bx = blockIdx.x;
    {
        volatile LAS unsigned* bst = (volatile LAS unsigned*)(lds + 131072 + 64);
        if (threadIdx.x < 2) bst[threadIdx.x] = 0u;
        if (threadIdx.x == 0) {
            LAS unsigned long long* t = (LAS unsigned long long*)(lds + PTAB_OFF);
            t[PT_X] = (unsigned long long)p.x; t[PT_C] = (unsigned long long)p.c; t[PT_POS] = (unsigned long long)p.pos; t[PT_NORMG] = (unsigned long long)p.norm_g;
            t[PT_ADAW] = (unsigned long long)p.ada_w; t[PT_ADAB] = (unsigned long long)p.ada_b; t[PT_RWIN] = (unsigned long long)p.ret_w_in; t[PT_RWOUT] = (unsigned long long)p.ret_w_out;
            t[PT_KVNG] = (unsigned long long)p.kv_norm_g; t[PT_KVAW] = (unsigned long long)p.kv_ada_w; t[PT_KVAB] = (unsigned long long)p.kv_ada_b; t[PT_KVW] = (unsigned long long)p.kv_w;
            t[PT_DWQ] = (unsigned long long)p.diff_w_q; t[PT_DWO] = (unsigned long long)p.diff_w_o; t[PT_DLAM] = (unsigned long long)p.diff_lam; t[PT_DSG] = (unsigned long long)p.diff_subln_g;
            t[PT_W1] = (unsigned long long)p.mlp_w1; t[PT_W2] = (unsigned long long)p.mlp_w2; t[PT_OUT] = (unsigned long long)p.out; t[PT_WS] = (unsigned long long)p.ws;
        }
        if (bx == 0) { unsigned* barw = (unsigned*)(p.ws + WS_BARW); for (int i = threadIdx.x; i < XCD_BAR_WORDS; i += 512) barw[i] = 0u; }
        __syncthreads();
    }
    p0_mod_gemv(lds, PIN_(PT_C, const float*), PIN_(PT_ADAW, const float*), PIN_(PT_ADAB, const float*), PIN_(PT_KVAW, const float*), PIN_(PT_KVAB, const float*), WSP(float*, WS_MOD), WSP(float*, WS_KVMOD));
    __syncthreads();
    convert_layer(lds, 0);
    rope_tables(PIN_(PT_POS, const int*), WSP(float*, WS_RCOS), WSP(float*, WS_RSIN), WSP(float*, WS_DCOS), WSP(float*, WS_DSIN));
    asm volatile("s_waitcnt vmcnt(0) lgkmcnt(0)" ::: "memory"); grid.sync();
    (void)xcd_barrier_post(WSP(unsigned*, WS_BARW), (volatile LAS unsigned*)(lds + 131072 + 64));
#define GSYNC() do { XcdBarrier xb_; xb_.bar = WSP(unsigned*, WS_BARW); xb_.x = xb_xcc_id(); xb_.st = (volatile LAS unsigned*)(lds + 131072 + 64); xcd_barrier(xb_); } while (0)
    { float* mod = WSP(float*, WS_MOD);
      row_phase(PIN_(PT_X, const float*), nullptr, nullptr, nullptr, nullptr, 0, 1, PIN_(PT_NORMG, const float*), mod + 1024, mod, 6144, WSP(bf16_t*, WS_H), nullptr, nullptr, nullptr, 0, nullptr, nullptr, WSP(float*, WS_H0S)); }
    GSYNC();

    for (int l = 0; l < 4; ++l) {
        if (l < 2) {
            {
                bf16_t* wsb = WSP(bf16_t*, 0);
                pg8::Gemm g{(const bf16_t*)((unsigned char*)wsb + WS_H), (const bf16_t*)((unsigned char*)wsb + WS_W) + WO_RET_IN, MTOK, 6144, 1024}; pg8::StaticOrder S; S.init(MTOK, 6144, G, bx);
                pg8::EpiRetProj E{(bf16_t*)((unsigned char*)wsb + WS_A), (bf16_t*)((unsigned char*)wsb + WS_B), (bf16_t*)((unsigned char*)wsb + WS_KZT), (bf16_t*)((unsigned char*)wsb + WS_VT), (bf16_t*)((unsigned char*)wsb + WS_R),
                                  (const float*)((unsigned char*)wsb + WS_RCOS), (const float*)((unsigned char*)wsb + WS_RSIN)};
                for (int rep = 0; rep < REP_GEMM; ++rep) pg8::gemm_phase<pg8::EpiRetProj, pg8::StaticOrder, true, true>(lds, g, S, E);
            }
            gemv8(lds, WSP(const float*, WS_H0S), 1024, PIN_(PT_RWIN, const float*) + (size_t)l * 1024 * 6144, 6144, WSP(float*, WS_PROJ0), 0);
            GSYNC();
            for (int rep = 0; rep < REP_RET; ++rep)
            ret_scan(lds, WSP(const bf16_t*, WS_A), WSP(const bf16_t*, WS_B), WSP(const bf16_t*, WS_KZT), WSP(const bf16_t*, WS_VT), WSP(bf16_t*, WS_R + 64 * MiB));
            GSYNC();
            gate_phase(WSP(bf16_t*, WS_R + 64 * MiB), WSP(const bf16_t*, WS_R), WSP(const float*, WS_PROJ0), WSP(float*, WS_GATED0));
            GSYNC();
        } else {
            {
                unsigned char* wsb = WSP(unsigned char*, 0);
                pg8::Gemm g{(const bf16_t*)(wsb + WS_H), (const bf16_t*)(wsb + WS_W) + WO_DF_Q, MTOK, 1024, 1024}; pg8::StaticOrder S; S.init(MTOK, 1024, G, bx);
                pg8::EpiRope64<false> E{(bf16_t*)(wsb + WS_R), nullptr, (const float*)(wsb + WS_DCOS), (const float*)(wsb + WS_DSIN), 0.125f * 1.4426950408889634f};
                for (int rep = 0; rep < REP_GEMM; ++rep) pg8::gemm_phase<pg8::EpiRope64<false>, pg8::StaticOrder, true, true>(lds, g, S, E);
            }
            if (l == 2) {
                unsigned char* wsb = WSP(unsigned char*, 0);
                pg8::Gemm g{(const bf16_t*)(wsb + WS_R + 64 * MiB), (const bf16_t*)(wsb + WS_W) + WO_DF_KV, MTOK, 2048, 1024}; pg8::StaticOrder S; S.init(MTOK, 2048, G, bx);
                pg8::EpiRope64<true> E{(bf16_t*)(wsb + WS_A), (bf16_t*)(wsb + WS_B), (const float*)(wsb + WS_DCOS), (const float*)(wsb + WS_DSIN), 1.0f};
                for (int rep = 0; rep < REP_GEMM; ++rep) pg8::gemm_phase<pg8::EpiRope64<true>, pg8::StaticOrder, true, true>(lds, g, S, E);
            }
            GSYNC();
            for (int rep = 0; rep < REP_ATT; ++rep)
            diff_attn(lds, WSP(const bf16_t*, WS_R), WSP(const bf16_t*, WS_A), WSP(const bf16_t*, WS_B), WSP(bf16_t*, WS_R + 32 * MiB),
                      PIN_(PT_DLAM, const float*) + (size_t)(l - 2) * 256, PIN_(PT_DSG, const float*) + (size_t)(l - 2) * 128, (l == 2) ? p.linit2 : p.linit3);
            GSYNC();
        }
        {
            unsigned char* wsb = WSP(unsigned char*, 0);
            pg8::Gemm g{(const bf16_t*)(wsb + WS_R + (l < 2 ? 64 * MiB : 32 * MiB)), (const bf16_t*)(wsb + WS_W) + (l < 2 ? WO_RET_OUT : WO_DF_O), MTOK, 1024, (l < 2) ? 2048 : 1024};
            pg8::StaticOrder S; S.init(MTOK, 1024, G, bx);
            pg8::EpiF32 E{(float*)(wsb + WS_Y), 1024};
            for (int rep = 0; rep < REP_GEMM; ++rep) pg8::gemm_phase<pg8::EpiF32, pg8::StaticOrder, true, true>(lds, g, S, E);
        }
        if (l < 2) gemv8(lds, WSP(const float*, WS_GATED0), 2048, PIN_(PT_RWOUT, const float*) + (size_t)l * 2048 * 1024, 1024, WSP(float*, WS_Y0S), 0);
        GSYNC();
        {
            const float* ng = PIN_(PT_NORMG, const float*) + (size_t)l * 4 * 1024; const float* modl = WSP(const float*, WS_MOD) + (size_t)l * 8 * 6144;
            float* outp = PIN_(PT_OUT, float*);
            row_phase((l == 0) ? PIN_(PT_X, const float*) : (const float*)outp, outp, WSP(const float*, WS_Y), ng + 1024, modl + 2048, 6144, 1, ng + 2048, modl + 4096, modl + 3072, 6144, WSP(bf16_t*, WS_H),
                      nullptr, nullptr, nullptr, 0, nullptr, (l < 2) ? WSP(const float*, WS_Y0S) : nullptr, (l < 2) ? WSP(float*, WS_H0S) : nullptr);
        }
        GSYNC();
        {
            unsigned char* wsb = WSP(unsigned char*, 0);
            pg8::Gemm g{(const bf16_t*)(wsb + WS_H), (const bf16_t*)(wsb + WS_W) + (l < 2 ? WO_RET_W1 : WO_DF_W1), MTOK, 4096, 1024}; pg8::StaticOrder S; S.init(MTOK, 4096, G, bx);
            pg8::EpiRelu2 E{(bf16_t*)(wsb + WS_R), 4096};
            for (int rep = 0; rep < REP_GEMM; ++rep) pg8::gemm_phase<pg8::EpiRelu2, pg8::StaticOrder, true, true>(lds, g, S, E);
        }
        if (l < 2) gemv8(lds, WSP(const float*, WS_H0S), 1024, PIN_(PT_W1, const float*) + (size_t)l * 1024 * 4096, 4096, WSP(float*, WS_U0S), 1);
        GSYNC();
        {
            unsigned char* wsb = WSP(unsigned char*, 0);
            pg8::Gemm g{(const bf16_t*)(wsb + WS_R), (const bf16_t*)(wsb + WS_W) + (l < 2 ? WO_RET_W2 : WO_DF_W2), MTOK, 1024, 4096}; pg8::StaticOrder S; S.init(MTOK, 1024, G, bx);
            pg8::EpiF32 E{(float*)(wsb + WS_Y), 1024};
            for (int rep = 0; rep < REP_GEMM; ++rep) pg8::gemm_phase<pg8::EpiF32, pg8::StaticOrder, true, true>(lds, g, S, E);
        }
        if (l < 2) gemv8(lds, WSP(const float*, WS_U0S), 4096, PIN_(PT_W2, const float*) + (size_t)l * 4096 * 1024, 1024, WSP(float*, WS_Y0S), 0);
        GSYNC();
        {
            const float* ng = PIN_(PT_NORMG, const float*) + (size_t)l * 4 * 1024; const float* mod = WSP(const float*, WS_MOD); const float* modl = mod + (size_t)l * 8 * 6144;
            float* outp = PIN_(PT_OUT, float*);
            if (l < 3) {
                const float* ngn = ng + 4 * 1024; const float* modn = modl + 8 * 6144; const float* kvmod = WSP(const float*, WS_KVMOD);
                row_phase(outp, outp, WSP(const float*, WS_Y), ng + 3072, modl + 5120, 6144, (l == 1) ? 2 : 1, ngn, modn + 1024, modn, 6144, WSP(bf16_t*, WS_H),
                          PIN_(PT_KVNG, const float*), kvmod + 1024, kvmod, 2048, WSP(bf16_t*, WS_R + 64 * MiB), (l < 2) ? WSP(const float*, WS_Y0S) : nullptr, (l == 0) ? WSP(float*, WS_H0S) : nullptr);
                __syncthreads();
                convert_layer(lds, l + 1);
                GSYNC();
            } else {
                row_phase(outp, outp, WSP(const float*, WS_Y), ng + 3072, modl + 5120, 6144, 0, nullptr, nullptr, nullptr, 0, nullptr, nullptr, nullptr, nullptr, 0, nullptr, nullptr, nullptr);
            }
        }
    }
}

extern "C" void kernel_launch(void* const* d_in, const int* in_sizes, int n_in, void* d_out, int out_size, void* d_ws, size_t ws_size, hipStream_t stream) {
    static int grid_blocks = 0;
    if (!grid_blocks) {
        int dev = 0, cus = 0, per_cu = 0;
        hipGetDevice(&dev);
        hipDeviceGetAttribute(&cus, hipDeviceAttributeMultiprocessorCount, dev);
        hipFuncSetAttribute((const void*)yoco_fwd, hipFuncAttributeMaxDynamicSharedMemorySize, LDS_BYTES);
        if (hipOccupancyMaxActiveBlocksPerMultiprocessor(&per_cu, (const void*)yoco_fwd, 512, LDS_BYTES) != hipSuccess || per_cu < 1) per_cu = 1;
        (void)hipGetLastError();
        if (cus < 1) cus = 256;
        grid_blocks = cus * per_cu;
    }
    Params p{};
    p.x = (const float*)d_in[0]; p.c = (const float*)d_in[1]; p.pos = (const int*)d_in[2];
    p.norm_g = (const float*)d_in[3]; p.ada_w = (const float*)d_in[4]; p.ada_b = (const float*)d_in[5];
    p.ret_w_in = (const float*)d_in[6]; p.ret_w_out = (const float*)d_in[7]; p.kv_norm_g = (const float*)d_in[8];
    p.kv_ada_w = (const float*)d_in[9]; p.kv_ada_b = (const float*)d_in[10]; p.kv_w = (const float*)d_in[11];
    p.diff_w_q = (const float*)d_in[12]; p.diff_w_o = (const float*)d_in[13]; p.diff_lam = (const float*)d_in[14];
    p.diff_subln_g = (const float*)d_in[15]; p.mlp_w1 = (const float*)d_in[16]; p.mlp_w2 = (const float*)d_in[17];
    p.out = (float*)d_out; p.ws = (unsigned char*)d_ws;
    p.linit2 = (float)(0.8 - 0.6 * exp(-0.3 * 2.0)); p.linit3 = (float)(0.8 - 0.6 * exp(-0.3 * 3.0));
    void* args[] = {&p};
    hipError_t e = hipLaunchCooperativeKernel((const void*)yoco_fwd, dim3(grid_blocks), dim3(512), args, LDS_BYTES, stream);
    if (e != hipSuccess) fprintf(stderr, "cooperative launch failed: %s (grid %d)\n", hipGetErrorString(e), grid_blocks);
}
```

```cpp
#include <hip/hip_runtime.h>
#include <hip/hip_cooperative_groups.h>
#include <cstdio>
#include <cstdint>
#include <cmath>
namespace cg = cooperative_groups;

#define LAS __attribute__((address_space(3)))
typedef unsigned short bf16_t;
typedef short bf16x8 __attribute__((ext_vector_type(8)));
typedef float f32x4 __attribute__((ext_vector_type(4)));
typedef float f32x16 __attribute__((ext_vector_type(16)));
typedef unsigned u32x4 __attribute__((ext_vector_type(4)));
typedef unsigned u32x2 __attribute__((ext_vector_type(2)));
typedef float f32x2_t __attribute__((ext_vector_type(2)));
typedef __bf16 bf16x2_t __attribute__((ext_vector_type(2)));

__device__ __forceinline__ unsigned pk2(float lo, float hi) { f32x2_t v = {lo, hi}; bf16x2_t b = __builtin_convertvector(v, bf16x2_t); return __builtin_bit_cast(unsigned, b); }
__device__ __forceinline__ bf16_t f2bf(float x) { return (bf16_t)(pk2(x, 0.f) & 0xffffu); }
__device__ __forceinline__ u32x4 pk8(f32x4 a, f32x4 b) { u32x4 w; w.x = pk2(a[0], a[1]); w.y = pk2(a[2], a[3]); w.z = pk2(b[0], b[1]); w.w = pk2(b[2], b[3]); return w; }
__device__ __forceinline__ float bf2f(unsigned short h) { return __uint_as_float(((unsigned)h) << 16); }

constexpr int DM = 1024, NB = 8, SEQ = 2048, MTOK = NB * SEQ, DFF = 4096;
constexpr float EPS = 1e-6f;
constexpr size_t MiB = 1u << 20;
constexpr size_t WS_MOD = 0, WS_KVMOD = 1 * MiB, WS_RCOS = 2 * MiB, WS_RSIN = 10 * MiB, WS_DCOS = 18 * MiB, WS_DSIN = 19 * MiB;
constexpr size_t WS_W = 20 * MiB;
constexpr size_t WS_H = 52 * MiB;
constexpr size_t WS_A = 84 * MiB;
constexpr size_t WS_B = 116 * MiB;
constexpr size_t WS_R = 148 * MiB;
constexpr size_t WS_KZT = 276 * MiB;
constexpr size_t WS_VT = 308 * MiB;
constexpr size_t WS_Y = 276 * MiB;
constexpr size_t WO_RET_IN = 0, WO_RET_OUT = 6291456, WO_RET_W1 = 8388608, WO_RET_W2 = 12582912;
constexpr size_t WO_DF_Q = 0, WO_DF_O = 1048576, WO_DF_W1 = 2097152, WO_DF_W2 = 6291456, WO_DF_KV = 10485760;

namespace pg8 {
#define PG8_LAS __attribute__((address_space(3)))
constexpr int BM = 256, BK = 64, HALF = 128, HTB = HALF * BK * 2, STAGE_BYTES = 8 * HTB, NXCD = 8, WGM = 8;
__host__ __device__ __forceinline__ int lds_byte(int r, int c) { const int st = (r >> 4) * 2 + (c >> 5), rr = r & 15, cc = c & 31, ob = rr * 64 + cc * 2; return st * 1024 + (ob ^ (((ob >> 9) & 1) << 5)); }
__host__ __device__ __forceinline__ void stage_rc(int b, int& R, int& C) { const int st = b / 1024, sb = b % 1024, swz = sb ^ (((sb >> 9) & 1) << 5); R = (st >> 1) * 16 + swz / 64; C = (st & 1) * 32 + (swz % 64) / 2; }
__host__ __device__ __forceinline__ int perm32(int rho) { const int n = rho >> 4, i = rho & 15; return 8 * (i >> 2) + 4 * n + (i & 3); }
struct Unit { int pm, pn; };
struct Gemm { const bf16_t* A; const bf16_t* Bt; int M, N, K; };
struct StaticOrder {
    int nM, nN, nwg, G, c;
    __host__ __device__ void init(int M, int N, int G_, int c_) { nM = M / BM; nN = N / BM; nwg = nM * nN; G = G_; c = c_; }
    __host__ __device__ bool next(int i, Unit& u) const {
        const long L = (long)i * G + c; if (L >= nwg) return false;
        int wgid = (int)L; { const int q = nwg / NXCD, r = nwg % NXCD, xcd = wgid % NXCD, off = wgid / NXCD; wgid = (xcd < r ? xcd * (q + 1) : r * (q + 1) + (xcd - r) * q) + off; }
        const int nig = WGM * nN, gid = wgid / nig, fm = gid * WGM, gsz = (nM - fm) < WGM ? (nM - fm) : WGM;
        u.pm = fm + ((wgid % nig) % gsz); u.pn = (wgid % nig) / gsz; return true;
    }
    __device__ __forceinline__ void a_ready(const Unit&) const {}
    __device__ __forceinline__ void done(const Unit&) const {}
};

struct EpiF32 {
    static constexpr bool PERM = false, AFTER_DRAIN = false;
    float* Y; int ldc;
    __device__ __forceinline__ void operator()(const f32x4 (&acc)[2][2][4][2], const Unit& u, int wr, int wc, int fr, int fq) const {
        int row0 = u.pm * BM + wr * 64 + fr, col0 = u.pn * BM + wc * 32 + 4 * fq;
        asm volatile("" : "+v"(row0), "+v"(col0));
#pragma unroll
        for (int ai = 0; ai < 2; ++ai)
#pragma unroll
            for (int m = 0; m < 4; ++m) { float* rp = Y + (size_t)(row0 + ai * HALF + m * 16) * ldc + col0;
#pragma unroll
                for (int bj = 0; bj < 2; ++bj)
#pragma unroll
                    for (int n = 0; n < 2; ++n) *(f32x4*)(rp + bj * HALF + n * 16) = acc[ai][bj][m][n]; }
    }
};
struct EpiRelu2 {
    static constexpr bool PERM = true, AFTER_DRAIN = false;
    bf16_t* O; int ldc;
    __device__ __forceinline__ void operator()(const f32x4 (&acc)[2][2][4][2], const Unit& u, int wr, int wc, int fr, int fq) const {
        const int row0 = u.pm * BM + wr * 64 + fr, col0 = u.pn * BM + wc * 32 + 8 * fq;
#pragma unroll
        for (int ai = 0; ai < 2; ++ai)
#pragma unroll
            for (int m = 0; m < 4; ++m) { bf16_t* rp = O + (size_t)(row0 + ai * HALF + m * 16) * ldc + col0;
#pragma unroll
                for (int bj = 0; bj < 2; ++bj) { f32x4 v0 = acc[ai][bj][m][0], v1 = acc[ai][bj][m][1];
#pragma unroll
                    for (int i = 0; i < 4; ++i) { float a = fmaxf(v0[i], 0.f), b = fmaxf(v1[i], 0.f); v0[i] = a * a; v1[i] = b * b; }
                    *(u32x4*)(rp + bj * HALF) = pk8(v0, v1); } }
    }
};
struct EpiRetProj {
    static constexpr bool PERM = true, AFTER_DRAIN = false;
    bf16_t *q, *k, *kzT, *vT, *g; const float *rcos, *rsin;
    __device__ __forceinline__ void operator()(const f32x4 (&acc)[2][2][4][2], const Unit& u, int wr, int wc, int fr, int fq) const {
        const int pn = u.pn, rbase = u.pm * BM + wr * 64 + fr, cl = wc * 32 + 8 * fq;
        if (pn < 8) {
            const int head = pn & 3; const bool isk = pn >= 4;
            const float lg = __log2f(1.0f - exp2f(-5.0f - (float)head));
            bf16_t* dst = isk ? k : q; const float sc = isk ? 0.0625f : 1.0f;
#pragma unroll
            for (int ai = 0; ai < 2; ++ai)
#pragma unroll
                for (int m = 0; m < 4; ++m) {
                    const int row = rbase + ai * HALF + m * 16;
                    const f32x4 c0 = *(const f32x4*)(rcos + (size_t)row * 128 + cl), c1 = *(const f32x4*)(rcos + (size_t)row * 128 + cl + 4);
                    const f32x4 s0 = *(const f32x4*)(rsin + (size_t)row * 128 + cl), s1 = *(const f32x4*)(rsin + (size_t)row * 128 + cl + 4);
                    const f32x4 a0 = acc[ai][0][m][0], a1 = acc[ai][0][m][1], b0 = acc[ai][1][m][0], b1 = acc[ai][1][m][1];
                    f32x4 o10 = (a0 * c0 - b0 * s0) * sc, o11 = (a1 * c1 - b1 * s1) * sc, o20 = (b0 * c0 + a0 * s0) * sc, o21 = (b1 * c1 + a1 * s1) * sc;
                    bf16_t* rp = dst + (size_t)row * 1024 + head * 256 + cl;
                    *(u32x4*)(rp) = pk8(o10, o11); *(u32x4*)(rp + 128) = pk8(o20, o21);
                    if (isk) {
                        const float zeta = exp2f((float)(127 - (row & 127)) * lg);
                        bf16_t* tb = kzT + ((size_t)((row >> 11) * 4 + head) * 256 + cl) * 2048 + (row & 2047);
#pragma unroll
                        for (int i = 0; i < 4; ++i) { tb[(size_t)i * 2048] = f2bf(o10[i] * zeta); tb[(size_t)(4 + i) * 2048] = f2bf(o11[i] * zeta);
                                                      tb[(size_t)(128 + i) * 2048] = f2bf(o20[i] * zeta); tb[(size_t)(132 + i) * 2048] = f2bf(o21[i] * zeta); }
                    }
                }
        } else if (pn < 16) {
            const int head = (pn - 8) >> 1, e0 = ((pn - 8) & 1) * 256 + cl;
#pragma unroll
            for (int ai = 0; ai < 2; ++ai)
#pragma unroll
                for (int m = 0; m < 4; ++m) {
                    const int row = rbase + ai * HALF + m * 16;
                    bf16_t* tb = vT + ((size_t)((row >> 11) * 4 + head) * 512 + e0) * 2048 + (row & 2047);
#pragma unroll
                    for (int bj = 0; bj < 2; ++bj)
#pragma unroll
                        for (int n = 0; n < 2; ++n)
#pragma unroll
                            for (int i = 0; i < 4; ++i) tb[(size_t)(bj * 128 + 4 * n + i) * 2048] = f2bf(acc[ai][bj][m][n][i]);
                }
        } else {
            const int col0 = (pn - 16) * 256 + cl;
#pragma unroll
            for (int ai = 0; ai < 2; ++ai)
#pragma unroll
                for (int m = 0; m < 4; ++m) { bf16_t* rp = g + (size_t)(rbase + ai * HALF + m * 16) * 2048 + col0;
#pragma unroll
                    for (int bj = 0; bj < 2; ++bj) *(u32x4*)(rp + bj * HALF) = pk8(acc[ai][bj][m][0], acc[ai][bj][m][1]); }
        }
    }
};
template <bool KV> struct EpiRope64 {
    static constexpr bool PERM = true, AFTER_DRAIN = false;
    bf16_t* dst; bf16_t* vT; const float *dcos, *dsin; float scale;
    __device__ __forceinline__ void operator()(const f32x4 (&acc)[2][2][4][2], const Unit& u, int wr, int wc, int fr, int fq) const {
        const int pn = u.pn, rbase = u.pm * BM + wr * 64 + fr, cl = wc * 32 + 8 * fq;
        if (!KV || pn < 4) {
            const bool dorope = ((wc & 1) == 0) && (fq < 2);
#pragma unroll
            for (int ai = 0; ai < 2; ++ai)
#pragma unroll
                for (int m = 0; m < 4; ++m) {
                    const int row = rbase + ai * HALF + m * 16;
                    const f32x4 c0 = *(const f32x4*)(dcos + (size_t)row * 8), c1 = *(const f32x4*)(dcos + (size_t)row * 8 + 4);
                    const f32x4 s0 = *(const f32x4*)(dsin + (size_t)row * 8), s1 = *(const f32x4*)(dsin + (size_t)row * 8 + 4);
                    bf16_t* rp = dst + (size_t)row * 1024 + pn * 256 + cl;
#pragma unroll
                    for (int bj = 0; bj < 2; ++bj) {
                        f32x4 v[2];
#pragma unroll
                        for (int n = 0; n < 2; ++n) {
                            const f32x4 x = acc[ai][bj][m][n]; f32x4 oth;
#pragma unroll
                            for (int i = 0; i < 4; ++i) oth[i] = __shfl_xor(x[i], 16);
                            const f32x4 cs = n ? c1 : c0, sn = n ? s1 : s0;
                            const f32x4 rot = (fq == 0) ? (x * cs - oth * sn) : (x * cs + oth * sn);
                            v[n] = (dorope ? rot : x) * scale;
                        }
                        *(u32x4*)(rp + bj * HALF) = pk8(v[0], v[1]);
                    }
                }
        } else {
#pragma unroll
            for (int ai = 0; ai < 2; ++ai)
#pragma unroll
                for (int m = 0; m < 4; ++m) {
                    const int row = rbase + ai * HALF + m * 16;
#pragma unroll
                    for (int bj = 0; bj < 2; ++bj) {
                        const int H = 2 * (pn - 4) + bj;
                        bf16_t* tb = vT + ((size_t)((row >> 11) * 8 + H) * 128 + cl) * 2048 + (row & 2047);
#pragma unroll
                        for (int n = 0; n < 2; ++n)
#pragma unroll
                            for (int i = 0; i < 4; ++i) tb[(size_t)(4 * n + i) * 2048] = f2bf(acc[ai][bj][m][n][i]);
                    }
                }
        }
    }
};

template <class Epi, class Sched, bool ALIGN_EPI = false, bool SP2 = false>
__device__ __forceinline__ void gemm_phase(PG8_LAS unsigned char* lds, const Gemm g, const Sched& S, const Epi& E) {
    int tid_o = threadIdx.x; asm volatile("" : "+v"(tid_o));
    const int tid = tid_o, wid = __builtin_amdgcn_readfirstlane(tid >> 6), lane = tid & 63, wr = wid >> 2, wc = wid & 3, fr = lane & 15, fq = lane >> 4;
    const int K = g.K, nt = K / BK;
    unsigned voffA[2], voffB[2];
#pragma unroll
    for (int i = 0; i < 2; ++i) { int R, C; stage_rc(tid * 16 + i * 8192, R, C); const int Rb = Epi::PERM ? ((R & ~31) + perm32(R & 31)) : R;
        voffA[i] = (unsigned)(R * K + C) * 2u; voffB[i] = (unsigned)(Rb * K + C) * 2u; }
    const size_t kstep = (size_t)(BK * 2);
    const size_t hstep = (size_t)HALF * K * 2;
    const size_t tstep = 2 * hstep;
    const unsigned ldsw = (unsigned)wid * 1024u;
    const int aoff = lds_byte(wr * 64 + fr, fq * 8), boff = lds_byte(wc * 32 + fr, fq * 8);
#define PG8_SA(b, h) (((b) * 2 + (h)) * HTB)
#define PG8_SB(b, h) ((4 + (b) * 2 + (h)) * HTB)
#define PG8_STAGE(bufoff, gbase, voff) do { _Pragma("unroll") for (int _i = 0; _i < 2; ++_i) \
        __builtin_amdgcn_global_load_lds((const unsigned*)((const char*)(gbase) + (voff)[_i]), (PG8_LAS unsigned*)(lds + (bufoff) + ldsw + _i * 8192), 16, 0, 0); } while (0)
#define PG8_LDA(dst, b, h) do { _Pragma("unroll") for (int m = 0; m < 4; ++m) _Pragma("unroll") for (int k = 0; k < 2; ++k) dst[m][k] = *(const PG8_LAS bf16x8*)(lds + PG8_SA(b, h) + aoff + m * 2048 + k * 1024); } while (0)
#define PG8_LDB(dst, b, h) do { _Pragma("unroll") for (int n = 0; n < 2; ++n) _Pragma("unroll") for (int k = 0; k < 2; ++k) dst[n][k] = *(const PG8_LAS bf16x8*)(lds + PG8_SB(b, h) + boff + n * 2048 + k * 1024); } while (0)
#define PG8_MMA(ai, bj, At, Bt) do { __builtin_amdgcn_s_setprio(1); _Pragma("unroll") for (int m = 0; m < 4; ++m) _Pragma("unroll") for (int n = 0; n < 2; ++n) _Pragma("unroll") for (int k = 0; k < 2; ++k) \
        acc[ai][bj][m][n] = __builtin_amdgcn_mfma_f32_16x16x32_bf16(Bt[n][k], At[m][k], acc[ai][bj][m][n], 0, 0, 0); __builtin_amdgcn_s_setprio(0); } while (0)
#define PG8_WAIT_V(n) asm volatile("s_waitcnt vmcnt(" #n ")" ::: "memory")
#define PG8_WAIT_L(n) asm volatile("s_waitcnt lgkmcnt(" #n ")" ::: "memory")
#define PG8_BAR __builtin_amdgcn_s_barrier()
#define PG8_SCHED __builtin_amdgcn_sched_barrier(0)
    Unit cur, nxt; int ui = 0;
    if (!S.next(0, cur)) return;
    f32x4 acc[2][2][4][2];
#pragma unroll
    for (int a = 0; a < 2; ++a)
#pragma unroll
        for (int b = 0; b < 2; ++b)
#pragma unroll
            for (int m = 0; m < 4; ++m)
#pragma unroll
                for (int n = 0; n < 2; ++n) acc[a][b][m][n] = (f32x4){0.f, 0.f, 0.f, 0.f};
    bf16x8 At[4][2], B0[2][2], B1[2][2];
    const char* cA = (const char*)g.A + (size_t)cur.pm * tstep; const char* cB = (const char*)g.Bt + (size_t)cur.pn * tstep;
    S.a_ready(cur);
    if constexpr (SP2) {
        PG8_STAGE(PG8_SB(0, 0), cB, voffB); PG8_STAGE(PG8_SB(0, 1), cB + hstep, voffB); PG8_STAGE(PG8_SA(0, 0), cA, voffA); PG8_STAGE(PG8_SA(0, 1), cA + hstep, voffA);
        if (wr == 1) PG8_BAR;
        PG8_WAIT_V(2); PG8_BAR;
        PG8_STAGE(PG8_SB(1, 0), cB + kstep, voffB); PG8_STAGE(PG8_SA(1, 0), cA + kstep, voffA); PG8_STAGE(PG8_SB(1, 1), cB + hstep + kstep, voffB);
        PG8_WAIT_V(6); PG8_BAR;
    } else {
        PG8_STAGE(PG8_SB(0, 0), cB, voffB); PG8_STAGE(PG8_SA(0, 0), cA, voffA); PG8_STAGE(PG8_SB(0, 1), cB + hstep, voffB); PG8_STAGE(PG8_SA(0, 1), cA + hstep, voffA);
        if (wr == 1) PG8_BAR;
        PG8_WAIT_V(4); PG8_BAR;
        PG8_STAGE(PG8_SB(1, 0), cB + kstep, voffB); PG8_STAGE(PG8_SA(1, 0), cA + kstep, voffA); PG8_STAGE(PG8_SB(1, 1), cB + hstep + kstep, voffB);
        PG8_WAIT_V(6); PG8_BAR;
    }
    for (;;) {
        const bool has_next = S.next(ui + 1, nxt);
        const char* nA = has_next ? (const char*)g.A + (size_t)nxt.pm * tstep : cA; const char* nB = has_next ? (const char*)g.Bt + (size_t)nxt.pn * tstep : cB;
        for (int t = 0; t < nt; t += 2) {
            const bool last = (t == nt - 2);
            const char* a1 = cA + (size_t)(t + 1) * kstep;
            const char* a2 = last ? nA : cA + (size_t)(t + 2) * kstep; const char* b2 = last ? nB : cB + (size_t)(t + 2) * kstep;
            const char* a3 = a2 + kstep; const char* b3 = b2 + kstep;
            if (last && has_next) S.a_ready(nxt);
            if constexpr (SP2) {
            PG8_LDB(B0, 0, 0); PG8_LDB(B1, 0, 1); PG8_SCHED; PG8_LDA(At, 0, 0); PG8_STAGE(PG8_SA(1, 1), a1 + hstep, voffA);
            PG8_WAIT_V(8); PG8_WAIT_L(0); PG8_BAR; PG8_MMA(0, 0, At, B0); PG8_MMA(0, 1, At, B1); PG8_BAR; PG8_SCHED;
            PG8_LDA(At, 0, 1); PG8_STAGE(PG8_SB(0, 0), b2, voffB); PG8_STAGE(PG8_SB(0, 1), b2 + hstep, voffB); PG8_STAGE(PG8_SA(0, 0), a2, voffA);
            PG8_WAIT_V(8); PG8_WAIT_L(0); PG8_BAR; PG8_MMA(1, 0, At, B0); PG8_MMA(1, 1, At, B1); PG8_BAR; PG8_SCHED;
            PG8_LDB(B0, 1, 0); PG8_LDB(B1, 1, 1); PG8_SCHED; PG8_LDA(At, 1, 0); PG8_STAGE(PG8_SA(0, 1), a2 + hstep, voffA);
            PG8_WAIT_V(8); PG8_WAIT_L(0); PG8_BAR; PG8_MMA(0, 0, At, B0); PG8_MMA(0, 1, At, B1); PG8_BAR; PG8_SCHED;
            PG8_LDA(At, 1, 1); PG8_STAGE(PG8_SB(1, 0), b3, voffB); PG8_STAGE(PG8_SB(1, 1), b3 + hstep, voffB); PG8_STAGE(PG8_SA(1, 0), a3, voffA);
            PG8_WAIT_V(8); PG8_WAIT_L(0); PG8_BAR; PG8_MMA(1, 0, At, B0); PG8_MMA(1, 1, At, B1); PG8_BAR; PG8_SCHED;
            } else {
            PG8_LDB(B0, 0, 0); PG8_SCHED; PG8_LDA(At, 0, 0); PG8_STAGE(PG8_SA(1, 1), a1 + hstep, voffA);
            PG8_WAIT_L(8); PG8_BAR; PG8_WAIT_L(0); PG8_MMA(0, 0, At, B0); PG8_BAR; PG8_SCHED;
            PG8_LDB(B1, 0, 1); PG8_STAGE(PG8_SB(0, 0), b2, voffB);
            PG8_BAR; PG8_WAIT_L(0); PG8_MMA(0, 1, At, B1); PG8_BAR;
            PG8_LDA(At, 0, 1); PG8_STAGE(PG8_SA(0, 0), a2, voffA);
            PG8_BAR; PG8_WAIT_L(0); PG8_MMA(1, 0, At, B0); PG8_BAR; PG8_SCHED;
            PG8_STAGE(PG8_SB(0, 1), b2 + hstep, voffB);
            PG8_WAIT_V(6); PG8_BAR; PG8_MMA(1, 1, At, B1); PG8_BAR;
            PG8_LDB(B0, 1, 0); PG8_SCHED; PG8_LDA(At, 1, 0); PG8_STAGE(PG8_SA(0, 1), a2 + hstep, voffA);
            PG8_WAIT_L(8); PG8_BAR; PG8_WAIT_L(0); PG8_MMA(0, 0, At, B0); PG8_BAR; PG8_SCHED;
            PG8_LDB(B1, 1, 1); PG8_STAGE(PG8_SB(1, 0), b3, voffB);
            PG8_BAR; PG8_WAIT_L(0); PG8_MMA(0, 1, At, B1); PG8_BAR;
            PG8_LDA(At, 1, 1); PG8_STAGE(PG8_SA(1, 0), a3, voffA);
            PG8_BAR; PG8_WAIT_L(0); PG8_MMA(1, 0, At, B0); PG8_BAR; PG8_SCHED;
            PG8_STAGE(PG8_SB(1, 1), b3 + hstep, voffB);
            PG8_WAIT_V(6); PG8_BAR; PG8_MMA(1, 1, At, B1); PG8_BAR;
            }
        }
        if constexpr (ALIGN_EPI) { if (wr == 0) PG8_BAR; }
        if constexpr (!Epi::AFTER_DRAIN) { E(acc, cur, wr, wc, fr, fq); S.done(cur); }
        if (!has_next) break;
#pragma unroll
        for (int a = 0; a < 2; ++a)
#pragma unroll
            for (int b = 0; b < 2; ++b)
#pragma unroll
                for (int m = 0; m < 4; ++m)
#pragma unroll
                    for (int n = 0; n < 2; ++n) acc[a][b][m][n] = (f32x4){0.f, 0.f, 0.f, 0.f};
        cur = nxt; cA = nA; cB = nB; ++ui;
        if constexpr (ALIGN_EPI) { if (wr == 1) PG8_BAR; }
    }
    PG8_WAIT_V(0);
    if constexpr (!ALIGN_EPI) { if (wr == 0) PG8_BAR; }
    PG8_BAR;
    if constexpr (Epi::AFTER_DRAIN) { E.fused(acc, cur, wr, wc, fr, fq, lds, wid, lane); S.done(cur); }
#undef PG8_SA
#undef PG8_SB
#undef PG8_STAGE
#undef PG8_LDA
#undef PG8_LDB
#undef PG8_MMA
#undef PG8_WAIT_V
#undef PG8_WAIT_L
#undef PG8_BAR
#undef PG8_SCHED
}
}

__device__ __forceinline__ int opq_tid() { int t = threadIdx.x; asm volatile("" : "+v"(t)); return t; }
#define MFMA32(a, b, c) __builtin_amdgcn_mfma_f32_32x32x16_bf16((a), (b), (c), 0, 0, 0)
__device__ __forceinline__ int crow(int r, int hi) { return (r & 3) + 8 * (r >> 2) + 4 * hi; }
__device__ __forceinline__ float wave_sum(float v) {
#pragma unroll
    for (int o = 1; o < 64; o <<= 1) v += __shfl_xor(v, o);
    return v;
}
__device__ __forceinline__ f32x16 zero16() { f32x16 z;
#pragma unroll
    for (int i = 0; i < 16; ++i) z[i] = 0.f;
    return z; }

__device__ __forceinline__ void p0_mod_gemv(LAS unsigned char* lds, const float* c, const float* ada_w, const float* ada_b, const float* kv_ada_w, const float* kv_ada_b, float* mod, float* kvmod) {
    LAS float* cact = (LAS float*)lds;
    LAS float* red = (LAS float*)(lds + 32768);
    const int tid = opq_tid();
    for (int i = tid; i < 8192; i += 512) { const float v = c[i]; cact[i] = v / (1.0f + expf(-v)); }
    __syncthreads();
    const int cg4 = tid & 15, kg = tid >> 4;
    for (int u = blockIdx.x; u < 416; u += gridDim.x) {
        const float* W; const float* bias; float* out; int N, cb;
        if (u < 384) { const int l = u / 96; cb = (u % 96) * 64; W = ada_w + (size_t)l * 1024 * 6144; N = 6144; bias = ada_b + l * 6144; out = mod + (size_t)l * 8 * 6144; }
        else { cb = (u - 384) * 64; W = kv_ada_w; N = 2048; bias = kv_ada_b; out = kvmod; }
        f32x4 acc[8];
#pragma unroll
        for (int b = 0; b < 8; ++b) acc[b] = (f32x4){0.f, 0.f, 0.f, 0.f};
        const float* wp = W + (size_t)(kg * 32) * N + cb + 4 * cg4;
#pragma unroll 8
        for (int kk = 0; kk < 32; ++kk) {
            const f32x4 w = *(const f32x4*)(wp + (size_t)kk * N);
#pragma unroll
            for (int b = 0; b < 8; ++b) acc[b] += w * cact[b * 1024 + kg * 32 + kk];
        }
#pragma unroll
        for (int b = 0; b < 8; ++b) *(LAS f32x4*)(red + (kg * 8 + b) * 64 + 4 * cg4) = acc[b];
        __syncthreads();
        { const int b = tid >> 6, col = tid & 63; float s = bias[cb + col];
#pragma unroll 8
          for (int g = 0; g < 32; ++g) s += red[(g * 8 + b) * 64 + col];
          out[(size_t)b * N + cb + col] = s; }
        __syncthreads();
    }
}


__device__ __forceinline__ void gemv8(LAS unsigned char* lds, const float* in, int K, const float* W, int N, float* out, int act) {
    LAS float* cact = (LAS float*)lds;
    LAS float* red = (LAS float*)(lds + 32768);
    const int tid = opq_tid();
    const int cg4 = tid & 15, kg = tid >> 4;
    for (int u = blockIdx.x; u < N / 64; u += gridDim.x) {
        f32x4 acc[8];
#pragma unroll
        for (int b = 0; b < 8; ++b) acc[b] = (f32x4){0.f, 0.f, 0.f, 0.f};
        for (int kc = 0; kc < K; kc += 1024) {
            __syncthreads();
            for (int i = tid; i < 8192; i += 512) cact[i] = in[(size_t)(i >> 10) * K + kc + (i & 1023)];
            __syncthreads();
            const float* wp = W + (size_t)(kc + kg * 32) * N + u * 64 + 4 * cg4;
#pragma unroll 8
            for (int kk = 0; kk < 32; ++kk) {
                const f32x4 w = *(const f32x4*)(wp + (size_t)kk * N);
#pragma unroll
                for (int b = 0; b < 8; ++b) acc[b] += w * cact[b * 1024 + kg * 32 + kk];
            }
        }
#pragma unroll
        for (int b = 0; b < 8; ++b) *(LAS f32x4*)(red + (kg * 8 + b) * 64 + 4 * cg4) = acc[b];
        __syncthreads();
        { const int b = tid >> 6, col = tid & 63; float s = 0.f;
#pragma unroll 8
          for (int g = 0; g < 32; ++g) s += red[(g * 8 + b) * 64 + col];
          if (act == 1) { s = fmaxf(s, 0.f); s = s * s; }
          out[(size_t)b * N + u * 64 + col] = s; }
        __syncthreads();
    }
}

__device__ __forceinline__ void transpose_item(const float* W, int K, int N, bf16_t* WT, LAS float* scr, int item, int lane) {
    const int nblk = N / 32, kb = item / nblk, nb = item % nblk, k0 = 64 * kb, n0 = 32 * nb;
#pragma unroll 8
    for (int i = 0; i < 32; ++i) { const int kk = 2 * i + (lane >> 5); scr[kk * 33 + (lane & 31)] = W[(size_t)(k0 + kk) * N + n0 + (lane & 31)]; }
    asm volatile("s_waitcnt lgkmcnt(0)" ::: "memory");
    const int c = lane & 7;
#pragma unroll
    for (int j = 0; j < 4; ++j) { const int n = (lane >> 3) + 8 * j; const LAS float* s = scr + (8 * c) * 33 + n;
        u32x4 o; o.x = pk2(s[0 * 33], s[1 * 33]); o.y = pk2(s[2 * 33], s[3 * 33]); o.z = pk2(s[4 * 33], s[5 * 33]); o.w = pk2(s[6 * 33], s[7 * 33]);
        *(u32x4*)(WT + (size_t)(n0 + n) * K + k0 + 8 * c) = o; }
    asm volatile("s_waitcnt lgkmcnt(0)" ::: "memory");
}
struct WSpec { const float* W; int K, N; size_t off; };
__device__ __forceinline__ void convert_weights(LAS unsigned char* lds, bf16_t* wbuf, const WSpec& a, const WSpec& b, const WSpec& c, const WSpec& d, const WSpec& e, int nmat) {
    const int tid = opq_tid(); const int lane = tid & 63, wave = tid >> 6;
    LAS float* scr = (LAS float*)(lds + wave * 16384);
    const int gw = blockIdx.x * 8 + wave, NGW = gridDim.x * 8;
    const int ia = (a.K / 64) * (a.N / 32), ib = (b.K / 64) * (b.N / 32), ic = (c.K / 64) * (c.N / 32), id = (d.K / 64) * (d.N / 32), ie = nmat > 4 ? (e.K / 64) * (e.N / 32) : 0;
    const int total = ia + ib + ic + id + ie;
    for (int it = gw; it < total; it += NGW) {
        int r = it;
        if (r < ia) { transpose_item(a.W, a.K, a.N, wbuf + a.off, scr, r, lane); continue; } r -= ia;
        if (r < ib) { transpose_item(b.W, b.K, b.N, wbuf + b.off, scr, r, lane); continue; } r -= ib;
        if (r < ic) { transpose_item(c.W, c.K, c.N, wbuf + c.off, scr, r, lane); continue; } r -= ic;
        if (r < id) { transpose_item(d.W, d.K, d.N, wbuf + d.off, scr, r, lane); continue; } r -= id;
        transpose_item(e.W, e.K, e.N, wbuf + e.off, scr, r, lane);
    }
}

__device__ __forceinline__ void rope_tables(const int* pos, float* rcos, float* rsin, float* dcos, float* dsin) {
    const int gt = blockIdx.x * 512 + opq_tid(), NT = gridDim.x * 512;
    for (int idx = gt; idx < MTOK * 128; idx += NT) {
        const int tok = idx >> 7, j = idx & 127;
        const float inv = (float)exp2(-(double)(2 * j) * (13.287712379549449 / 256.0));
        const float ang = (float)pos[tok] * inv;
        double rv = (double)ang * 0.15915494309189535; rv -= rint(rv);
        const float fr = (float)rv;
        rcos[idx] = __builtin_amdgcn_cosf(fr); rsin[idx] = __builtin_amdgcn_sinf(fr);
    }
    for (int idx = gt; idx < MTOK * 8; idx += NT) {
        const int tok = idx >> 3, j = idx & 7;
        const float inv = (float)exp2(-(double)(2 * j) * (18.931568569324174 / 16.0));
        const float ang = (float)pos[tok] * inv;
        double rv = (double)ang * 0.15915494309189535; rv -= rint(rv);
        const float fr = (float)rv;
        dcos[idx] = __builtin_amdgcn_cosf(fr); dsin[idx] = __builtin_amdgcn_sinf(fr);
    }
}

__device__ __forceinline__ void row_phase(const float* xin, float* xout, const float* y, const float* gy, const float* gate, int gate_bs,
                                          int nout, const float* g0, const float* sc0, const float* sh0, int bs0, bf16_t* d0,
                                          const float* g1, const float* sc1, const float* sh1, int bs1, bf16_t* d1, const float* ysh, float* h0s) {
    const int tid = opq_tid(); const int lane = tid & 63, gw = blockIdx.x * 8 + (tid >> 6), NGW = gridDim.x * 8;
    for (int row = gw; row < MTOK; row += NGW) {
        const int b = row >> 11;
        f32x4 xv[4];
#pragma unroll
        for (int j = 0; j < 4; ++j) xv[j] = *(const f32x4*)(xin + (size_t)row * 1024 + 4 * lane + 256 * j);
        if (y) {
            f32x4 yv[4]; float s = 0.f;
            const float* yrow = (ysh && (row & 2047) == 0) ? (ysh + (size_t)b * 1024) : (y + (size_t)row * 1024);
#pragma unroll
            for (int j = 0; j < 4; ++j) { yv[j] = *(const f32x4*)(yrow + 4 * lane + 256 * j); s += (yv[j][0] * yv[j][0] + yv[j][1] * yv[j][1]) + (yv[j][2] * yv[j][2] + yv[j][3] * yv[j][3]); }
            const float rstd = rsqrtf(wave_sum(s) * (1.0f / 1024.0f) + EPS);
#pragma unroll
            for (int j = 0; j < 4; ++j) { const int col = 4 * lane + 256 * j;
                const f32x4 gg = *(const f32x4*)(gy + col), ga = *(const f32x4*)(gate + (size_t)b * gate_bs + col);
                xv[j] += (ga + 1.0f) * (yv[j] * rstd * gg);
                *(f32x4*)(xout + (size_t)row * 1024 + col) = xv[j]; }
        }
        if (nout > 0) {
            float s = 0.f;
#pragma unroll
            for (int j = 0; j < 4; ++j) s += (xv[j][0] * xv[j][0] + xv[j][1] * xv[j][1]) + (xv[j][2] * xv[j][2] + xv[j][3] * xv[j][3]);
            const float rstd = rsqrtf(wave_sum(s) * (1.0f / 1024.0f) + EPS);
#pragma unroll
            for (int j = 0; j < 4; ++j) { const int col = 4 * lane + 256 * j;
                const f32x4 gg = *(const f32x4*)(g0 + col), sc = *(const f32x4*)(sc0 + (size_t)b * bs0 + col), sh = *(const f32x4*)(sh0 + (size_t)b * bs0 + col);
                const f32x4 h = (xv[j] * rstd * gg) * (sc + 1.0f) + sh;
                u32x2 w; w.x = pk2(h[0], h[1]); w.y = pk2(h[2], h[3]);
                *(u32x2*)(d0 + (size_t)row * 1024 + col) = w;
                if (h0s && (row & 2047) == 0) *(f32x4*)(h0s + (size_t)b * 1024 + col) = h; }
            if (nout > 1) {
#pragma unroll
                for (int j = 0; j < 4; ++j) { const int col = 4 * lane + 256 * j;
                    const f32x4 gg = *(const f32x4*)(g1 + col), sc = *(const f32x4*)(sc1 + (size_t)b * bs1 + col), sh = *(const f32x4*)(sh1 + (size_t)b * bs1 + col);
                    const f32x4 h = (xv[j] * rstd * gg) * (sc + 1.0f) + sh;
                    u32x2 w; w.x = pk2(h[0], h[1]); w.y = pk2(h[2], h[3]);
                    *(u32x2*)(d1 + (size_t)row * 1024 + col) = w; }
            }
        }
    }
}

__device__ __forceinline__ void gate_phase(bf16_t* o, const bf16_t* g, const float* proj0, float* gated0) {
    const int tid = opq_tid(); const int lane = tid & 63, gw = blockIdx.x * 8 + (tid >> 6), NGW = gridDim.x * 8;
    if (gw < 32) {
        const int b = gw >> 2, h = gw & 3; const float* pr = proj0 + (size_t)b * 6144;
        const f32x4 qv = *(const f32x4*)(pr + h * 256 + 4 * lane), kv = *(const f32x4*)(pr + 1024 + h * 256 + 4 * lane);
        const float s00 = wave_sum((qv[0] * kv[0] + qv[1] * kv[1]) + (qv[2] * kv[2] + qv[3] * kv[3])) * 0.0625f;
        const f32x4 v0 = *(const f32x4*)(pr + 2048 + h * 512 + 8 * lane), v1 = *(const f32x4*)(pr + 2048 + h * 512 + 8 * lane + 4);
        const f32x4 g0 = *(const f32x4*)(pr + 4096 + h * 512 + 8 * lane), g1 = *(const f32x4*)(pr + 4096 + h * 512 + 8 * lane + 4);
        const f32x4 o0 = v0 * s00, o1 = v1 * s00;
        const float ss = wave_sum((o0[0] * o0[0] + o0[1] * o0[1]) + (o0[2] * o0[2] + o0[3] * o0[3]) + (o1[0] * o1[0] + o1[1] * o1[1]) + (o1[2] * o1[2] + o1[3] * o1[3]));
        const float rstd = rsqrtf(ss * (1.0f / 512.0f) + EPS);
        f32x4 r0, r1;
#pragma unroll
        for (int i = 0; i < 4; ++i) { r0[i] = (g0[i] / (1.0f + expf(-g0[i]))) * (o0[i] * rstd); r1[i] = (g1[i] / (1.0f + expf(-g1[i]))) * (o1[i] * rstd); }
        *(f32x4*)(gated0 + (size_t)b * 2048 + h * 512 + 8 * lane) = r0; *(f32x4*)(gated0 + (size_t)b * 2048 + h * 512 + 8 * lane + 4) = r1;
    }
    for (int it = gw; it < MTOK * 4; it += NGW) {
        const size_t off = (size_t)it * 512 + 8 * lane;
        const u32x4 ov = *(const u32x4*)(o + off), gv = *(const u32x4*)(g + off);
        float of[8], gf[8];
#pragma unroll
        for (int i = 0; i < 4; ++i) { of[2 * i] = __uint_as_float(ov[i] << 16); of[2 * i + 1] = __uint_as_float(ov[i] & 0xffff0000u);
                                      gf[2 * i] = __uint_as_float(gv[i] << 16); gf[2 * i + 1] = __uint_as_float(gv[i] & 0xffff0000u); }
        float s = 0.f;
#pragma unroll
        for (int i = 0; i < 8; ++i) s += of[i] * of[i];
        const float rstd = rsqrtf(wave_sum(s) * (1.0f / 512.0f) + EPS);
        float r[8];
#pragma unroll
        for (int i = 0; i < 8; ++i) r[i] = (gf[i] / (1.0f + __expf(-gf[i]))) * (of[i] * rstd);
        u32x4 w; w.x = pk2(r[0], r[1]); w.y = pk2(r[2], r[3]); w.z = pk2(r[4], r[5]); w.w = pk2(r[6], r[7]);
        *(u32x4*)(o + off) = w;
    }
}

constexpr int P_LD = 136, R_LD = 264;
__device__ __forceinline__ void ret_intra(LAS unsigned char* lds, const bf16_t* q, const bf16_t* k, const bf16_t* vT, bf16_t* o) {
    LAS bf16_t* Pl = (LAS bf16_t*)lds;
    const int tid = opq_tid(); const int lane = tid & 63, wid = __builtin_amdgcn_readfirstlane(tid >> 6), l31 = lane & 31, hi = lane >> 5;
    for (int unit = blockIdx.x; unit < 512; unit += gridDim.x) {
        const int b = unit >> 6, h = (unit >> 4) & 3, n = unit & 15;
        const float lg = __log2f(1.0f - exp2f(-5.0f - (float)h));
        const int t0 = b * 2048 + n * 128;
        const int cb = wid >> 1;
        {
            const bf16_t* qa = q + (size_t)(t0 + 32 * cb + l31) * 1024 + h * 256 + 8 * hi;
#pragma unroll
            for (int mt = 0; mt < 2; ++mt) {
                const int mb = 2 * (wid & 1) + mt;
                f32x16 acc = zero16();
                if (mb <= cb) {
                    const bf16_t* kb = k + (size_t)(t0 + 32 * mb + l31) * 1024 + h * 256 + 8 * hi;
#pragma unroll
                    for (int ks = 0; ks < 16; ++ks) acc = MFMA32(*(const bf16x8*)(qa + 16 * ks), *(const bf16x8*)(kb + 16 * ks), acc);
                }
#pragma unroll
                for (int r = 0; r < 16; ++r) {
                    const int c = 32 * cb + crow(r, hi), m = 32 * mb + l31, df = c - m;
                    const float v = (df >= 0) ? acc[r] * exp2f((float)df * lg) : 0.f;
                    Pl[c * P_LD + m] = f2bf(v);
                }
            }
        }
        __syncthreads();
        {
            const int nks = 2 * (cb + 1);
            bf16x8 pa[8];
#pragma unroll
            for (int ks = 0; ks < 8; ++ks) if (ks < nks) pa[ks] = *(const LAS bf16x8*)(Pl + (32 * cb + l31) * P_LD + 16 * ks + 8 * hi);
#pragma unroll 2
            for (int et = 0; et < 8; ++et) {
                const int eb = (wid & 1) * 8 + et;
                const bf16_t* vb = vT + ((size_t)(b * 4 + h) * 512 + 32 * eb + l31) * 2048 + n * 128 + 8 * hi;
                f32x16 acc = zero16();
#pragma unroll
                for (int ks = 0; ks < 8; ++ks) if (ks < nks) acc = MFMA32(pa[ks], *(const bf16x8*)(vb + 16 * ks), acc);
                bf16_t* op = o + (size_t)(t0 + 32 * cb) * 2048 + h * 512 + 32 * eb + l31;
#pragma unroll
                for (int r = 0; r < 16; ++r) op[(size_t)crow(r, hi) * 2048] = f2bf(acc[r]);
            }
        }
        __syncthreads();
    }
}

__device__ __forceinline__ void ret_scan(LAS unsigned char* lds, const bf16_t* q, const bf16_t* kzT, const bf16_t* vT, bf16_t* o) {
    const int tid = opq_tid(); const int lane = tid & 63, wid = __builtin_amdgcn_readfirstlane(tid >> 6), l31 = lane & 31, hi = lane >> 5;
    for (int unit = blockIdx.x; unit < 256; unit += gridDim.x) {
        const int b = unit >> 5, h = (unit >> 3) & 3, es = unit & 7;
        const float lg = __log2f(1.0f - exp2f(-5.0f - (float)h));
        const float decay = exp2f(128.0f * lg);
        f32x16 Rt[2]; Rt[0] = zero16(); Rt[1] = zero16();
        const bf16_t* vTb = vT + ((size_t)(b * 4 + h) * 512 + es * 64) * 2048;
        const bf16_t* kzb = kzT + ((size_t)(b * 4 + h) * 256 + 32 * wid + l31) * 2048;
        const int cb = wid >> 1, eb2 = wid & 1;
        for (int n = 0; n < 16; ++n) {
            const int t0 = b * 2048 + n * 128;
            if (n > 0) {
                LAS bf16_t* Rl = (LAS bf16_t*)lds + (n & 1) * (64 * R_LD);
#pragma unroll
                for (int eb = 0; eb < 2; ++eb)
#pragma unroll
                    for (int r = 0; r < 16; ++r) Rl[(32 * eb + crow(r, hi)) * R_LD + 32 * wid + l31] = f2bf(Rt[eb][r]);
                bf16x8 qa[16];
                { const bf16_t* qp = q + (size_t)(t0 + 32 * cb + l31) * 1024 + h * 256 + 8 * hi;
#pragma unroll
                  for (int ks = 0; ks < 16; ++ks) qa[ks] = *(const bf16x8*)(qp + 16 * ks); }
                bf16_t* op = o + (size_t)(t0 + 32 * cb) * 2048 + h * 512 + es * 64 + 32 * eb2 + l31;
                unsigned short oi[16];
#pragma unroll
                for (int r = 0; r < 16; ++r) oi[r] = op[(size_t)crow(r, hi) * 2048];
                __syncthreads();
                f32x16 acc = zero16();
#pragma unroll
                for (int ks = 0; ks < 16; ++ks) acc = MFMA32(qa[ks], *(const LAS bf16x8*)(Rl + (32 * eb2 + l31) * R_LD + 16 * ks + 8 * hi), acc);
#pragma unroll
                for (int r = 0; r < 16; ++r) op[(size_t)crow(r, hi) * 2048] = f2bf(bf2f(oi[r]) + acc[r] * exp2f((float)(32 * cb + crow(r, hi) + 1) * lg));
            }
            if (n < 15) {
#pragma unroll
                for (int eb = 0; eb < 2; ++eb) {
                    const bf16_t* va = vTb + (size_t)(32 * eb + l31) * 2048 + n * 128 + 8 * hi;
                    f32x16 acc = Rt[eb] * decay;
#pragma unroll
                    for (int ks = 0; ks < 8; ++ks) acc = MFMA32(*(const bf16x8*)(va + 16 * ks), *(const bf16x8*)(kzb + n * 128 + 16 * ks + 8 * hi), acc);
                    Rt[eb] = acc;
                }
            }
        }
        __syncthreads();
    }
}

constexpr int AT_LD = 72;
constexpr int AT_KBYTES = 2 * 64 * AT_LD * 2, AT_VBYTES = 128 * AT_LD * 2, AT_BUF = AT_KBYTES + AT_VBYTES;
__device__ __forceinline__ void diff_attn(LAS unsigned char* lds, const bf16_t* qb_, const bf16_t* ksh, const bf16_t* vTsh, bf16_t* aout,
                                          const float* lam, const float* subg, float linit) {
    LAS float* xch = (LAS float*)lds;
    const int tid = opq_tid(); const int lane = tid & 63, wid = __builtin_amdgcn_readfirstlane(tid >> 6), l31 = lane & 31, hi = lane >> 5, grp = wid >> 2, wq = wid & 3;
    float lam_full;
    { const float p1 = lam[lane] * lam[64 + lane], p2 = lam[128 + lane] * lam[192 + lane];
      lam_full = expf(wave_sum(p1)) - expf(wave_sum(p2)) + linit; }
    const int pi_l = 16 * (((l31 & 3) + 4 * (l31 >> 3)) >> 3) + 8 * ((l31 >> 2) & 1) + (((l31 & 3) + 4 * (l31 >> 3)) & 7);
    const int kg0 = tid >> 9, kr0 = (tid >> 3) & 63, kc = tid & 7;
    for (int u = blockIdx.x; u < 1024; u += gridDim.x) {
        const int vv = u & 255, ii = u >> 8, bh = vv >> 2, s4 = vv & 3;
        const int qblk = (ii == 0) ? s4 : (ii == 1) ? 7 - s4 : (ii == 2) ? 8 + s4 : 15 - s4;
        const int b = bh >> 3, H = bh & 7, head = 2 * H + grp;
        const int qs0 = qblk * 128 + 32 * wq, myq = qs0 + l31;
        bf16x8 qf[4];
        { const bf16_t* qp = qb_ + (size_t)(b * 2048 + myq) * 1024 + head * 64 + 8 * hi;
#pragma unroll
          for (int ks = 0; ks < 4; ++ks) qf[ks] = *(const bf16x8*)(qp + 16 * ks); }
        f32x16 OT[4];
#pragma unroll
        for (int e = 0; e < 4; ++e) OT[e] = zero16();
        float m_run = -1e30f, l_run = 0.f;
        const int T_blk = 2 * qblk + 2, tmax_w = 2 * qblk + (wq >> 1);
        const bf16_t* ksrc0 = ksh + (size_t)(b * 2048 + kr0) * 1024 + (2 * H) * 64 + kc * 8;
        const bf16_t* vsrc0 = vTsh + ((size_t)(b * 8 + H) * 128 + (tid >> 3)) * 2048 + kc * 8;
        const int kdst = (kr0 * AT_LD + kc * 8) * 2, vdst = AT_KBYTES + ((tid >> 3) * AT_LD + kc * 8) * 2;
        u32x4 stg[4];
        stg[0] = *(const u32x4*)(ksrc0); stg[1] = *(const u32x4*)(ksrc0 + 64); stg[2] = *(const u32x4*)(vsrc0); stg[3] = *(const u32x4*)(vsrc0 + (size_t)64 * 2048);
        *(LAS u32x4*)(lds + kdst) = stg[0]; *(LAS u32x4*)(lds + kdst + 64 * AT_LD * 2) = stg[1];
        *(LAS u32x4*)(lds + vdst) = stg[2]; *(LAS u32x4*)(lds + vdst + 64 * AT_LD * 2) = stg[3];
        __syncthreads();
        for (int t = 0; t < T_blk; ++t) {
            const int kv0 = 64 * t;
            const bool more = (t + 1 < T_blk);
            if (more) { const bf16_t* kn = ksrc0 + (size_t)(kv0 + 64) * 1024; const bf16_t* vn = vsrc0 + kv0 + 64;
                        stg[0] = *(const u32x4*)(kn); stg[1] = *(const u32x4*)(kn + 64); stg[2] = *(const u32x4*)(vn); stg[3] = *(const u32x4*)(vn + (size_t)64 * 2048); }
            if (t <= tmax_w) {
                LAS unsigned char* buf = lds + (t & 1) * AT_BUF;
                const LAS bf16_t* Kl = (const LAS bf16_t*)buf + (grp * 64 + pi_l) * AT_LD + 8 * hi;
                const LAS bf16_t* Vl = (const LAS bf16_t*)(buf + AT_KBYTES) + l31 * AT_LD + 8 * hi;
                f32x16 acc[2];
#pragma unroll
                for (int j = 0; j < 2; ++j) { acc[j] = zero16();
#pragma unroll
                    for (int ks = 0; ks < 4; ++ks) acc[j] = MFMA32(*(const LAS bf16x8*)(Kl + (32 * j) * AT_LD + 16 * ks), qf[ks], acc[j]); }
                if (t == tmax_w) {
#pragma unroll
                    for (int j = 0; j < 2; ++j)
#pragma unroll
                        for (int r = 0; r < 16; ++r) { const int kv = kv0 + 32 * j + 16 * (r >> 3) + 8 * hi + (r & 7); if (kv > myq) acc[j][r] = -INFINITY; }
                }
                float rm = fmaxf(acc[0][0], acc[1][0]);
#pragma unroll
                for (int r = 1; r < 16; ++r) rm = fmaxf(rm, fmaxf(acc[0][r], acc[1][r]));
                rm = fmaxf(rm, __shfl_xor(rm, 32));
                const float m_new = fmaxf(m_run, rm);
                const float alpha = __builtin_amdgcn_exp2f(m_run - m_new);
                float rs = 0.f;
#pragma unroll
                for (int j = 0; j < 2; ++j)
#pragma unroll
                    for (int r = 0; r < 16; ++r) { acc[j][r] = __builtin_amdgcn_exp2f(acc[j][r] - m_new); rs += acc[j][r]; }
                rs += __shfl_xor(rs, 32);
                l_run = l_run * alpha + rs; m_run = m_new;
#pragma unroll
                for (int e = 0; e < 4; ++e) OT[e] *= alpha;
                bf16x8 pf[4];
#pragma unroll
                for (int j = 0; j < 2; ++j)
#pragma unroll
                    for (int kk = 0; kk < 2; ++kk) { u32x4 w; w.x = pk2(acc[j][8 * kk], acc[j][8 * kk + 1]); w.y = pk2(acc[j][8 * kk + 2], acc[j][8 * kk + 3]);
                                                     w.z = pk2(acc[j][8 * kk + 4], acc[j][8 * kk + 5]); w.w = pk2(acc[j][8 * kk + 6], acc[j][8 * kk + 7]);
                                                     pf[2 * j + kk] = __builtin_bit_cast(bf16x8, w); }
#pragma unroll
                for (int e = 0; e < 4; ++e)
#pragma unroll
                    for (int c = 0; c < 4; ++c) OT[e] = MFMA32(*(const LAS bf16x8*)(Vl + (32 * e) * AT_LD + 16 * c), pf[c], OT[e]);
            }
            if (more) { LAS unsigned char* nb = lds + ((t + 1) & 1) * AT_BUF;
                        *(LAS u32x4*)(nb + kdst) = stg[0]; *(LAS u32x4*)(nb + kdst + 64 * AT_LD * 2) = stg[1];
                        *(LAS u32x4*)(nb + vdst) = stg[2]; *(LAS u32x4*)(nb + vdst + 64 * AT_LD * 2) = stg[3]; }
            __syncthreads();
        }
        const float inv = 1.0f / l_run;
        if (grp == 1) {
            const float f = inv * lam_full;
#pragma unroll
            for (int e = 0; e < 4; ++e)
#pragma unroll
                for (int r = 0; r < 16; ++r) xch[(wq * 64 + e * 16 + r) * 64 + lane] = OT[e][r] * f;
        }
        __syncthreads();
        if (grp == 0) {
            float ss = 0.f;
#pragma unroll
            for (int e = 0; e < 4; ++e)
#pragma unroll
                for (int r = 0; r < 16; ++r) { const float v = OT[e][r] * inv - xch[(wq * 64 + e * 16 + r) * 64 + lane]; OT[e][r] = v; ss += v * v; }
            ss += __shfl_xor(ss, 32);
            const float rstd = rsqrtf(ss * (1.0f / 128.0f) + EPS) * (1.0f - linit);
            bf16_t* op = aout + (size_t)(b * 2048 + myq) * 1024 + H * 128;
#pragma unroll
            for (int e = 0; e < 4; ++e)
#pragma unroll
                for (int a = 0; a < 4; ++a) {
                    const int e0 = 32 * e + 8 * a + 4 * hi;
                    const f32x4 gg = *(const f32x4*)(subg + e0);
                    u32x2 w; w.x = pk2(OT[e][4 * a] * rstd * gg[0], OT[e][4 * a + 1] * rstd * gg[1]); w.y = pk2(OT[e][4 * a + 2] * rstd * gg[2], OT[e][4 * a + 3] * rstd * gg[3]);
                    *(u32x2*)(op + e0) = w;
                }
        }
        __syncthreads();
    }
}

#define XB_TMO      128
#define XB_XCNT(j)  (256  + 64 * (j))
#define XB_XSUB(j)  (1280 + 64 * (j))
#define XB_XGEN(j)  (2304 + 64 * (j))
#define XB_TOP      3328
#define XB_TOPGEN   3392
#define XCD_BAR_WORDS 3456
#define XB_SPIN_CAP (1u << 18)

__device__ __forceinline__ unsigned xb_ld(unsigned* p)              { return __hip_atomic_load(p, __ATOMIC_RELAXED, __HIP_MEMORY_SCOPE_AGENT); }
__device__ __forceinline__ unsigned xb_add(unsigned* p, unsigned v) { return __hip_atomic_fetch_add(p, v, __ATOMIC_RELAXED, __HIP_MEMORY_SCOPE_AGENT); }
__device__ __forceinline__ unsigned xb_xcc_id() { return (unsigned)__builtin_amdgcn_s_getreg((3 << 11) | 20) & 0xFu; }
#define XB_SPIN(cond, bar) do { unsigned _sp = 0; while (cond) { __builtin_amdgcn_s_sleep(1); \
    if ((++_sp & 255u) == 0u) { if (xb_ld(&(bar)[XB_TMO])) break; if (_sp > XB_SPIN_CAP) { atomicAdd(&(bar)[XB_TMO], 1u); break; } } } } while (0)

struct XcdBarrier {
    unsigned* bar; unsigned x;
    volatile LAS unsigned* st;
};

__device__ __forceinline__ XcdBarrier xcd_barrier_post(unsigned* bar, volatile LAS unsigned* st) {
    XcdBarrier b; b.bar = bar; b.x = xb_xcc_id(); b.st = st;
    if (threadIdx.x == 0) (void)xb_add(&bar[XB_XCNT(b.x)], 1u);
    return b;
}
__device__ __forceinline__ void xcd_barrier_complete(unsigned* bar, unsigned x, unsigned& nloc, unsigned& nx) {
    const unsigned G = gridDim.x * gridDim.y * gridDim.z;
    unsigned sum, cnt, mine, sp = 0u;
    for (;;) {
        sum = 0u; cnt = 0u; mine = 0u;
#pragma unroll
        for (unsigned j = 0; j < 16; ++j) { const unsigned c = xb_ld(&bar[XB_XCNT(j)]); sum += c; cnt += (c > 0u) ? 1u : 0u; mine = (j == x) ? c : mine; }
        if (sum == G) break;
        __builtin_amdgcn_s_sleep(1);
        if ((++sp & 255u) == 0u) { if (xb_ld(&bar[XB_TMO])) break; if (sp > XB_SPIN_CAP) { atomicAdd(&bar[XB_TMO], 1u); break; } }
    }
    nloc = mine > 0u ? mine : 1u; nx = cnt > 0u ? cnt : 1u;
}

__device__ __forceinline__ void xcd_barrier(const XcdBarrier& b) {
    asm volatile("s_waitcnt vmcnt(0)" ::: "memory");
    __syncthreads();
    if (threadIdx.x == 0) {
        unsigned* bar = b.bar;
        __builtin_amdgcn_s_waitcnt(0);
        unsigned nloc = b.st[0], nx = b.st[1];
        if (nloc == 0u) { xcd_barrier_complete(bar, b.x, nloc, nx); b.st[0] = nloc; b.st[1] = nx; }
        const unsigned old = xb_add(&bar[XB_XSUB(b.x)], 1u);
        const unsigned gen = old / nloc;
        if (old + 1u == (gen + 1u) * nloc) {
            __builtin_amdgcn_fence(__ATOMIC_RELEASE, "agent");
            asm volatile("s_waitcnt vmcnt(0)" ::: "memory");
            const unsigned og = xb_add(&bar[XB_TOP], 1u);
            const unsigned tg = og / nx;
            if (og + 1u == (tg + 1u) * nx) xb_add(&bar[XB_TOPGEN], 1u);
            else XB_SPIN(xb_ld(&bar[XB_TOPGEN]) == tg, bar);
            __builtin_amdgcn_fence(__ATOMIC_ACQUIRE, "agent");
            xb_add(&bar[XB_XGEN(b.x)], 1u);
            asm volatile("s_waitcnt vmcnt(0)" ::: "memory");
        } else {
            XB_SPIN(xb_ld(&bar[XB_XGEN(b.x)]) == gen, bar);
            __builtin_amdgcn_fence(__ATOMIC_ACQUIRE, "agent");
            asm volatile("s_waitcnt vmcnt(0)" ::: "memory");
        }
    }
    __syncthreads();
}

struct Params {
    const float *x, *c; const int* pos;
    const float *norm_g, *ada_w, *ada_b, *ret_w_in, *ret_w_out, *kv_norm_g, *kv_ada_w, *kv_ada_b, *kv_w, *diff_w_q, *diff_w_o, *diff_lam, *diff_subln_g, *mlp_w1, *mlp_w2;
    float* out; unsigned char* ws; float linit2, linit3, pad0, pad1;
};
constexpr int LDS_BYTES = 147456;
#ifndef REP_ATT
#define REP_ATT 1
#endif
#ifndef REP_RET
#define REP_RET 1
#endif
#ifndef REP_GEMM
#define REP_GEMM 1
#endif
#ifndef REP_ROW0
#define REP_ROW0 1
#endif

constexpr int PTAB_OFF = 131072 + 128;
enum { PT_X = 0, PT_C, PT_POS, PT_NORMG, PT_ADAW, PT_ADAB, PT_RWIN, PT_RWOUT, PT_KVNG, PT_KVAW, PT_KVAB, PT_KVW, PT_DWQ, PT_DWO, PT_DLAM, PT_DSG, PT_W1, PT_W2, PT_OUT, PT_WS, PT_N };
__device__ __forceinline__ unsigned long long ptab_get(LAS unsigned char* lds, int i) {
    volatile LAS unsigned* t = (volatile LAS unsigned*)(lds + PTAB_OFF) + 2 * i;
    const unsigned lo = __builtin_amdgcn_readfirstlane(t[0]), hi = __builtin_amdgcn_readfirstlane(t[1]);
    return ((unsigned long long)hi << 32) | lo;
}
#define PIN_(i, T) ((T)ptab_get(lds, (i)))
#define WSP(T, off) ((T)(ptab_get(lds, PT_WS) + (unsigned long long)(off)))

__device__ __forceinline__ void convert_layer(LAS unsigned char* lds, int l) {
    bf16_t* wbuf = WSP(bf16_t*, WS_W);
    const float* w1 = PIN_(PT_W1, const float*) + (size_t)l * 1024 * 4096; const float* w2 = PIN_(PT_W2, const float*) + (size_t)l * 4096 * 1024;
    if (l < 2) {
        WSpec a{PIN_(PT_RWIN, const float*) + (size_t)l * 1024 * 6144, 1024, 6144, WO_RET_IN}, b{PIN_(PT_RWOUT, const float*) + (size_t)l * 2048 * 1024, 2048, 1024, WO_RET_OUT},
              c{w1, 1024, 4096, WO_RET_W1}, d{w2, 4096, 1024, WO_RET_W2};
        convert_weights(lds, wbuf, a, b, c, d, d, 4);
    } else {
        const int j = l - 2;
        WSpec a{PIN_(PT_DWQ, const float*) + (size_t)j * 1024 * 1024, 1024, 1024, WO_DF_Q}, b{PIN_(PT_DWO, const float*) + (size_t)j * 1024 * 1024, 1024, 1024, WO_DF_O},
              c{w1, 1024, 4096, WO_DF_W1}, d{w2, 4096, 1024, WO_DF_W2}, e{PIN_(PT_KVW, const float*), 1024, 2048, WO_DF_KV};
        convert_weights(lds, wbuf, a, b, c, d, e, l == 2 ? 5 : 4);
    }
}

constexpr size_t WS_H0S = WS_KVMOD + 131072, WS_PROJ0 = WS_KVMOD + 196608, WS_GATED0 = WS_KVMOD + 393216, WS_Y0S = WS_KVMOD + 458752, WS_U0S = WS_KVMOD + 524288, WS_BARW = WS_KVMOD + 786432;

__global__ void __launch_bounds__(512, 2) yoco_fwd(Params p) {
    extern __shared__ __attribute__((aligned(16))) unsigned char lds_raw[];
    LAS unsigned char* lds = (LAS unsigned char*)lds_raw;
    cg::grid_group grid = cg::this_grid();
    const int G = gridDim.x, bx = blockIdx.x;
    {
        volatile LAS unsigned* bst = (volatile LAS unsigned*)(lds + 131072 + 64);
        if (threadIdx.x < 2) bst[threadIdx.x] = 0u;
        if (threadIdx.x == 0) {
            LAS unsigned long long* t = (LAS unsigned long long*)(lds + PTAB_OFF);
            t[PT_X] = (unsigned long long)p.x; t[PT_C] = (unsigned long long)p.c; t[PT_POS] = (unsigned long long)p.pos; t[PT_NORMG] = (unsigned long long)p.norm_g;
            t[PT_ADAW] = (unsigned long long)p.ada_w; t[PT_ADAB] = (unsigned long long)p.ada_b; t[PT_RWIN] = (unsigned long long)p.ret_w_in; t[PT_RWOUT] = (unsigned long long)p.ret_w_out;
            t[PT_KVNG] = (unsigned long long)p.kv_norm_g; t[PT_KVAW] = (unsigned long long)p.kv_ada_w; t[PT_KVAB] = (unsigned long long)p.kv_ada_b; t[PT_KVW] = (unsigned long long)p.kv_w;
            t[PT_DWQ] = (unsigned long long)p.diff_w_q; t[PT_DWO] = (unsigned long long)p.diff_w_o; t[PT_DLAM] = (unsigned long long)p.diff_lam; t[PT_DSG] = (unsigned long long)p.diff_subln_g;
            t[PT_W1] = (unsigned long long)p.mlp_w1; t[PT_W2] = (unsigned long long)p.mlp_w2; t[PT_OUT] = (unsigned long long)p.out; t[PT_WS] = (unsigned long long)p.ws;
        }
        if (bx == 0) { unsigned* barw = (unsigned*)(p.ws + WS_BARW); for (int i = threadIdx.x; i < XCD_BAR_WORDS; i += 512) barw[i] = 0u; }
        __syncthreads();
    }
    p0_mod_gemv(lds, PIN_(PT_C, const float*), PIN_(PT_ADAW, const float*), PIN_(PT_ADAB, const float*), PIN_(PT_KVAW, const float*), PIN_(PT_KVAB, const float*), WSP(float*, WS_MOD), WSP(float*, WS_KVMOD));
    __syncthreads();
    convert_layer(lds, 0);
    rope_tables(PIN_(PT_POS, const int*), WSP(float*, WS_RCOS), WSP(float*, WS_RSIN), WSP(float*, WS_DCOS), WSP(float*, WS_DSIN));
    asm volatile("s_waitcnt vmcnt(0) lgkmcnt(0)" ::: "memory"); grid.sync();
    (void)xcd_barrier_post(WSP(unsigned*, WS_BARW), (volatile LAS unsigned*)(lds + 131072 + 64));
#define GSYNC() do { XcdBarrier xb_; xb_.bar = WSP(unsigned*, WS_BARW); xb_.x = xb_xcc_id(); xb_.st = (volatile LAS unsigned*)(lds + 131072 + 64); xcd_barrier(xb_); } while (0)
    { float* mod = WSP(float*, WS_MOD);
      row_phase(PIN_(PT_X, const float*), nullptr, nullptr, nullptr, nullptr, 0, 1, PIN_(PT_NORMG, const float*), mod + 1024, mod, 6144, WSP(bf16_t*, WS_H), nullptr, nullptr, nullptr, 0, nullptr, nullptr, WSP(float*, WS_H0S)); }
    GSYNC();

    for (int l = 0; l < 4; ++l) {
        if (l < 2) {
            {
                bf16_t* wsb = WSP(bf16_t*, 0);
                pg8::Gemm g{(const bf16_t*)((unsigned char*)wsb + WS_H), (const bf16_t*)((unsigned char*)wsb + WS_W) + WO_RET_IN, MTOK, 6144, 1024}; pg8::StaticOrder S; S.init(MTOK, 6144, G, bx);
                pg8::EpiRetProj E{(bf16_t*)((unsigned char*)wsb + WS_A), (bf16_t*)((unsigned char*)wsb + WS_B), (bf16_t*)((unsigned char*)wsb + WS_KZT), (bf16_t*)((unsigned char*)wsb + WS_VT), (bf16_t*)((unsigned char*)wsb + WS_R),
                                  (const float*)((unsigned char*)wsb + WS_RCOS), (const float*)((unsigned char*)wsb + WS_RSIN)};
                for (int rep = 0; rep < REP_GEMM; ++rep) pg8::gemm_phase<pg8::EpiRetProj, pg8::StaticOrder, true, true>(lds, g, S, E);
            }
            gemv8(lds, WSP(const float*, WS_H0S), 1024, PIN_(PT_RWIN, const float*) + (size_t)l * 1024 * 6144, 6144, WSP(float*, WS_PROJ0), 0);
            GSYNC();
            ret_intra(lds, WSP(const bf16_t*, WS_A), WSP(const bf16_t*, WS_B), WSP(const bf16_t*, WS_VT), WSP(bf16_t*, WS_R + 64 * MiB));
            GSYNC();
            ret_scan(lds, WSP(const bf16_t*, WS_A), WSP(const bf16_t*, WS_KZT), WSP(const bf16_t*, WS_VT), WSP(bf16_t*, WS_R + 64 * MiB));
            GSYNC();
            gate_phase(WSP(bf16_t*, WS_R + 64 * MiB), WSP(const bf16_t*, WS_R), WSP(const float*, WS_PROJ0), WSP(float*, WS_GATED0));
            GSYNC();
        } else {
            {
                unsigned char* wsb = WSP(unsigned char*, 0);
                pg8::Gemm g{(const bf16_t*)(wsb + WS_H), (const bf16_t*)(wsb + WS_W) + WO_DF_Q, MTOK, 1024, 1024}; pg8::StaticOrder S; S.init(MTOK, 1024, G, bx);
                pg8::EpiRope64<false> E{(bf16_t*)(wsb + WS_R), nullptr, (const float*)(wsb + WS_DCOS), (const float*)(wsb + WS_DSIN), 0.125f * 1.4426950408889634f};
                for (int rep = 0; rep < REP_GEMM; ++rep) pg8::gemm_phase<pg8::EpiRope64<false>, pg8::StaticOrder, true, true>(lds, g, S, E);
            }
            if (l == 2) {
                unsigned char* wsb = WSP(unsigned char*, 0);
                pg8::Gemm g{(const bf16_t*)(wsb + WS_R + 64 * MiB), (const bf16_t*)(wsb + WS_W) + WO_DF_KV, MTOK, 2048, 1024}; pg8::StaticOrder S; S.init(MTOK, 2048, G, bx);
                pg8::EpiRope64<true> E{(bf16_t*)(wsb + WS_A), (bf16_t*)(wsb + WS_B), (const float*)(wsb + WS_DCOS), (const float*)(wsb + WS_DSIN), 1.0f};
                for (int rep = 0; rep < REP_GEMM; ++rep) pg8::gemm_phase<pg8::EpiRope64<true>, pg8::StaticOrder, true, true>(lds, g, S, E);
            }
            GSYNC();
            for (int rep = 0; rep < REP_ATT; ++rep)
            diff_attn(lds, WSP(const bf16_t*, WS_R), WSP(const bf16_t*, WS_A), WSP(const bf16_t*, WS_B), WSP(bf16_t*, WS_R + 32 * MiB),
                      PIN_(PT_DLAM, const float*) + (size_t)(l - 2) * 256, PIN_(PT_DSG, const float*) + (size_t)(l - 2) * 128, (l == 2) ? p.linit2 : p.linit3);
            GSYNC();
        }
        {
            unsigned char* wsb = WSP(unsigned char*, 0);
            pg8::Gemm g{(const bf16_t*)(wsb + WS_R + (l < 2 ? 64 * MiB : 32 * MiB)), (const bf16_t*)(wsb + WS_W) + (l < 2 ? WO_RET_OUT : WO_DF_O), MTOK, 1024, (l < 2) ? 2048 : 1024};
            pg8::StaticOrder S; S.init(MTOK, 1024, G, bx);
            pg8::EpiF32 E{(float*)(wsb + WS_Y), 1024};
            for (int rep = 0; rep < REP_GEMM; ++rep) pg8::gemm_phase<pg8::EpiF32, pg8::StaticOrder, true, true>(lds, g, S, E);
        }
        if (l < 2) gemv8(lds, WSP(const float*, WS_GATED0), 2048, PIN_(PT_RWOUT, const float*) + (size_t)l * 2048 * 1024, 1024, WSP(float*, WS_Y0S), 0);
        GSYNC();
        {
            const float* ng = PIN_(PT_NORMG, const float*) + (size_t)l * 4 * 1024; const float* modl = WSP(const float*, WS_MOD) + (size_t)l * 8 * 6144;
            float* outp = PIN_(PT_OUT, float*);
            row_phase((l == 0) ? PIN_(PT_X, const float*) : (const float*)outp, outp, WSP(const float*, WS_Y), ng + 1024, modl + 2048, 6144, 1, ng + 2048, modl + 4096, modl + 3072, 6144, WSP(bf16_t*, WS_H),
                      nullptr, nullptr, nullptr, 0, nullptr, (l < 2) ? WSP(const float*, WS_Y0S) : nullptr, (l < 2) ? WSP(float*, WS_H0S) : nullptr);
        }
        GSYNC();
        {
            unsigned char* wsb = WSP(unsigned char*, 0);
            pg8::Gemm g{(const bf16_t*)(wsb + WS_H), (const bf16_t*)(wsb + WS_W) + (l < 2 ? WO_RET_W1 : WO_DF_W1), MTOK, 4096, 1024}; pg8::StaticOrder S; S.init(MTOK, 4096, G, bx);
            pg8::EpiRelu2 E{(bf16_t*)(wsb + WS_R), 4096};
            for (int rep = 0; rep < REP_GEMM; ++rep) pg8::gemm_phase<pg8::EpiRelu2, pg8::StaticOrder, true, true>(lds, g, S, E);
        }
        if (l < 2) gemv8(lds, WSP(const float*, WS_H0S), 1024, PIN_(PT_W1, const float*) + (size_t)l * 1024 * 4096, 4096, WSP(float*, WS_U0S), 1);
        GSYNC();
        {
            unsigned char* wsb = WSP(unsigned char*, 0);
            pg8::Gemm g{(const bf16_t*)(wsb + WS_R), (const bf16_t*)(wsb + WS_W) + (l < 2 ? WO_RET_W2 : WO_DF_W2), MTOK, 1024, 4096}; pg8::StaticOrder S; S.init(MTOK, 1024, G, bx);
            pg8::EpiF32 E{(float*)(wsb + WS_Y), 1024};
            for (int rep = 0; rep < REP_GEMM; ++rep) pg8::gemm_phase<pg8::EpiF32, pg8::StaticOrder, true, true>(lds, g, S, E);
        }
        if (l < 2) gemv8(lds, WSP(const float*, WS_U0S), 4096, PIN_(PT_W2, const float*) + (size_t)l * 4096 * 1024, 1024, WSP(float*, WS_Y0S), 0);
        GSYNC();
        {
            const float* ng = PIN_(PT_NORMG, const float*) + (size_t)l * 4 * 1024; const float* mod = WSP(const float*, WS_MOD); const float* modl = mod + (size_t)l * 8 * 6144;
            float* outp = PIN_(PT_OUT, float*);
            if (l < 3) {
                const float* ngn = ng + 4 * 1024; const float* modn = modl + 8 * 6144; const float* kvmod = WSP(const float*, WS_KVMOD);
                row_phase(outp, outp, WSP(const float*, WS_Y), ng + 3072, modl + 5120, 6144, (l == 1) ? 2 : 1, ngn, modn + 1024, modn, 6144, WSP(bf16_t*, WS_H),
                          PIN_(PT_KVNG, const float*), kvmod + 1024, kvmod, 2048, WSP(bf16_t*, WS_R + 64 * MiB), (l < 2) ? WSP(const float*, WS_Y0S) : nullptr, (l == 0) ? WSP(float*, WS_H0S) : nullptr);
                __syncthreads();
                convert_layer(lds, l + 1);
                GSYNC();
            } else {
                row_phase(outp, outp, WSP(const float*, WS_Y), ng + 3072, modl + 5120, 6144, 0, nullptr, nullptr, nullptr, 0, nullptr, nullptr, nullptr, nullptr, 0, nullptr, nullptr, nullptr);
            }
        }
    }
}

extern "C" void kernel_launch(void* const* d_in, const int* in_sizes, int n_in, void* d_out, int out_size, void* d_ws, size_t ws_size, hipStream_t stream) {
    static int grid_blocks = 0;
    if (!grid_blocks) {
        int dev = 0, cus = 0, per_cu = 0;
        hipGetDevice(&dev);
        hipDeviceGetAttribute(&cus, hipDeviceAttributeMultiprocessorCount, dev);
        hipFuncSetAttribute((const void*)yoco_fwd, hipFuncAttributeMaxDynamicSharedMemorySize, LDS_BYTES);
        if (hipOccupancyMaxActiveBlocksPerMultiprocessor(&per_cu, (const void*)yoco_fwd, 512, LDS_BYTES) != hipSuccess || per_cu < 1) per_cu = 1;
        (void)hipGetLastError();
        if (cus < 1) cus = 256;
        grid_blocks = cus * per_cu;
    }
    Params p{};
    p.x = (const float*)d_in[0]; p.c = (const float*)d_in[1]; p.pos = (const int*)d_in[2];
    p.norm_g = (const float*)d_in[3]; p.ada_w = (const float*)d_in[4]; p.ada_b = (const float*)d_in[5];
    p.ret_w_in = (const float*)d_in[6]; p.ret_w_out = (const float*)d_in[7]; p.kv_norm_g = (const float*)d_in[8];
    p.kv_ada_w = (const float*)d_in[9]; p.kv_ada_b = (const float*)d_in[10]; p.kv_w = (const float*)d_in[11];
    p.diff_w_q = (const float*)d_in[12]; p.diff_w_o = (const float*)d_in[13]; p.diff_lam = (const float*)d_in[14];
    p.diff_subln_g = (const float*)d_in[15]; p.mlp_w1 = (const float*)d_in[16]; p.mlp_w2 = (const float*)d_in[17];
    p.out = (float*)d_out; p.ws = (unsigned char*)d_ws;
    p.linit2 = (float)(0.8 - 0.6 * exp(-0.3 * 2.0)); p.linit3 = (float)(0.8 - 0.6 * exp(-0.3 * 3.0));
    void* args[] = {&p};
    hipError_t e = hipLaunchCooperativeKernel((const void*)yoco_fwd, dim3(grid_blocks), dim3(512), args, LDS_BYTES, stream);
    if (e != hipSuccess) fprintf(stderr, "cooperative launch failed: %s (grid %d)\n", hipGetErrorString(e), grid_blocks);
}
```

```cpp
#include <hip/hip_runtime.h>
#include <hip/hip_cooperative_groups.h>
#include <cstdio>
#include <cstdint>
#include <cmath>
namespace cg = cooperative_groups;

#define LAS __attribute__((address_space(3)))
#define GAS __attribute__((address_space(1)))
typedef unsigned short bf16_t;
typedef short bf16x8 __attribute__((ext_vector_type(8)));
typedef float f32x4 __attribute__((ext_vector_type(4)));
typedef float f32x16 __attribute__((ext_vector_type(16)));
typedef unsigned u32x4 __attribute__((ext_vector_type(4)));
typedef unsigned u32x2 __attribute__((ext_vector_type(2)));
typedef float f32x2_t __attribute__((ext_vector_type(2)));
typedef __bf16 bf16x2_t __attribute__((ext_vector_type(2)));

template <class T> __device__ __forceinline__ T ldg(const void* p) { return *(const GAS T*)p; }
template <class T> __device__ __forceinline__ void stglob(void* p, T v) { *(GAS T*)p = v; }
__device__ __forceinline__ unsigned pk2(float lo, float hi) { f32x2_t v = {lo, hi}; bf16x2_t b = __builtin_convertvector(v, bf16x2_t); return __builtin_bit_cast(unsigned, b); }
__device__ __forceinline__ bf16_t f2bf(float x) { return (bf16_t)(pk2(x, 0.f) & 0xffffu); }
__device__ __forceinline__ u32x4 pk8(f32x4 a, f32x4 b) { u32x4 w; w.x = pk2(a[0], a[1]); w.y = pk2(a[2], a[3]); w.z = pk2(b[0], b[1]); w.w = pk2(b[2], b[3]); return w; }
__device__ __forceinline__ float bf2f(unsigned short h) { return __uint_as_float(((unsigned)h) << 16); }

constexpr int DM = 1024, NB = 8, SEQ = 2048, MTOK = NB * SEQ, DFF = 4096;
constexpr float EPS = 1e-6f;
constexpr size_t MiB = 1u << 20;
constexpr size_t WS_MOD = 0, WS_KVMOD = 1 * MiB, WS_RCOS = 2 * MiB, WS_RSIN = 10 * MiB, WS_DCOS = 18 * MiB, WS_DSIN = 19 * MiB;
constexpr size_t WS_W = 20 * MiB;
constexpr size_t WS_H = 52 * MiB;
constexpr size_t WS_A = 84 * MiB;
constexpr size_t WS_B = 116 * MiB;
constexpr size_t WS_R = 148 * MiB;
constexpr size_t WS_KZT = 276 * MiB;
constexpr size_t WS_VT = 308 * MiB;
constexpr size_t WS_Y = 276 * MiB;
constexpr size_t WS_XCNT = 372 * MiB, WS_XB1 = WS_XCNT, WS_XB2 = WS_XCNT + 524288;
constexpr size_t WO_RET_IN = 0, WO_RET_OUT = 6291456, WO_RET_W1 = 8388608, WO_RET_W2 = 12582912;
constexpr size_t WO_DF_Q = 0, WO_DF_O = 1048576, WO_DF_W1 = 2097152, WO_DF_W2 = 6291456, WO_DF_KV = 10485760;

__device__ __forceinline__ int opq_tid(int wv_) {
    int l; asm volatile("v_mbcnt_lo_u32_b32 %0, -1, 0\n\tv_mbcnt_hi_u32_b32 %0, -1, %0" : "=v"(l));
    return __builtin_amdgcn_readfirstlane(wv_) * 64 + l; }
template <int K> __device__ __forceinline__ float xor_lane(float v) { static_assert(K > 0 && K < 32, "xor_lane: 1..31"); return __int_as_float(__builtin_amdgcn_ds_swizzle(__float_as_int(v), (K << 10) | 0x1f)); }
__device__ __forceinline__ float sum_halves(float v) { auto rr = __builtin_amdgcn_permlane32_swap(__float_as_uint(v), __float_as_uint(v), false, false); return __uint_as_float(rr[0]) + __uint_as_float(rr[1]); }
__device__ __forceinline__ float max_halves(float v) { auto rr = __builtin_amdgcn_permlane32_swap(__float_as_uint(v), __float_as_uint(v), false, false); return fmaxf(__uint_as_float(rr[0]), __uint_as_float(rr[1])); }

namespace pg8 {
#define PG8_LAS __attribute__((address_space(3)))
constexpr int BM = 256, BK = 64, HALF = 128, HTB = HALF * BK * 2, STAGE_BYTES = 8 * HTB, NXCD = 8, WGM = 8;
__host__ __device__ __forceinline__ int lds_byte(int r, int c) { const int st = (r >> 4) * 2 + (c >> 5), rr = r & 15, cc = c & 31, ob = rr * 64 + cc * 2; return st * 1024 + (ob ^ (((ob >> 9) & 1) << 5)); }
__host__ __device__ __forceinline__ void stage_rc(int b, int& R, int& C) { const int st = b / 1024, sb = b % 1024, swz = sb ^ (((sb >> 9) & 1) << 5); R = (st >> 1) * 16 + swz / 64; C = (st & 1) * 32 + (swz % 64) / 2; }
__host__ __device__ __forceinline__ int perm32(int rho) { const int n = rho >> 4, i = rho & 15; return 8 * (i >> 2) + 4 * n + (i & 3); }
struct Unit { int pm, pn; };
struct Gemm { const bf16_t* A; const bf16_t* Bt; int M, N, K; };
struct StaticOrder {
    int nM, nN, nwg, G, c;
    __host__ __device__ void init(int M, int N, int G_, int c_) { nM = M / BM; nN = N / BM; nwg = nM * nN; G = G_; c = c_; }
    __host__ __device__ bool next(int i, Unit& u) const {
        const long L = (long)i * G + c; if (L >= nwg) return false;
        int wgid = (int)L; { const int q = nwg / NXCD, r = nwg % NXCD, xcd = wgid % NXCD, off = wgid / NXCD; wgid = (xcd < r ? xcd * (q + 1) : r * (q + 1) + (xcd - r) * q) + off; }
        const int nig = WGM * nN, gid = wgid / nig, fm = gid * WGM, gsz = (nM - fm) < WGM ? (nM - fm) : WGM;
        u.pm = fm + ((wgid % nig) % gsz); u.pn = (wgid % nig) / gsz; return true;
    }
    __device__ __forceinline__ void a_ready(const Unit&) const {}
    __device__ __forceinline__ void done(const Unit&) const {}
};

struct EpiF32 {
    static constexpr bool PERM = false, AFTER_DRAIN = false;
    float* Y; int ldc;
    __device__ __forceinline__ void operator()(const f32x4 (&acc)[2][2][4][2], const Unit& u, int wr, int wc, int fr, int fq) const {
        int row0 = u.pm * BM + wr * 64 + fr, col0 = u.pn * BM + wc * 32 + 4 * fq;
        asm volatile("" : "+v"(row0), "+v"(col0));
#pragma unroll
        for (int ai = 0; ai < 2; ++ai)
#pragma unroll
            for (int m = 0; m < 4; ++m) { float* rp = Y + (size_t)(row0 + ai * HALF + m * 16) * ldc + col0;
#pragma unroll
                for (int bj = 0; bj < 2; ++bj)
#pragma unroll
                    for (int n = 0; n < 2; ++n) stglob<f32x4>(rp + bj * HALF + n * 16, acc[ai][bj][m][n]); }
    }
};
struct EpiRelu2 {
    static constexpr bool PERM = true, AFTER_DRAIN = false;
    bf16_t* O; int ldc;
    __device__ __forceinline__ void operator()(const f32x4 (&acc)[2][2][4][2], const Unit& u, int wr, int wc, int fr, int fq) const {
        const int row0 = u.pm * BM + wr * 64 + fr, col0 = u.pn * BM + wc * 32 + 8 * fq;
#pragma unroll
        for (int ai = 0; ai < 2; ++ai)
#pragma unroll
            for (int m = 0; m < 4; ++m) { bf16_t* rp = O + (size_t)(row0 + ai * HALF + m * 16) * ldc + col0;
#pragma unroll
                for (int bj = 0; bj < 2; ++bj) { f32x4 v0 = acc[ai][bj][m][0], v1 = acc[ai][bj][m][1];
#pragma unroll
                    for (int i = 0; i < 4; ++i) { float a = fmaxf(v0[i], 0.f), b = fmaxf(v1[i], 0.f); v0[i] = a * a; v1[i] = b * b; }
                    stglob<u32x4>(rp + bj * HALF, pk8(v0, v1)); } }
    }
};
struct EpiRetProj {
    static constexpr bool PERM = true, AFTER_DRAIN = false;
    bf16_t *q, *k, *kzT, *vT, *g; const float *rcos, *rsin;
    __device__ __forceinline__ void operator()(const f32x4 (&acc)[2][2][4][2], const Unit& u, int wr, int wc, int fr, int fq) const {
        const int pn = u.pn, rbase = u.pm * BM + wr * 64 + fr, cl = wc * 32 + 8 * fq;
        if (pn < 8) {
            const int head = pn & 3; const bool isk = pn >= 4;
            const float lg = __log2f(1.0f - exp2f(-5.0f - (float)head));
            bf16_t* dst = isk ? k : q; const float sc = isk ? 0.0625f : 1.0f;
#pragma unroll
            for (int ai = 0; ai < 2; ++ai)
#pragma unroll
                for (int m = 0; m < 4; ++m) {
                    const int row = rbase + ai * HALF + m * 16;
                    const f32x4 c0 = ldg<f32x4>(rcos + (size_t)row * 128 + cl), c1 = ldg<f32x4>(rcos + (size_t)row * 128 + cl + 4);
                    const f32x4 s0 = ldg<f32x4>(rsin + (size_t)row * 128 + cl), s1 = ldg<f32x4>(rsin + (size_t)row * 128 + cl + 4);
                    const f32x4 a0 = acc[ai][0][m][0], a1 = acc[ai][0][m][1], b0 = acc[ai][1][m][0], b1 = acc[ai][1][m][1];
                    f32x4 o10 = (a0 * c0 - b0 * s0) * sc, o11 = (a1 * c1 - b1 * s1) * sc, o20 = (b0 * c0 + a0 * s0) * sc, o21 = (b1 * c1 + a1 * s1) * sc;
                    bf16_t* rp = dst + (size_t)row * 1024 + head * 256 + cl;
                    stglob<u32x4>(rp, pk8(o10, o11)); stglob<u32x4>(rp + 128, pk8(o20, o21));
                    if (isk) {
                        const float zeta = exp2f((float)(127 - (row & 127)) * lg);
                        bf16_t* tb = kzT + ((size_t)((row >> 11) * 4 + head) * 256 + cl) * 2048 + (row & 2047);
#pragma unroll
                        for (int i = 0; i < 4; ++i) { stglob<bf16_t>(tb + (size_t)i * 2048, f2bf(o10[i] * zeta)); stglob<bf16_t>(tb + (size_t)(4 + i) * 2048, f2bf(o11[i] * zeta));
                                                      stglob<bf16_t>(tb + (size_t)(128 + i) * 2048, f2bf(o20[i] * zeta)); stglob<bf16_t>(tb + (size_t)(132 + i) * 2048, f2bf(o21[i] * zeta)); }
                    }
                }
        } else if (pn < 16) {
            const int head = (pn - 8) >> 1, e0 = ((pn - 8) & 1) * 256 + cl;
#pragma unroll
            for (int ai = 0; ai < 2; ++ai)
#pragma unroll
                for (int m = 0; m < 4; ++m) {
                    const int row = rbase + ai * HALF + m * 16;
                    bf16_t* tb = vT + ((size_t)((row >> 11) * 4 + head) * 512 + e0) * 2048 + (row & 2047);
#pragma unroll
                    for (int bj = 0; bj < 2; ++bj)
#pragma unroll
                        for (int n = 0; n < 2; ++n)
#pragma unroll
                            for (int i = 0; i < 4; ++i) stglob<bf16_t>(tb + (size_t)(bj * 128 + 4 * n + i) * 2048, f2bf(acc[ai][bj][m][n][i]));
                }
        } else {
            const int col0 = (pn - 16) * 256 + cl;
#pragma unroll
            for (int ai = 0; ai < 2; ++ai)
#pragma unroll
                for (int m = 0; m < 4; ++m) { bf16_t* rp = g + (size_t)(rbase + ai * HALF + m * 16) * 2048 + col0;
#pragma unroll
                    for (int bj = 0; bj < 2; ++bj) stglob<u32x4>(rp + bj * HALF, pk8(acc[ai][bj][m][0], acc[ai][bj][m][1])); }
        }
    }
};
template <bool KV> struct EpiRope64 {
    static constexpr bool PERM = true, AFTER_DRAIN = false;
    bf16_t* dst; bf16_t* vT; const float *dcos, *dsin; float scale;
    __device__ __forceinline__ void operator()(const f32x4 (&acc)[2][2][4][2], const Unit& u, int wr, int wc, int fr, int fq) const {
        const int pn = u.pn, rbase = u.pm * BM + wr * 64 + fr, cl = wc * 32 + 8 * fq;
        if (!KV || pn < 4) {
            const bool dorope = ((wc & 1) == 0) && (fq < 2);
#pragma unroll
            for (int ai = 0; ai < 2; ++ai)
#pragma unroll
                for (int m = 0; m < 4; ++m) {
                    const int row = rbase + ai * HALF + m * 16;
                    const f32x4 c0 = ldg<f32x4>(dcos + (size_t)row * 8), c1 = ldg<f32x4>(dcos + (size_t)row * 8 + 4);
                    const f32x4 s0 = ldg<f32x4>(dsin + (size_t)row * 8), s1 = ldg<f32x4>(dsin + (size_t)row * 8 + 4);
                    bf16_t* rp = dst + (size_t)row * 1024 + pn * 256 + cl;
#pragma unroll
                    for (int bj = 0; bj < 2; ++bj) {
                        f32x4 v[2];
#pragma unroll
                        for (int n = 0; n < 2; ++n) {
                            const f32x4 x = acc[ai][bj][m][n]; f32x4 oth;
#pragma unroll
                            for (int i = 0; i < 4; ++i) oth[i] = xor_lane<16>(x[i]);
                            const f32x4 cs = n ? c1 : c0, sn = n ? s1 : s0;
                            const f32x4 rot = (fq == 0) ? (x * cs - oth * sn) : (x * cs + oth * sn);
                            v[n] = (dorope ? rot : x) * scale;
                        }
                        stglob<u32x4>(rp + bj * HALF, pk8(v[0], v[1]));
                    }
                }
        } else {
#pragma unroll
            for (int ai = 0; ai < 2; ++ai)
#pragma unroll
                for (int m = 0; m < 4; ++m) {
                    const int row = rbase + ai * HALF + m * 16;
#pragma unroll
                    for (int bj = 0; bj < 2; ++bj) {
                        const int H = 2 * (pn - 4) + bj;
                        bf16_t* tb = vT + ((size_t)((row >> 11) * 8 + H) * 128 + cl) * 2048 + (row & 2047);
#pragma unroll
                        for (int n = 0; n < 2; ++n)
#pragma unroll
                            for (int i = 0; i < 4; ++i) stglob<bf16_t>(tb + (size_t)(4 * n + i) * 2048, f2bf(acc[ai][bj][m][n][i]));
                    }
                }
        }
    }
};

struct RmsStats {
    unsigned long long* xbuf;
    unsigned tag;
    __device__ __forceinline__ void run(const f32x4 (&v)[2][2][4][2], const Unit& u, int wr, int wc, int fr, int fq, PG8_LAS unsigned char* lds, int wid, int lane) const {
        PG8_LAS float* P = (PG8_LAS float*)lds;
        PG8_LAS float* S = (PG8_LAS float*)(lds + 8192);
#pragma unroll
        for (int ai = 0; ai < 2; ++ai)
#pragma unroll
            for (int m = 0; m < 4; ++m) {
                float s = 0.f;
#pragma unroll
                for (int bj = 0; bj < 2; ++bj)
#pragma unroll
                    for (int n = 0; n < 2; ++n) { const f32x4 x = v[ai][bj][m][n]; s += (x[0] * x[0] + x[1] * x[1]) + (x[2] * x[2] + x[3] * x[3]); }
                s += xor_lane<16>(s); s = sum_halves(s);
                if (fq == 0) P[(ai * HALF + wr * 64 + m * 16 + fr) * 4 + wc] = s;
            }
        asm volatile("s_waitcnt lgkmcnt(0)" ::: "memory"); __builtin_amdgcn_s_barrier(); asm volatile("" ::: "memory");
        const int row = wid * 32 + (lane & 31);
        if (lane < 32) {
            const float t = (P[row * 4 + 0] + P[row * 4 + 1]) + (P[row * 4 + 2] + P[row * 4 + 3]);
            unsigned long long* slot = xbuf + (size_t)(u.pm * BM + row) * 4;
            __hip_atomic_store(slot + u.pn, ((unsigned long long)tag << 32) | (unsigned long long)__float_as_uint(t), __ATOMIC_RELAXED, __HIP_MEMORY_SCOPE_AGENT);
            float tot = 0.f; unsigned spins = 0;
            for (;;) {
                const unsigned long long w0 = __hip_atomic_load(slot + 0, __ATOMIC_RELAXED, __HIP_MEMORY_SCOPE_AGENT), w1 = __hip_atomic_load(slot + 1, __ATOMIC_RELAXED, __HIP_MEMORY_SCOPE_AGENT),
                                         w2 = __hip_atomic_load(slot + 2, __ATOMIC_RELAXED, __HIP_MEMORY_SCOPE_AGENT), w3 = __hip_atomic_load(slot + 3, __ATOMIC_RELAXED, __HIP_MEMORY_SCOPE_AGENT);
                const bool ok = ((unsigned)(w0 >> 32) == tag) && ((unsigned)(w1 >> 32) == tag) && ((unsigned)(w2 >> 32) == tag) && ((unsigned)(w3 >> 32) == tag);
                tot = (__uint_as_float((unsigned)w0) + __uint_as_float((unsigned)w1)) + (__uint_as_float((unsigned)w2) + __uint_as_float((unsigned)w3));
                if (__builtin_amdgcn_ballot_w64(!ok) == 0ull) break;
                if (++spins > (1u << 18)) break;
                __builtin_amdgcn_s_sleep(1);
            }
            S[row] = rsqrtf(tot * (1.0f / 1024.0f) + 1e-6f);
        }
        asm volatile("s_waitcnt vmcnt(0) lgkmcnt(0)" ::: "memory"); __builtin_amdgcn_s_barrier(); asm volatile("" ::: "memory");
    }
};
struct EpiResNorm {
    static constexpr bool PERM = false, AFTER_DRAIN = true;
    const float* xin; float* xout; const float* gy; const float* gate; int gate_bs;
    int nout; const float *g0, *sc0, *sh0; int bs0; bf16_t* d0; const float *g1, *sc1, *sh1; int bs1; bf16_t* d1;
    const float* ysh; int ysh_parts; float* h0s; RmsStats st1, st2;
    __device__ __forceinline__ void fused(f32x4 (&acc)[2][2][4][2], const Unit& u, int wr, int wc, int fr, int fq, PG8_LAS unsigned char* lds, int wid, int lane) const {
        const PG8_LAS float* S = (const PG8_LAS float*)(lds + 8192);
        const int b = u.pm >> 3, col0 = u.pn * BM + wc * 32 + 4 * fq;
        const bool tok0 = ((u.pm & 7) == 0) && (wr == 0) && (fr == 0);
        if (ysh && tok0) {
            const PG8_LAS float* ysum = (const PG8_LAS float*)(lds + 131072 + 1024);
#pragma unroll
            for (int bj = 0; bj < 2; ++bj)
#pragma unroll
                for (int n = 0; n < 2; ++n) acc[0][bj][0][n] = *(const PG8_LAS f32x4*)(ysum + wc * 32 + 4 * fq + bj * HALF + n * 16);
        }
        f32x4 cy[2][2], pre[2][2][2];
#pragma unroll
        for (int bj = 0; bj < 2; ++bj)
#pragma unroll
            for (int n = 0; n < 2; ++n) { const int c = col0 + bj * HALF + n * 16; cy[bj][n] = ldg<f32x4>(gy + c) * (ldg<f32x4>(gate + (size_t)b * gate_bs + c) + 1.0f); }
#pragma unroll
        for (int m = 0; m < 2; ++m) { const size_t off = (size_t)(u.pm * BM + wr * 64 + m * 16 + fr) * 1024 + col0;
#pragma unroll
            for (int bj = 0; bj < 2; ++bj)
#pragma unroll
                for (int n = 0; n < 2; ++n) pre[m][bj][n] = ldg<f32x4>(xin + off + bj * HALF + n * 16); }
        st1.run(acc, u, wr, wc, fr, fq, lds, wid, lane);
        {
#pragma unroll
            for (int ai = 0; ai < 2; ++ai)
#pragma unroll
                for (int m = 0; m < 4; ++m) { const int r = ai * HALF + wr * 64 + m * 16 + fr; const float rs = S[r]; const size_t off = (size_t)(u.pm * BM + r) * 1024 + col0;
#pragma unroll
                    for (int bj = 0; bj < 2; ++bj)
#pragma unroll
                        for (int n = 0; n < 2; ++n) { const f32x4 xs = (ai == 0 && m < 2) ? pre[m & 1][bj][n] : ldg<f32x4>(xin + off + bj * HALF + n * 16); acc[ai][bj][m][n] = xs + acc[ai][bj][m][n] * rs * cy[bj][n]; }
                    asm volatile("" : "+v"(acc[ai][0][m][0]), "+v"(acc[ai][0][m][1]), "+v"(acc[ai][1][m][0]), "+v"(acc[ai][1][m][1]));
                    if (m & 1) asm volatile("" ::: "memory"); }
        }
        if (nout == 0) {
#pragma unroll
            for (int ai = 0; ai < 2; ++ai)
#pragma unroll
                for (int m = 0; m < 4; ++m) { const int r = ai * HALF + wr * 64 + m * 16 + fr; const size_t off = (size_t)(u.pm * BM + r) * 1024 + col0;
#pragma unroll
                    for (int bj = 0; bj < 2; ++bj)
#pragma unroll
                        for (int n = 0; n < 2; ++n) stglob<f32x4>(xout + off + bj * HALF + n * 16, acc[ai][bj][m][n]); }
            return;
        }
        st2.run(acc, u, wr, wc, fr, fq, lds, wid, lane);
        {
            f32x4 ca[2][2], cb[2][2];
#pragma unroll
            for (int bj = 0; bj < 2; ++bj)
#pragma unroll
                for (int n = 0; n < 2; ++n) { const int c = col0 + bj * HALF + n * 16; ca[bj][n] = ldg<f32x4>(g0 + c) * (ldg<f32x4>(sc0 + (size_t)b * bs0 + c) + 1.0f); cb[bj][n] = ldg<f32x4>(sh0 + (size_t)b * bs0 + c); }
#pragma unroll
            for (int ai = 0; ai < 2; ++ai)
#pragma unroll
                for (int m = 0; m < 4; ++m) { const int r = ai * HALF + wr * 64 + m * 16 + fr; const float rs = S[r]; const size_t off = (size_t)(u.pm * BM + r) * 1024 + col0;
#pragma unroll
                    for (int bj = 0; bj < 2; ++bj)
#pragma unroll
                        for (int n = 0; n < 2; ++n) { const f32x4 x1 = acc[ai][bj][m][n]; stglob<f32x4>(xout + off + bj * HALF + n * 16, x1);
                            const f32x4 h = x1 * rs * ca[bj][n] + cb[bj][n]; u32x2 w; w.x = pk2(h[0], h[1]); w.y = pk2(h[2], h[3]);
                            stglob<u32x2>(d0 + off + bj * HALF + n * 16, w);
                            if (h0s && tok0 && ai == 0 && m == 0) stglob<f32x4>(h0s + (size_t)b * 1024 + col0 + bj * HALF + n * 16, h); }
                    asm volatile("" ::: "memory"); }
        }
        if (nout > 1) {
            f32x4 ca[2][2], cb[2][2];
#pragma unroll
            for (int bj = 0; bj < 2; ++bj)
#pragma unroll
                for (int n = 0; n < 2; ++n) { const int c = col0 + bj * HALF + n * 16; ca[bj][n] = ldg<f32x4>(g1 + c) * (ldg<f32x4>(sc1 + (size_t)b * bs1 + c) + 1.0f); cb[bj][n] = ldg<f32x4>(sh1 + (size_t)b * bs1 + c); }
#pragma unroll
            for (int ai = 0; ai < 2; ++ai)
#pragma unroll
                for (int m = 0; m < 4; ++m) { const int r = ai * HALF + wr * 64 + m * 16 + fr; const float rs = S[r]; const size_t off = (size_t)(u.pm * BM + r) * 1024 + col0;
#pragma unroll
                    for (int bj = 0; bj < 2; ++bj)
#pragma unroll
                        for (int n = 0; n < 2; ++n) { const f32x4 h = acc[ai][bj][m][n] * rs * ca[bj][n] + cb[bj][n]; u32x2 w; w.x = pk2(h[0], h[1]); w.y = pk2(h[2], h[3]);
                            stglob<u32x2>(d1 + off + bj * HALF + n * 16, w); }
                    asm volatile("" ::: "memory"); }
        }
    }
};

template <class Epi, class Sched, bool ALIGN_EPI = false, bool SP2 = false>
__device__ __forceinline__ void gemm_phase(PG8_LAS unsigned char* lds, const Gemm g, const Sched& S, const Epi& E, int wv_) {
    const int tid_o = opq_tid(wv_);
    const int tid = tid_o, wid = __builtin_amdgcn_readfirstlane(tid >> 6), lane = tid & 63, wr = wid >> 2, wc = wid & 3, fr = lane & 15, fq = lane >> 4;
    const int K = g.K, nt = K / BK;
    unsigned voffA[2], voffB[2];
#pragma unroll
    for (int i = 0; i < 2; ++i) { int R, C; stage_rc(tid * 16 + i * 8192, R, C); const int Rb = Epi::PERM ? ((R & ~31) + perm32(R & 31)) : R;
        voffA[i] = (unsigned)(R * K + C) * 2u; voffB[i] = (unsigned)(Rb * K + C) * 2u; }
    const size_t kstep = (size_t)(BK * 2);
    const size_t hstep = (size_t)HALF * K * 2;
    const size_t tstep = 2 * hstep;
    const unsigned ldsw = (unsigned)wid * 1024u;
    const int aoff = lds_byte(wr * 64 + fr, fq * 8), boff = lds_byte(wc * 32 + fr, fq * 8);
#define PG8_SA(b, h) (((b) * 2 + (h)) * HTB)
#define PG8_SB(b, h) ((4 + (b) * 2 + (h)) * HTB)
#define PG8_STAGE(bufoff, gbase, voff) do { _Pragma("unroll") for (int _i = 0; _i < 2; ++_i) \
        __builtin_amdgcn_global_load_lds((const unsigned*)((const char*)(gbase) + (voff)[_i]), (PG8_LAS unsigned*)(lds + (bufoff) + ldsw + _i * 8192), 16, 0, 0); } while (0)
#define PG8_LDA(dst, b, h) do { _Pragma("unroll") for (int m = 0; m < 4; ++m) _Pragma("unroll") for (int k = 0; k < 2; ++k) dst[m][k] = *(const PG8_LAS bf16x8*)(lds + PG8_SA(b, h) + aoff + m * 2048 + k * 1024); } while (0)
#define PG8_LDB(dst, b, h) do { _Pragma("unroll") for (int n = 0; n < 2; ++n) _Pragma("unroll") for (int k = 0; k < 2; ++k) dst[n][k] = *(const PG8_LAS bf16x8*)(lds + PG8_SB(b, h) + boff + n * 2048 + k * 1024); } while (0)
#define PG8_MMA(ai, bj, At, Bt) do { __builtin_amdgcn_s_setprio(1); _Pragma("unroll") for (int m = 0; m < 4; ++m) _Pragma("unroll") for (int n = 0; n < 2; ++n) _Pragma("unroll") for (int k = 0; k < 2; ++k) \
        acc[ai][bj][m][n] = __builtin_amdgcn_mfma_f32_16x16x32_bf16(Bt[n][k], At[m][k], acc[ai][bj][m][n], 0, 0, 0); __builtin_amdgcn_s_setprio(0); } while (0)
#define PG8_WAIT_V(n) asm volatile("s_waitcnt vmcnt(" #n ")" ::: "memory")
#define PG8_WAIT_L(n) asm volatile("s_waitcnt lgkmcnt(" #n ")" ::: "memory")
#define PG8_BAR __builtin_amdgcn_s_barrier()
#define PG8_SCHED __builtin_amdgcn_sched_barrier(0)
    Unit cur, nxt; int ui = 0;
    if (!S.next(0, cur)) return;
    f32x4 acc[2][2][4][2];
#pragma unroll
    for (int a = 0; a < 2; ++a)
#pragma unroll
        for (int b = 0; b < 2; ++b)
#pragma unroll
            for (int m = 0; m < 4; ++m)
#pragma unroll
                for (int n = 0; n < 2; ++n) acc[a][b][m][n] = (f32x4){0.f, 0.f, 0.f, 0.f};
    bf16x8 At[4][2], B0[2][2], B1[2][2];
    const char* cA = (const char*)g.A + (size_t)cur.pm * tstep; const char* cB = (const char*)g.Bt + (size_t)cur.pn * tstep;
    S.a_ready(cur);
    if constexpr (SP2) {
        PG8_STAGE(PG8_SB(0, 0), cB, voffB); PG8_STAGE(PG8_SB(0, 1), cB + hstep, voffB); PG8_STAGE(PG8_SA(0, 0), cA, voffA); PG8_STAGE(PG8_SA(0, 1), cA + hstep, voffA);
        if (wr == 1) PG8_BAR;
        PG8_WAIT_V(2); PG8_BAR;
        PG8_STAGE(PG8_SB(1, 0), cB + kstep, voffB); PG8_STAGE(PG8_SA(1, 0), cA + kstep, voffA); PG8_STAGE(PG8_SB(1, 1), cB + hstep + kstep, voffB);
        PG8_WAIT_V(6); PG8_BAR;
    } else {
        PG8_STAGE(PG8_SB(0, 0), cB, voffB); PG8_STAGE(PG8_SA(0, 0), cA, voffA); PG8_STAGE(PG8_SB(0, 1), cB + hstep, voffB); PG8_STAGE(PG8_SA(0, 1), cA + hstep, voffA);
        if (wr == 1) PG8_BAR;
        PG8_WAIT_V(4); PG8_BAR;
        PG8_STAGE(PG8_SB(1, 0), cB + kstep, voffB); PG8_STAGE(PG8_SA(1, 0), cA + kstep, voffA); PG8_STAGE(PG8_SB(1, 1), cB + hstep + kstep, voffB);
        PG8_WAIT_V(6); PG8_BAR;
    }
    for (;;) {
        const bool has_next = S.next(ui + 1, nxt);
        const char* nA = has_next ? (const char*)g.A + (size_t)nxt.pm * tstep : cA; const char* nB = has_next ? (const char*)g.Bt + (size_t)nxt.pn * tstep : cB;
        for (int t = 0; t < nt; t += 2) {
            const bool last = (t == nt - 2);
            const char* a1 = cA + (size_t)(t + 1) * kstep;
            const char* a2 = last ? nA : cA + (size_t)(t + 2) * kstep; const char* b2 = last ? nB : cB + (size_t)(t + 2) * kstep;
            const char* a3 = a2 + kstep; const char* b3 = b2 + kstep;
            if (last && has_next) S.a_ready(nxt);
            if constexpr (SP2) {
            PG8_LDB(B0, 0, 0); PG8_LDB(B1, 0, 1); PG8_SCHED; PG8_LDA(At, 0, 0); PG8_STAGE(PG8_SA(1, 1), a1 + hstep, voffA);
            PG8_WAIT_V(8); PG8_WAIT_L(0); PG8_BAR; PG8_MMA(0, 0, At, B0); PG8_MMA(0, 1, At, B1); PG8_BAR; PG8_SCHED;
            PG8_LDA(At, 0, 1); PG8_STAGE(PG8_SB(0, 0), b2, voffB); PG8_STAGE(PG8_SB(0, 1), b2 + hstep, voffB); PG8_STAGE(PG8_SA(0, 0), a2, voffA);
            PG8_WAIT_V(8); PG8_WAIT_L(0); PG8_BAR; PG8_MMA(1, 0, At, B0); PG8_MMA(1, 1, At, B1); PG8_BAR; PG8_SCHED;
            PG8_LDB(B0, 1, 0); PG8_LDB(B1, 1, 1); PG8_SCHED; PG8_LDA(At, 1, 0); PG8_STAGE(PG8_SA(0, 1), a2 + hstep, voffA);
            PG8_WAIT_V(8); PG8_WAIT_L(0); PG8_BAR; PG8_MMA(0, 0, At, B0); PG8_MMA(0, 1, At, B1); PG8_BAR; PG8_SCHED;
            PG8_LDA(At, 1, 1); PG8_STAGE(PG8_SB(1, 0), b3, voffB); PG8_STAGE(PG8_SB(1, 1), b3 + hstep, voffB); PG8_STAGE(PG8_SA(1, 0), a3, voffA);
            PG8_WAIT_V(8); PG8_WAIT_L(0); PG8_BAR; PG8_MMA(1, 0, At, B0); PG8_MMA(1, 1, At, B1); PG8_BAR; PG8_SCHED;
            } else {
            PG8_LDB(B0, 0, 0); PG8_SCHED; PG8_LDA(At, 0, 0); PG8_STAGE(PG8_SA(1, 1), a1 + hstep, voffA);
            PG8_WAIT_L(8); PG8_BAR; PG8_WAIT_L(0); PG8_MMA(0, 0, At, B0); PG8_BAR; PG8_SCHED;
            PG8_LDB(B1, 0, 1); PG8_STAGE(PG8_SB(0, 0), b2, voffB);
            PG8_BAR; PG8_WAIT_L(0); PG8_MMA(0, 1, At, B1); PG8_BAR;
            PG8_LDA(At, 0, 1); PG8_STAGE(PG8_SA(0, 0), a2, voffA);
            PG8_BAR; PG8_WAIT_L(0); PG8_MMA(1, 0, At, B0); PG8_BAR; PG8_SCHED;
            PG8_STAGE(PG8_SB(0, 1), b2 + hstep, voffB);
            PG8_WAIT_V(6); PG8_BAR; PG8_MMA(1, 1, At, B1); PG8_BAR;
            PG8_LDB(B0, 1, 0); PG8_SCHED; PG8_LDA(At, 1, 0); PG8_STAGE(PG8_SA(0, 1), a2 + hstep, voffA);
            PG8_WAIT_L(8); PG8_BAR; PG8_WAIT_L(0); PG8_MMA(0, 0, At, B0); PG8_BAR; PG8_SCHED;
            PG8_LDB(B1, 1, 1); PG8_STAGE(PG8_SB(1, 0), b3, voffB);
            PG8_BAR; PG8_WAIT_L(0); PG8_MMA(0, 1, At, B1); PG8_BAR;
            PG8_LDA(At, 1, 1); PG8_STAGE(PG8_SA(1, 0), a3, voffA);
            PG8_BAR; PG8_WAIT_L(0); PG8_MMA(1, 0, At, B0); PG8_BAR; PG8_SCHED;
            PG8_STAGE(PG8_SB(1, 1), b3 + hstep, voffB);
            PG8_WAIT_V(6); PG8_BAR; PG8_MMA(1, 1, At, B1); PG8_BAR;
            }
        }
        if constexpr (ALIGN_EPI) { if (wr == 0) PG8_BAR; }
        if constexpr (!Epi::AFTER_DRAIN) { E(acc, cur, wr, wc, fr, fq); S.done(cur); }
        if (!has_next) break;
#pragma unroll
        for (int a = 0; a < 2; ++a)
#pragma unroll
            for (int b = 0; b < 2; ++b)
#pragma unroll
                for (int m = 0; m < 4; ++m)
#pragma unroll
                    for (int n = 0; n < 2; ++n) acc[a][b][m][n] = (f32x4){0.f, 0.f, 0.f, 0.f};
        cur = nxt; cA = nA; cB = nB; ++ui;
        if constexpr (ALIGN_EPI) { if (wr == 1) PG8_BAR; }
    }
    PG8_WAIT_V(0);
    if constexpr (!ALIGN_EPI) { if (wr == 0) PG8_BAR; }
    PG8_BAR;
    if constexpr (Epi::AFTER_DRAIN) { E.fused(acc, cur, wr, wc, fr, fq, lds, wid, lane); S.done(cur); }
#undef PG8_SA
#undef PG8_SB
#undef PG8_STAGE
#undef PG8_LDA
#undef PG8_LDB
#undef PG8_MMA
#undef PG8_WAIT_V
#undef PG8_WAIT_L
#undef PG8_BAR
#undef PG8_SCHED
}
}

#define MFMA32(a, b, c) __builtin_amdgcn_mfma_f32_32x32x16_bf16((a), (b), (c), 0, 0, 0)
__device__ __forceinline__ int crow(int r, int hi) { return (r & 3) + 8 * (r >> 2) + 4 * hi; }
__device__ __forceinline__ float wave_sum(float v) {
    v += xor_lane<1>(v); v += xor_lane<2>(v); v += xor_lane<4>(v); v += xor_lane<8>(v); v += xor_lane<16>(v);
    return sum_halves(v);
}
__device__ __forceinline__ f32x16 zero16() { f32x16 z;
#pragma unroll
    for (int i = 0; i < 16; ++i) z[i] = 0.f;
    return z; }

__device__ __forceinline__ void p0_mod_gemv(LAS unsigned char* lds, const float* c, const float* ada_w, const float* ada_b, const float* kv_ada_w, const float* kv_ada_b, float* mod, float* kvmod, int wv_) {
    LAS float* cact = (LAS float*)lds;
    LAS float* red = (LAS float*)(lds + 32768);
    const int tid = opq_tid(wv_);
    for (int i = tid; i < 8192; i += 512) { const float v = ldg<float>(c + i); cact[i] = v / (1.0f + expf(-v)); }
    __syncthreads();
    const int cg4 = tid & 15, kg = tid >> 4;
    for (int u = blockIdx.x; u < 416; u += gridDim.x) {
        const float* W; const float* bias; float* out; int N, cb;
        if (u < 384) { const int l = u / 96; cb = (u % 96) * 64; W = ada_w + (size_t)l * 1024 * 6144; N = 6144; bias = ada_b + l * 6144; out = mod + (size_t)l * 8 * 6144; }
        else { cb = (u - 384) * 64; W = kv_ada_w; N = 2048; bias = kv_ada_b; out = kvmod; }
        f32x4 acc[8];
#pragma unroll
        for (int b = 0; b < 8; ++b) acc[b] = (f32x4){0.f, 0.f, 0.f, 0.f};
        const float* wp = W + (size_t)(kg * 32) * N + cb + 4 * cg4;
#pragma unroll 8
        for (int kk = 0; kk < 32; ++kk) {
            const f32x4 w = ldg<f32x4>(wp + (size_t)kk * N);
#pragma unroll
            for (int b = 0; b < 8; ++b) acc[b] += w * cact[b * 1024 + kg * 32 + kk];
        }
#pragma unroll
        for (int b = 0; b < 8; ++b) *(LAS f32x4*)(red + (kg * 8 + b) * 64 + 4 * cg4) = acc[b];
        __syncthreads();
        { const int b = tid >> 6, col = tid & 63; float s = ldg<float>(bias + cb + col);
#pragma unroll 8
          for (int g = 0; g < 32; ++g) s += red[(g * 8 + b) * 64 + col];
          stglob<float>(out + (size_t)b * N + cb + col, s); }
        __syncthreads();
    }
}


__device__ __forceinline__ void gemv8p(LAS unsigned char* lds, const float* in, int in_parts, int in_relu2, int K, const float* W, int N, float* outp, int wv_) {
    LAS float* cact = (LAS float*)lds;
    LAS float* red = (LAS float*)(lds + 8192);
    const int tid = opq_tid(wv_);
    const int cg4 = tid & 15, kg = tid >> 4, ncg = N / 64, nunits = ncg * (K / 256);
    for (int u = blockIdx.x; u < nunits; u += gridDim.x) {
        const int cgp = u % ncg, kc = u / ncg;
        f32x4 wq[8];
        { const float* wp = W + (size_t)(kc * 256 + kg * 8) * N + cgp * 64 + 4 * cg4;
#pragma unroll
          for (int kk = 0; kk < 8; ++kk) wq[kk] = ldg<f32x4>(wp + (size_t)kk * N); }
        __syncthreads();
        {
            float pv[4][4];
#pragma unroll
            for (int j = 0; j < 4; ++j)
#pragma unroll
                for (int pp = 0; pp < 4; ++pp) { const int i = tid + 512 * j, b = i >> 8, kk = i & 255; pv[j][pp] = (pp < in_parts) ? ldg<float>(in + ((size_t)pp * 8 + b) * K + kc * 256 + kk) : 0.f; }
#pragma unroll
            for (int j = 0; j < 4; ++j) { float v = (pv[j][0] + pv[j][1]) + (pv[j][2] + pv[j][3]); if (in_relu2) { v = fmaxf(v, 0.f); v = v * v; } cact[tid + 512 * j] = v; }
        }
        __syncthreads();
        f32x4 acc[8];
#pragma unroll
        for (int b = 0; b < 8; ++b) acc[b] = (f32x4){0.f, 0.f, 0.f, 0.f};
#pragma unroll
        for (int kk = 0; kk < 8; ++kk) {
            const f32x4 w = wq[kk];
#pragma unroll
            for (int b = 0; b < 8; ++b) acc[b] += w * cact[b * 256 + kg * 8 + kk];
        }
#pragma unroll
        for (int b = 0; b < 8; ++b) *(LAS f32x4*)(red + (kg * 8 + b) * 64 + 4 * cg4) = acc[b];
        __syncthreads();
        { const int b = tid >> 6, col = tid & 63; float sacc = 0.f;
#pragma unroll 8
          for (int g = 0; g < 32; ++g) sacc += red[(g * 8 + b) * 64 + col];
          stglob<float>(outp + ((size_t)kc * 8 + b) * N + cgp * 64 + col, sacc); }
    }
    __syncthreads();
}
__device__ __forceinline__ void shadow_gate(const float* proj0p, float* gated0, int wv_) {
    const int tid = opq_tid(wv_); const int lane = tid & 63, gw = blockIdx.x * 8 + (tid >> 6);
    if (gw < 32) {
        const int b = gw >> 2, h = gw & 3;
        f32x4 qv = {0.f, 0.f, 0.f, 0.f}, kv = qv, v0 = qv, v1 = qv, g0 = qv, g1 = qv;
#pragma unroll
        for (int pp = 0; pp < 4; ++pp) { const float* pr = proj0p + ((size_t)pp * 8 + b) * 6144;
            qv += ldg<f32x4>(pr + h * 256 + 4 * lane); kv += ldg<f32x4>(pr + 1024 + h * 256 + 4 * lane);
            v0 += ldg<f32x4>(pr + 2048 + h * 512 + 8 * lane); v1 += ldg<f32x4>(pr + 2048 + h * 512 + 8 * lane + 4);
            g0 += ldg<f32x4>(pr + 4096 + h * 512 + 8 * lane); g1 += ldg<f32x4>(pr + 4096 + h * 512 + 8 * lane + 4); }
        const float s00 = wave_sum((qv[0] * kv[0] + qv[1] * kv[1]) + (qv[2] * kv[2] + qv[3] * kv[3])) * 0.0625f;
        const f32x4 o0 = v0 * s00, o1 = v1 * s00;
        const float ss = wave_sum((o0[0] * o0[0] + o0[1] * o0[1]) + (o0[2] * o0[2] + o0[3] * o0[3]) + (o1[0] * o1[0] + o1[1] * o1[1]) + (o1[2] * o1[2] + o1[3] * o1[3]));
        const float rstd = rsqrtf(ss * (1.0f / 512.0f) + EPS);
        f32x4 r0, r1;
#pragma unroll
        for (int i = 0; i < 4; ++i) { r0[i] = (g0[i] / (1.0f + expf(-g0[i]))) * (o0[i] * rstd); r1[i] = (g1[i] / (1.0f + expf(-g1[i]))) * (o1[i] * rstd); }
        stglob<f32x4>(gated0 + (size_t)b * 2048 + h * 512 + 8 * lane, r0); stglob<f32x4>(gated0 + (size_t)b * 2048 + h * 512 + 8 * lane + 4, r1);
    }
}

__device__ __forceinline__ void transpose_item(const float* W, int K, int N, bf16_t* WT, LAS float* scr, int item, int lane) {
    const int nblk = N / 32, kb = item / nblk, nb = item % nblk, k0 = 64 * kb, n0 = 32 * nb;
    {
        float wv[32]; const float* wp = W + (size_t)(k0 + (lane >> 5)) * N + n0 + (lane & 31);
#pragma unroll
        for (int i = 0; i < 32; ++i) wv[i] = ldg<float>(wp + (size_t)(2 * i) * N);
        __builtin_amdgcn_sched_barrier(0);
#pragma unroll
        for (int i = 0; i < 32; ++i) scr[(2 * i + (lane >> 5)) * 33 + (lane & 31)] = wv[i];
    }
    asm volatile("s_waitcnt lgkmcnt(0)" ::: "memory");
    const int c = lane & 7;
#pragma unroll
    for (int j = 0; j < 4; ++j) { const int n = (lane >> 3) + 8 * j; const LAS float* s = scr + (8 * c) * 33 + n;
        u32x4 o; o.x = pk2(s[0 * 33], s[1 * 33]); o.y = pk2(s[2 * 33], s[3 * 33]); o.z = pk2(s[4 * 33], s[5 * 33]); o.w = pk2(s[6 * 33], s[7 * 33]);
        stglob<u32x4>(WT + (size_t)(n0 + n) * K + k0 + 8 * c, o); }
    asm volatile("s_waitcnt lgkmcnt(0)" ::: "memory");
}
struct WSpec { const float* W; int K, N; size_t off; };
__device__ __forceinline__ void convert_weights(LAS unsigned char* lds, bf16_t* wbuf, const WSpec& a, const WSpec& b, const WSpec& c, const WSpec& d, const WSpec& e, int nmat, int wv_) {
    const int tid = opq_tid(wv_); const int lane = tid & 63, wave = tid >> 6;
    LAS float* scr = (LAS float*)(lds + wave * 16384);
    const int gw = blockIdx.x * 8 + wave, NGW = gridDim.x * 8;
    const int ia = (a.K / 64) * (a.N / 32), ib = nmat > 1 ? (b.K / 64) * (b.N / 32) : 0, ic = nmat > 2 ? (c.K / 64) * (c.N / 32) : 0, id = nmat > 3 ? (d.K / 64) * (d.N / 32) : 0, ie = nmat > 4 ? (e.K / 64) * (e.N / 32) : 0;
    const int total = ia + ib + ic + id + ie;
    for (int it = gw; it < total; it += NGW) {
        int r = it;
        if (r < ia) { transpose_item(a.W, a.K, a.N, wbuf + a.off, scr, r, lane); continue; } r -= ia;
        if (r < ib) { transpose_item(b.W, b.K, b.N, wbuf + b.off, scr, r, lane); continue; } r -= ib;
        if (r < ic) { transpose_item(c.W, c.K, c.N, wbuf + c.off, scr, r, lane); continue; } r -= ic;
        if (r < id) { transpose_item(d.W, d.K, d.N, wbuf + d.off, scr, r, lane); continue; } r -= id;
        transpose_item(e.W, e.K, e.N, wbuf + e.off, scr, r, lane);
    }
}

__device__ __forceinline__ void rope_tables(const int* pos, float* rcos, float* rsin, float* dcos, float* dsin, int wv_) {
    const int gt = blockIdx.x * 512 + opq_tid(wv_), NT = gridDim.x * 512;
    {
        const int j = gt & 127;
        const float inv = (float)exp2(-(double)(2 * j) * (13.287712379549449 / 256.0));
        if (NT * 16 == MTOK * 128) {
            int pp[16];
#pragma unroll
            for (int k = 0; k < 16; ++k) pp[k] = ldg<int>(pos + ((gt + k * NT) >> 7));
            __builtin_amdgcn_sched_barrier(0);
#pragma unroll
            for (int k = 0; k < 16; ++k) { const int idx = gt + k * NT;
                const float ang = (float)pp[k] * inv;
                double rv = (double)ang * 0.15915494309189535; rv -= rint(rv);
                const float fr = (float)rv;
                stglob<float>(rcos + idx, __builtin_amdgcn_cosf(fr)); stglob<float>(rsin + idx, __builtin_amdgcn_sinf(fr)); }
        } else
        for (int idx = gt; idx < MTOK * 128; idx += NT) {
            const float ang = (float)ldg<int>(pos + (idx >> 7)) * inv;
            double rv = (double)ang * 0.15915494309189535; rv -= rint(rv);
            const float fr = (float)rv;
            stglob<float>(rcos + idx, __builtin_amdgcn_cosf(fr)); stglob<float>(rsin + idx, __builtin_amdgcn_sinf(fr));
        }
    }
    {
        const int j = gt & 7;
        const float inv = (float)exp2(-(double)(2 * j) * (18.931568569324174 / 16.0));
        for (int idx = gt; idx < MTOK * 8; idx += NT) {
            const float ang = (float)ldg<int>(pos + (idx >> 3)) * inv;
            double rv = (double)ang * 0.15915494309189535; rv -= rint(rv);
            const float fr = (float)rv;
            stglob<float>(dcos + idx, __builtin_amdgcn_cosf(fr)); stglob<float>(dsin + idx, __builtin_amdgcn_sinf(fr));
        }
    }
}

__device__ __forceinline__ void row_phase(const float* xin, float* xout, const float* y, const float* gy, const float* gate, int gate_bs,
                                          int nout, const float* g0, const float* sc0, const float* sh0, int bs0, bf16_t* d0,
                                          const float* g1, const float* sc1, const float* sh1, int bs1, bf16_t* d1, const float* ysh, int ysh_parts, float* h0s, int wv_) {
    const int tid = opq_tid(wv_); const int lane = tid & 63, gw = blockIdx.x * 8 + (tid >> 6), NGW = gridDim.x * 8;
    for (int row = gw; row < MTOK; row += NGW) {
        const int b = row >> 11;
        f32x4 xv[4];
#pragma unroll
        for (int j = 0; j < 4; ++j) xv[j] = ldg<f32x4>(xin + (size_t)row * 1024 + 4 * lane + 256 * j);
        if (y) {
            f32x4 yv[4]; float s = 0.f;
            const bool sh_ = ysh && (row & 2047) == 0;
#pragma unroll
            for (int j = 0; j < 4; ++j) { if (sh_) { f32x4 t = {0.f, 0.f, 0.f, 0.f};
_Pragma("unroll 1")
                for (int pp = 0; pp < ysh_parts; ++pp) { t += ldg<f32x4>(ysh + ((size_t)pp * 8 + b) * 1024 + 4 * lane + 256 * j); asm volatile("" : "+v"(t)); }
                yv[j] = t; } else yv[j] = ldg<f32x4>(y + (size_t)row * 1024 + 4 * lane + 256 * j); s += (yv[j][0] * yv[j][0] + yv[j][1] * yv[j][1]) + (yv[j][2] * yv[j][2] + yv[j][3] * yv[j][3]); }
            const float rstd = rsqrtf(wave_sum(s) * (1.0f / 1024.0f) + EPS);
#pragma unroll
            for (int j = 0; j < 4; ++j) { const int col = 4 * lane + 256 * j;
                const f32x4 gg = ldg<f32x4>(gy + col), ga = ldg<f32x4>(gate + (size_t)b * gate_bs + col);
                xv[j] += (ga + 1.0f) * (yv[j] * rstd * gg);
                stglob<f32x4>(xout + (size_t)row * 1024 + col, xv[j]); }
        }
        if (nout > 0) {
            float s = 0.f;
#pragma unroll
            for (int j = 0; j < 4; ++j) s += (xv[j][0] * xv[j][0] + xv[j][1] * xv[j][1]) + (xv[j][2] * xv[j][2] + xv[j][3] * xv[j][3]);
            const float rstd = rsqrtf(wave_sum(s) * (1.0f / 1024.0f) + EPS);
#pragma unroll
            for (int j = 0; j < 4; ++j) { const int col = 4 * lane + 256 * j;
                const f32x4 gg = ldg<f32x4>(g0 + col), sc = ldg<f32x4>(sc0 + (size_t)b * bs0 + col), sh = ldg<f32x4>(sh0 + (size_t)b * bs0 + col);
                const f32x4 h = (xv[j] * rstd * gg) * (sc + 1.0f) + sh;
                u32x2 w; w.x = pk2(h[0], h[1]); w.y = pk2(h[2], h[3]);
                stglob<u32x2>(d0 + (size_t)row * 1024 + col, w);
                if (h0s && (row & 2047) == 0) stglob<f32x4>(h0s + (size_t)b * 1024 + col, h); }
            if (nout > 1) {
#pragma unroll
                for (int j = 0; j < 4; ++j) { const int col = 4 * lane + 256 * j;
                    const f32x4 gg = ldg<f32x4>(g1 + col), sc = ldg<f32x4>(sc1 + (size_t)b * bs1 + col), sh = ldg<f32x4>(sh1 + (size_t)b * bs1 + col);
                    const f32x4 h = (xv[j] * rstd * gg) * (sc + 1.0f) + sh;
                    u32x2 w; w.x = pk2(h[0], h[1]); w.y = pk2(h[2], h[3]);
                    stglob<u32x2>(d1 + (size_t)row * 1024 + col, w); }
            }
        }
    }
}

__device__ __forceinline__ void gate_phase(const bf16_t* o, bf16_t* g, int wv_) {
    const int tid = opq_tid(wv_); const int lane = tid & 63;
    const bool xmap = (gridDim.x == 256);
    const int gw = xmap ? ((int)(blockIdx.x & 7) * 8192 + (int)(blockIdx.x >> 3) * 8 + (tid >> 6)) : ((int)blockIdx.x * 8 + (tid >> 6));
    const int NGW = xmap ? 256 : (int)gridDim.x * 8, itend = xmap ? ((int)(blockIdx.x & 7) + 1) * 8192 : MTOK * 4;
    for (int it0 = gw; it0 < itend; it0 += 4 * NGW) {
        u32x4 ov[4], gv[4];
#pragma unroll
        for (int k = 0; k < 4; ++k) { const int it = it0 + k * NGW; if (it < itend) {
            const int tok = it >> 2, h = it & 3, b = tok >> 11, n = (tok >> 7) & 15, c = tok & 127, cb = c >> 5, rho = c & 31, hi_ = (rho >> 2) & 1, r = (rho & 3) + 4 * (rho >> 3);
            const size_t so = ((size_t)((((b * 4 + h) * 16 + n) * 4 + cb) * 16 + (lane >> 2)) << 10) + r * 64 + hi_ * 32 + 8 * (lane & 3);
            ov[k] = ldg<u32x4>(o + so); gv[k] = ldg<u32x4>(g + (size_t)it * 512 + 8 * lane); } }
#pragma unroll
        for (int k = 0; k < 4; ++k) { const int it = it0 + k * NGW; if (it < itend) {
            const size_t off = (size_t)it * 512 + 8 * lane;
            float of[8], gf[8];
#pragma unroll
            for (int i = 0; i < 4; ++i) { of[2 * i] = __uint_as_float(ov[k][i] << 16); of[2 * i + 1] = __uint_as_float(ov[k][i] & 0xffff0000u);
                                          gf[2 * i] = __uint_as_float(gv[k][i] << 16); gf[2 * i + 1] = __uint_as_float(gv[k][i] & 0xffff0000u); }
            float ss = 0.f;
#pragma unroll
            for (int i = 0; i < 8; ++i) ss += of[i] * of[i];
            const float rstd = rsqrtf(wave_sum(ss) * (1.0f / 512.0f) + EPS);
            float rr[8];
#pragma unroll
            for (int i = 0; i < 8; ++i) rr[i] = (gf[i] / (1.0f + __expf(-gf[i]))) * (of[i] * rstd);
            u32x4 w; w.x = pk2(rr[0], rr[1]); w.y = pk2(rr[2], rr[3]); w.z = pk2(rr[4], rr[5]); w.w = pk2(rr[6], rr[7]);
            stglob<u32x4>(g + off, w); } }
    }
}

constexpr int P_LD = 136, R_LD = 264;
__device__ __forceinline__ void ret_intra(LAS unsigned char* lds, const bf16_t* q, const bf16_t* k, const bf16_t* vT, bf16_t* o, int wv_) {
    LAS bf16_t* Pl = (LAS bf16_t*)lds;
    const int tid = opq_tid(wv_); const int lane = tid & 63, wid = __builtin_amdgcn_readfirstlane(tid >> 6), l31 = lane & 31, hi = lane >> 5;
    for (int unit = blockIdx.x; unit < 512; unit += gridDim.x) {
        const int blk = unit & 255, bhh = (blk & 7) * 4 + (blk >> 6), n = ((blk >> 3) & 7) * 2 + (unit >> 8), b = bhh >> 2, h = bhh & 3;
        const float lg = __log2f(1.0f - exp2f(-5.0f - (float)h));
        const int t0 = b * 2048 + n * 128;
        const int cb = wid >> 1;
        {
            const bf16_t* qa = q + (size_t)(t0 + 32 * cb + l31) * 1024 + h * 256 + 8 * hi;
            bf16x8 qf[16];
#pragma unroll
            for (int ks = 0; ks < 16; ++ks) qf[ks] = ldg<bf16x8>(qa + 16 * ks);
#pragma unroll
            for (int mt = 0; mt < 2; ++mt) {
                const int mb = 2 * (wid & 1) + mt;
                f32x16 acc = zero16();
                if (mb <= cb) {
                    const bf16_t* kb = k + (size_t)(t0 + 32 * mb + l31) * 1024 + h * 256 + 8 * hi;
                    bf16x8 kf[16];
#pragma unroll
                    for (int ks = 0; ks < 16; ++ks) kf[ks] = ldg<bf16x8>(kb + 16 * ks);
                    __builtin_amdgcn_sched_barrier(0);
                    f32x16 accb = zero16();
#pragma unroll
                    for (int ks = 0; ks < 16; ks += 2) { acc = MFMA32(qf[ks], kf[ks], acc); accb = MFMA32(qf[ks + 1], kf[ks + 1], accb); }
                    acc += accb;
                }
#pragma unroll
                for (int r = 0; r < 16; ++r) {
                    const int c = 32 * cb + crow(r, hi), m = 32 * mb + l31, df = c - m;
                    const float v = (df >= 0) ? acc[r] * exp2f((float)df * lg) : 0.f;
                    Pl[c * P_LD + m] = f2bf(v);
                }
            }
        }
        __syncthreads();
        {
            bf16x8 pa[8];
#pragma unroll
            for (int ks = 0; ks < 8; ++ks) pa[ks] = *(const LAS bf16x8*)(Pl + (32 * cb + l31) * P_LD + 16 * ks + 8 * hi);
            for (int et = 0; et < 8; et += 2) {
                const int eb = (wid & 1) * 8 + et;
                const bf16_t* vb = vT + ((size_t)(b * 4 + h) * 512 + 32 * eb + l31) * 2048 + n * 128 + 8 * hi;
                bf16x8 vf[2][8];
#pragma unroll
                for (int ks = 0; ks < 8; ++ks) { vf[0][ks] = ldg<bf16x8>(vb + 16 * ks); vf[1][ks] = ldg<bf16x8>(vb + (size_t)32 * 2048 + 16 * ks); }
                __builtin_amdgcn_sched_barrier(0);
                f32x16 acc0 = zero16(), acc1 = zero16();
#pragma unroll
                for (int ks = 0; ks < 8; ++ks) { acc0 = MFMA32(pa[ks], vf[0][ks], acc0); acc1 = MFMA32(pa[ks], vf[1][ks], acc1); }
                bf16_t* op = o + ((size_t)((((b * 4 + h) * 16 + n) * 4 + cb) * 16 + eb) << 10) + lane;
#pragma unroll
                for (int r = 0; r < 16; ++r) { stglob<bf16_t>(op + r * 64, f2bf(acc0[r])); stglob<bf16_t>(op + 1024 + r * 64, f2bf(acc1[r])); }
            }
        }
        __syncthreads();
    }
}

constexpr int SV_LD = 136, SC_ROFF = 0, SC_RBYTES = 64 * R_LD * 2, SC_VOFF = 2 * SC_RBYTES, SC_VBYTES = 64 * SV_LD * 2;
__device__ __forceinline__ void ret_scan(LAS unsigned char* lds, const bf16_t* q, const bf16_t* kzT, const bf16_t* vT, bf16_t* o, int wv_) {
    const int tid = opq_tid(wv_); const int lane = tid & 63, wid = __builtin_amdgcn_readfirstlane(tid >> 6), l31 = lane & 31, hi = lane >> 5;
    for (int unit = blockIdx.x; unit < 256; unit += gridDim.x) {
        const int bhh = (unit & 7) * 4 + (unit >> 6), es = (unit >> 3) & 7, b = bhh >> 2, h = bhh & 3;
        const float lg = __log2f(1.0f - exp2f(-5.0f - (float)h));
        const float decay = exp2f(128.0f * lg);
        f32x16 Rt[2]; Rt[0] = zero16(); Rt[1] = zero16();
        const int cb = wid >> 1, eb2 = wid & 1;
        const bf16_t* vsrc = vT + ((size_t)(b * 4 + h) * 512 + es * 64 + (tid >> 4)) * 2048 + (tid & 15) * 8;
        const int vdst = SC_VOFF + ((tid >> 4) * SV_LD + (tid & 15) * 8) * 2;
        const bf16_t* kzb = kzT + ((size_t)(b * 4 + h) * 256 + 32 * wid + l31) * 2048 + 8 * hi;
        const bf16_t* qrow = q + (size_t)(b * 2048 + 32 * cb + l31) * 1024 + h * 256 + 8 * hi;
        bf16_t* orow = o + ((size_t)(((b * 4 + h) * 16 * 4 + cb) * 16 + es * 2 + eb2) << 10) + lane;
        const int vfo = (l31 * SV_LD + 8 * hi) * 2;
        bf16x8 qa[16], kz[8]; u32x4 vst[2]; unsigned short oi[16];
#pragma unroll
        for (int c0 = 0; c0 < 2; ++c0) { vst[0] = ldg<u32x4>(vsrc + c0 * 128); vst[1] = ldg<u32x4>(vsrc + (size_t)32 * 2048 + c0 * 128);
            LAS unsigned char* nb = lds + vdst + c0 * SC_VBYTES; *(LAS u32x4*)(nb) = vst[0]; *(LAS u32x4*)(nb + 32 * SV_LD * 2) = vst[1]; }
        vst[0] = ldg<u32x4>(vsrc + 256); vst[1] = ldg<u32x4>(vsrc + (size_t)32 * 2048 + 256);
#pragma unroll
        for (int ks = 0; ks < 8; ++ks) kz[ks] = ldg<bf16x8>(kzb + 16 * ks);
#pragma unroll
        for (int ks = 0; ks < 16; ++ks) qa[ks] = ldg<bf16x8>(qrow + (size_t)128 * 1024 + 16 * ks);
#pragma unroll
        for (int r = 0; r < 16; ++r) oi[r] = ldg<unsigned short>(orow + 65536 + r * 64);
        __syncthreads();
        int vs = 0;
        for (int n = 0; n < 16; ++n) {
            LAS bf16_t* Rl = (LAS bf16_t*)(lds + SC_ROFF + (n & 1) * SC_RBYTES);
            if (n > 0) {
#pragma unroll
                for (int eb = 0; eb < 2; ++eb)
#pragma unroll
                    for (int r = 0; r < 16; ++r) Rl[(32 * eb + crow(r, hi)) * R_LD + 32 * wid + l31] = f2bf(Rt[eb][r]);
            }
            if (n < 15) {
                const LAS unsigned char* Vl = lds + SC_VOFF + vs * SC_VBYTES + vfo;
                f32x16 r0 = Rt[0] * decay, r1 = Rt[1] * decay;
#pragma unroll
                for (int ks = 0; ks < 8; ++ks) { r0 = MFMA32(*(const LAS bf16x8*)(Vl + 32 * ks), kz[ks], r0); r1 = MFMA32(*(const LAS bf16x8*)(Vl + 32 * SV_LD * 2 + 32 * ks), kz[ks], r1); }
                Rt[0] = r0; Rt[1] = r1;
                if (n < 14) {
#pragma unroll
                    for (int ks = 0; ks < 8; ++ks) kz[ks] = ldg<bf16x8>(kzb + (n + 1) * 128 + 16 * ks);
                }
            }
            if (n > 0) {
                __syncthreads();
                f32x16 acc = zero16();
#pragma unroll
                for (int ks = 0; ks < 16; ++ks) acc = MFMA32(qa[ks], *(const LAS bf16x8*)(Rl + (32 * eb2 + l31) * R_LD + 16 * ks + 8 * hi), acc);
                bf16_t* op = orow + (size_t)n * 65536;
#pragma unroll
                for (int r = 0; r < 16; ++r) stglob<bf16_t>(op + r * 64, f2bf(bf2f(oi[r]) + acc[r] * exp2f((float)(32 * cb + crow(r, hi) + 1) * lg)));
                if (n < 15) {
#pragma unroll
                    for (int ks = 0; ks < 16; ++ks) qa[ks] = ldg<bf16x8>(qrow + (size_t)((n + 1) * 128) * 1024 + 16 * ks);
#pragma unroll
                    for (int r = 0; r < 16; ++r) oi[r] = ldg<unsigned short>(op + 65536 + r * 64);
                }
            }
            const int vs1 = (vs == 2) ? 0 : vs + 1, vs2 = (vs1 == 2) ? 0 : vs1 + 1;
            if (n + 2 < 15) { LAS unsigned char* nb = lds + vdst + vs2 * SC_VBYTES; *(LAS u32x4*)(nb) = vst[0]; *(LAS u32x4*)(nb + 32 * SV_LD * 2) = vst[1]; }
            if (n + 3 < 15) { vst[0] = ldg<u32x4>(vsrc + (n + 3) * 128); vst[1] = ldg<u32x4>(vsrc + (size_t)32 * 2048 + (n + 3) * 128); }
            vs = vs1;
        }
        __syncthreads();
    }
}

constexpr int AT_LD = 72;
constexpr int AT_KBYTES = 2 * 64 * AT_LD * 2, AT_VBYTES = 128 * AT_LD * 2, AT_BUF = AT_KBYTES + AT_VBYTES;
__device__ __forceinline__ void diff_attn(LAS unsigned char* lds, const bf16_t* qb_, const bf16_t* ksh, const bf16_t* vTsh, bf16_t* aout,
                                          const float* lam, const float* subg, float linit, int wv_) {
    LAS float* xch = (LAS float*)lds;
    const int tid = opq_tid(wv_); const int lane = tid & 63, wid = __builtin_amdgcn_readfirstlane(tid >> 6), l31 = lane & 31, hi = lane >> 5, grp = wid >> 2, wq = wid & 3;
    float lam_full;
    { const float p1 = ldg<float>(lam + lane) * ldg<float>(lam + 64 + lane), p2 = ldg<float>(lam + 128 + lane) * ldg<float>(lam + 192 + lane);
      lam_full = expf(wave_sum(p1)) - expf(wave_sum(p2)) + linit; }
    const int pi_l = 16 * (((l31 & 3) + 4 * (l31 >> 3)) >> 3) + 8 * ((l31 >> 2) & 1) + (((l31 & 3) + 4 * (l31 >> 3)) & 7);
    const int kg0 = tid >> 9, kr0 = (tid >> 3) & 63, kc = tid & 7;
    for (int u = blockIdx.x; u < 1024; u += gridDim.x) {
        const int vv = u & 255, ii = u >> 8, bh = (vv & 7) * 8 + (vv >> 5), s4 = (vv >> 3) & 3;
        const int qblk = (ii == 0) ? s4 : (ii == 1) ? 7 - s4 : (ii == 2) ? 8 + s4 : 15 - s4;
        const int b = bh >> 3, H = bh & 7, head = 2 * H + grp;
        const int qs0 = qblk * 128 + 32 * wq, myq = qs0 + l31;
        bf16x8 qf[4];
        { const bf16_t* qp = qb_ + (size_t)(b * 2048 + myq) * 1024 + head * 64 + 8 * hi;
#pragma unroll
          for (int ks = 0; ks < 4; ++ks) qf[ks] = ldg<bf16x8>(qp + 16 * ks); }
        f32x16 OT[4];
#pragma unroll
        for (int e = 0; e < 4; ++e) OT[e] = zero16();
        float m_run = -1e30f, l_run = 0.f;
        const int T_blk = 2 * qblk + 2, tmax_w = 2 * qblk + (wq >> 1);
        const bf16_t* ksrc0 = ksh + (size_t)(b * 2048 + kr0) * 1024 + (2 * H) * 64 + kc * 8;
        const bf16_t* vsrc0 = vTsh + ((size_t)(b * 8 + H) * 128 + (tid >> 3)) * 2048 + kc * 8;
        const int kdst = (kr0 * AT_LD + kc * 8) * 2, vdst = AT_KBYTES + ((tid >> 3) * AT_LD + kc * 8) * 2;
        u32x4 stg[4];
        stg[0] = ldg<u32x4>(ksrc0); stg[1] = ldg<u32x4>(ksrc0 + 64); stg[2] = ldg<u32x4>(vsrc0); stg[3] = ldg<u32x4>(vsrc0 + (size_t)64 * 2048);
        *(LAS u32x4*)(lds + kdst) = stg[0]; *(LAS u32x4*)(lds + kdst + 64 * AT_LD * 2) = stg[1];
        *(LAS u32x4*)(lds + vdst) = stg[2]; *(LAS u32x4*)(lds + vdst + 64 * AT_LD * 2) = stg[3];
        { const bf16_t* kn = ksrc0 + (size_t)64 * 1024; const bf16_t* vn = vsrc0 + 64;
          stg[0] = ldg<u32x4>(kn); stg[1] = ldg<u32x4>(kn + 64); stg[2] = ldg<u32x4>(vn); stg[3] = ldg<u32x4>(vn + (size_t)64 * 2048); }
        __syncthreads();
        const int koff = ((grp * 64 + pi_l) * AT_LD + 8 * hi) * 2, voff = AT_KBYTES + (l31 * AT_LD + 8 * hi) * 2;
        bf16x8 pfk[4]; bool pend = false; int slot = 0, slotp = 0;
#define ATT_PV(SLOT, PF) do { const LAS unsigned char* Vl_ = lds + (SLOT) * AT_BUF + voff; bf16x8 vf0[8], vf1[8]; \
            _Pragma("unroll") for (int e2 = 0; e2 < 2; ++e2) _Pragma("unroll") for (int c = 0; c < 4; ++c) { vf0[4 * e2 + c] = *(const LAS bf16x8*)(Vl_ + ((32 * e2) * AT_LD + 16 * c) * 2); vf1[4 * e2 + c] = *(const LAS bf16x8*)(Vl_ + ((32 * (2 + e2)) * AT_LD + 16 * c) * 2); } \
            __builtin_amdgcn_sched_barrier(0); \
            _Pragma("unroll") for (int c = 0; c < 4; ++c) { OT[0] = MFMA32(vf0[c], PF[c], OT[0]); OT[1] = MFMA32(vf0[4 + c], PF[c], OT[1]); } \
            _Pragma("unroll") for (int c = 0; c < 4; ++c) { OT[2] = MFMA32(vf1[c], PF[c], OT[2]); OT[3] = MFMA32(vf1[4 + c], PF[c], OT[3]); } \
            __builtin_amdgcn_sched_barrier(0); } while (0)
        for (int t = 0; t < T_blk; ++t) {
            const int kv0 = 64 * t;
            const int slot1 = (slot == 2) ? 0 : slot + 1;
            if (t + 1 < T_blk) { LAS unsigned char* nb = lds + slot1 * AT_BUF;
                                 *(LAS u32x4*)(nb + kdst) = stg[0]; *(LAS u32x4*)(nb + kdst + 64 * AT_LD * 2) = stg[1];
                                 *(LAS u32x4*)(nb + vdst) = stg[2]; *(LAS u32x4*)(nb + vdst + 64 * AT_LD * 2) = stg[3]; }
            if (t + 2 < T_blk) { const bf16_t* kn = ksrc0 + (size_t)(kv0 + 128) * 1024; const bf16_t* vn = vsrc0 + kv0 + 128;
                                 stg[0] = ldg<u32x4>(kn); stg[1] = ldg<u32x4>(kn + 64); stg[2] = ldg<u32x4>(vn); stg[3] = ldg<u32x4>(vn + (size_t)64 * 2048); }
            if (grp == 1 && pend) ATT_PV(slotp, pfk);
            const bool active = (t <= tmax_w);
            if (active) {
                const LAS unsigned char* Kl = lds + slot * AT_BUF + koff;
                f32x16 acc[2];
                {
                    bf16x8 kfr[8];
#pragma unroll
                    for (int j = 0; j < 2; ++j)
#pragma unroll
                        for (int ks = 0; ks < 4; ++ks) kfr[4 * j + ks] = *(const LAS bf16x8*)(Kl + ((32 * j) * AT_LD + 16 * ks) * 2);
                    __builtin_amdgcn_sched_barrier(0);
                    acc[0] = zero16(); acc[1] = zero16();
#pragma unroll
                    for (int ks = 0; ks < 4; ++ks) { acc[0] = MFMA32(kfr[ks], qf[ks], acc[0]); acc[1] = MFMA32(kfr[4 + ks], qf[ks], acc[1]); }
                    __builtin_amdgcn_sched_barrier(0);
                }
                if (t == tmax_w) {
#pragma unroll
                    for (int j = 0; j < 2; ++j)
#pragma unroll
                        for (int r = 0; r < 16; ++r) { const int kv = kv0 + 32 * j + 16 * (r >> 3) + 8 * hi + (r & 7); if (kv > myq) acc[j][r] = -INFINITY; }
                }
                float rm = fmaxf(acc[0][0], acc[1][0]);
#pragma unroll
                for (int r = 1; r < 16; ++r) rm = fmaxf(rm, fmaxf(acc[0][r], acc[1][r]));
                rm = max_halves(rm);
                const float m_new = fmaxf(m_run, rm);
                const float alpha = __builtin_amdgcn_exp2f(m_run - m_new);
                float rs = 0.f;
#pragma unroll
                for (int j = 0; j < 2; ++j)
#pragma unroll
                    for (int r = 0; r < 16; ++r) { acc[j][r] = __builtin_amdgcn_exp2f(acc[j][r] - m_new); rs += acc[j][r]; }
                rs = sum_halves(rs);
                l_run = l_run * alpha + rs; m_run = m_new;
                if (__builtin_amdgcn_ballot_w64(alpha != 1.0f) != 0ull) {
#pragma unroll
                    for (int e = 0; e < 4; ++e) OT[e] *= alpha;
                }
#pragma unroll
                for (int j = 0; j < 2; ++j)
#pragma unroll
                    for (int kk = 0; kk < 2; ++kk) { u32x4 w; w.x = pk2(acc[j][8 * kk], acc[j][8 * kk + 1]); w.y = pk2(acc[j][8 * kk + 2], acc[j][8 * kk + 3]);
                                                     w.z = pk2(acc[j][8 * kk + 4], acc[j][8 * kk + 5]); w.w = pk2(acc[j][8 * kk + 6], acc[j][8 * kk + 7]);
                                                     pfk[2 * j + kk] = __builtin_bit_cast(bf16x8, w); }
                __builtin_amdgcn_sched_barrier(0);
                if (grp == 0) ATT_PV(slot, pfk);
            }
            pend = active;
            __syncthreads();
            slotp = slot; slot = slot1;
        }
        if (grp == 1 && pend) ATT_PV(slotp, pfk);
#undef ATT_PV
        __syncthreads();
        const float inv = 1.0f / l_run;
        if (grp == 1) {
            const float f = inv * lam_full;
#pragma unroll
            for (int e = 0; e < 4; ++e)
#pragma unroll
                for (int r = 0; r < 16; ++r) xch[(wq * 64 + e * 16 + r) * 64 + lane] = OT[e][r] * f;
        }
        __syncthreads();
        if (grp == 0) {
            float ss = 0.f;
#pragma unroll
            for (int e = 0; e < 4; ++e)
#pragma unroll
                for (int r = 0; r < 16; ++r) { const float v = OT[e][r] * inv - xch[(wq * 64 + e * 16 + r) * 64 + lane]; OT[e][r] = v; ss += v * v; }
            ss = sum_halves(ss);
            const float rstd = rsqrtf(ss * (1.0f / 128.0f) + EPS) * (1.0f - linit);
            bf16_t* op = aout + (size_t)(b * 2048 + myq) * 1024 + H * 128;
#pragma unroll
            for (int e = 0; e < 4; ++e)
#pragma unroll
                for (int a = 0; a < 4; ++a) {
                    const int e0 = 32 * e + 8 * a + 4 * hi;
                    const f32x4 gg = ldg<f32x4>(subg + e0);
                    u32x2 w; w.x = pk2(OT[e][4 * a] * rstd * gg[0], OT[e][4 * a + 1] * rstd * gg[1]); w.y = pk2(OT[e][4 * a + 2] * rstd * gg[2], OT[e][4 * a + 3] * rstd * gg[3]);
                    stglob<u32x2>(op + e0, w);
                }
        }
        __syncthreads();
    }
}

#define XB_TMO      128
#define XB_XCNT(j)  (256  + 64 * (j))
#define XB_XSUB(j)  (1280 + 64 * (j))
#define XB_XGEN(j)  (2304 + 64 * (j))
#define XB_TOP      3328
#define XB_TOPGEN   3392
#define XCD_BAR_WORDS 3456
#define XB_SPIN_CAP (1u << 18)

__device__ __forceinline__ unsigned xb_ld(unsigned* p)              { return __hip_atomic_load(p, __ATOMIC_RELAXED, __HIP_MEMORY_SCOPE_AGENT); }
__device__ __forceinline__ unsigned xb_add(unsigned* p, unsigned v) { return __hip_atomic_fetch_add(p, v, __ATOMIC_RELAXED, __HIP_MEMORY_SCOPE_AGENT); }
__device__ __forceinline__ unsigned xb_xcc_id() { return (unsigned)__builtin_amdgcn_s_getreg((3 << 11) | 20) & 0xFu; }
#define XB_SPIN(cond, bar) do { unsigned _sp = 0; while (cond) { __builtin_amdgcn_s_sleep(1); \
    if ((++_sp & 255u) == 0u) { if (xb_ld(&(bar)[XB_TMO])) break; if (_sp > XB_SPIN_CAP) { atomicAdd(&(bar)[XB_TMO], 1u); break; } } } } while (0)

struct XcdBarrier {
    unsigned* bar; unsigned x;
    volatile LAS unsigned* st;
};

__device__ __forceinline__ XcdBarrier xcd_barrier_post(unsigned* bar, volatile LAS unsigned* st, int wv_) {
    XcdBarrier b; b.bar = bar; b.x = xb_xcc_id(); b.st = st;
    if (opq_tid(wv_) == 0) (void)xb_add(&bar[XB_XCNT(b.x)], 1u);
    return b;
}
__device__ __forceinline__ void xcd_barrier_complete(unsigned* bar, unsigned x, unsigned& nloc, unsigned& nx) {
    const unsigned G = gridDim.x * gridDim.y * gridDim.z;
    unsigned sum, cnt, mine, sp = 0u;
    for (;;) {
        sum = 0u; cnt = 0u; mine = 0u;
#pragma unroll
        for (unsigned j = 0; j < 16; ++j) { const unsigned c = xb_ld(&bar[XB_XCNT(j)]); sum += c; cnt += (c > 0u) ? 1u : 0u; mine = (j == x) ? c : mine; }
        if (sum == G) break;
        __builtin_amdgcn_s_sleep(1);
        if ((++sp & 255u) == 0u) { if (xb_ld(&bar[XB_TMO])) break; if (sp > XB_SPIN_CAP) { atomicAdd(&bar[XB_TMO], 1u); break; } }
    }
    nloc = mine > 0u ? mine : 1u; nx = cnt > 0u ? cnt : 1u;
}

__device__ __forceinline__ void xcd_barrier(const XcdBarrier& b, int wv_) {
    asm volatile("s_waitcnt vmcnt(0)" ::: "memory");
    __syncthreads();
    if (opq_tid(wv_) == 0) {
        unsigned* bar = b.bar;
        __builtin_amdgcn_s_waitcnt(0);
        unsigned nloc = b.st[0], nx = b.st[1];
        if (nloc == 0u) { xcd_barrier_complete(bar, b.x, nloc, nx); b.st[0] = nloc; b.st[1] = nx; }
        const unsigned old = xb_add(&bar[XB_XSUB(b.x)], 1u);
        const unsigned gen = old / nloc;
        if (old + 1u == (gen + 1u) * nloc) {
            __builtin_amdgcn_fence(__ATOMIC_RELEASE, "agent");
            asm volatile("s_waitcnt vmcnt(0)" ::: "memory");
            const unsigned og = xb_add(&bar[XB_TOP], 1u);
            const unsigned tg = og / nx;
            if (og + 1u == (tg + 1u) * nx) xb_add(&bar[XB_TOPGEN], 1u);
            else XB_SPIN(xb_ld(&bar[XB_TOPGEN]) == tg, bar);
            __builtin_amdgcn_fence(__ATOMIC_ACQUIRE, "agent");
            xb_add(&bar[XB_XGEN(b.x)], 1u);
            asm volatile("s_waitcnt vmcnt(0)" ::: "memory");
        } else {
            XB_SPIN(xb_ld(&bar[XB_XGEN(b.x)]) == gen, bar);
            __builtin_amdgcn_fence(__ATOMIC_ACQUIRE, "agent");
            asm volatile("s_waitcnt vmcnt(0)" ::: "memory");
        }
    }
    __syncthreads();
}

struct Params {
    const float *x, *c; const int* pos;
    const float *norm_g, *ada_w, *ada_b, *ret_w_in, *ret_w_out, *kv_norm_g, *kv_ada_w, *kv_ada_b, *kv_w, *diff_w_q, *diff_w_o, *diff_lam, *diff_subln_g, *mlp_w1, *mlp_w2;
    float* out; unsigned char* ws; float linit2, linit3, pad0, pad1;
};
constexpr int LDS_BYTES = 147456;
#ifndef REP_ATT
#define REP_ATT 1
#endif
#ifndef REP_RET
#define REP_RET 1
#endif
#ifndef REP_GEMM
#define REP_GEMM 1
#endif
#ifndef REP_ROW0
#define REP_ROW0 1
#endif

constexpr int PTAB_OFF = 131072 + 128;
enum { PT_X = 0, PT_C, PT_POS, PT_NORMG, PT_ADAW, PT_ADAB, PT_RWIN, PT_RWOUT, PT_KVNG, PT_KVAW, PT_KVAB, PT_KVW, PT_DWQ, PT_DWO, PT_DLAM, PT_DSG, PT_W1, PT_W2, PT_OUT, PT_WS, PT_N };
__device__ __forceinline__ unsigned long long ptab_get(LAS unsigned char* lds, int i) {
    unsigned zero_ = 0; asm volatile("" : "+v"(zero_));
    volatile LAS unsigned* t = (volatile LAS unsigned*)(lds + zero_ + PTAB_OFF) + 2 * i;
    const unsigned lo = __builtin_amdgcn_readfirstlane(t[0]), hi = __builtin_amdgcn_readfirstlane(t[1]);
    return ((unsigned long long)hi << 32) | lo;
}
#define PIN_(i, T) ((T)ptab_get(lds, (i)))
__device__ __forceinline__ unsigned long long ws_at(LAS unsigned char* lds, unsigned off_kb) { unsigned o = off_kb; asm volatile("" : "+s"(o)); return ptab_get(lds, PT_WS) + ((unsigned long long)o << 10); }
#define WSP(T, off) ((T)ws_at(lds, (unsigned)((size_t)(off) >> 10)))

__device__ __forceinline__ void convert_layer(LAS unsigned char* lds, int l, int part, int wv_) {
    bf16_t* wbuf = WSP(bf16_t*, WS_W);
    const float* w1 = PIN_(PT_W1, const float*) + (size_t)l * 1024 * 4096; const float* w2 = PIN_(PT_W2, const float*) + (size_t)l * 4096 * 1024;
    if (l < 2) {
        WSpec a{PIN_(PT_RWIN, const float*) + (size_t)l * 1024 * 6144, 1024, 6144, WO_RET_IN}, b{PIN_(PT_RWOUT, const float*) + (size_t)l * 2048 * 1024, 2048, 1024, WO_RET_OUT},
              c{w1, 1024, 4096, WO_RET_W1}, d{w2, 4096, 1024, WO_RET_W2};
        if (part == 1) convert_weights(lds, wbuf, d, d, d, d, d, 1, wv_); else convert_weights(lds, wbuf, a, b, c, d, d, part == 0 ? 3 : 4, wv_);
    } else {
        const int j = l - 2;
        WSpec a{PIN_(PT_DWQ, const float*) + (size_t)j * 1024 * 1024, 1024, 1024, WO_DF_Q}, b{PIN_(PT_DWO, const float*) + (size_t)j * 1024 * 1024, 1024, 1024, WO_DF_O},
              c{w1, 1024, 4096, WO_DF_W1}, d{w2, 4096, 1024, WO_DF_W2}, e{PIN_(PT_KVW, const float*), 1024, 2048, WO_DF_KV};
        if (part == 1) convert_weights(lds, wbuf, d, d, d, d, d, 1, wv_);
        else if (part == 0) { if (l == 2) convert_weights(lds, wbuf, a, b, c, e, e, 4, wv_); else convert_weights(lds, wbuf, a, b, c, c, c, 3, wv_); }
        else convert_weights(lds, wbuf, a, b, c, d, e, l == 2 ? 5 : 4, wv_);
    }
}

__device__ __forceinline__ void shadow_presum(LAS unsigned char* lds, const pg8::StaticOrder& S, const float* ysh, int parts, int wv_) {
    pg8::Unit u0;
    if (S.next(0, u0) && (u0.pm & 7) == 0) {
        const int t = opq_tid(wv_);
        if (t < 256) { float a = 0.f; const float* src = ysh + (size_t)(u0.pm >> 3) * 1024 + u0.pn * 256 + t;
#pragma unroll 8
            for (int pp = 0; pp < parts; ++pp) a += ldg<float>(src + (size_t)pp * 8 * 1024);
            ((LAS float*)(lds + 131072 + 1024))[t] = a; }
    }
    __syncthreads();
}

constexpr size_t WS_H0S = WS_KVMOD + 131072, WS_GATED0 = WS_KVMOD + 393216, WS_BARW = WS_XCNT + 1048576;
constexpr size_t WS_PROJ0 = 374 * MiB, WS_Y0S = 375 * MiB, WS_U0S = 376 * MiB;

__global__ void __launch_bounds__(512, 2) yoco_fwd(Params p) {
    extern __shared__ __attribute__((aligned(16))) unsigned char lds_raw[];
    LAS unsigned char* lds = (LAS unsigned char*)lds_raw;
    cg::grid_group grid = cg::this_grid();
    const int G = gridDim.x, bx = blockIdx.x;
    const int wv_ = __builtin_amdgcn_readfirstlane((int)(threadIdx.x >> 6));
    {
        volatile LAS unsigned* bst = (volatile LAS unsigned*)(lds + 131072 + 64);
        if (threadIdx.x < 2) bst[threadIdx.x] = 0u;
        if (threadIdx.x == 0) {
            LAS unsigned long long* t = (LAS unsigned long long*)(lds + PTAB_OFF);
            t[PT_X] = (unsigned long long)p.x; t[PT_C] = (unsigned long long)p.c; t[PT_POS] = (unsigned long long)p.pos; t[PT_NORMG] = (unsigned long long)p.norm_g;
            t[PT_ADAW] = (unsigned long long)p.ada_w; t[PT_ADAB] = (unsigned long long)p.ada_b; t[PT_RWIN] = (unsigned long long)p.ret_w_in; t[PT_RWOUT] = (unsigned long long)p.ret_w_out;
            t[PT_KVNG] = (unsigned long long)p.kv_norm_g; t[PT_KVAW] = (unsigned long long)p.kv_ada_w; t[PT_KVAB] = (unsigned long long)p.kv_ada_b; t[PT_KVW] = (unsigned long long)p.kv_w;
            t[PT_DWQ] = (unsigned long long)p.diff_w_q; t[PT_DWO] = (unsigned long long)p.diff_w_o; t[PT_DLAM] = (unsigned long long)p.diff_lam; t[PT_DSG] = (unsigned long long)p.diff_subln_g;
            t[PT_W1] = (unsigned long long)p.mlp_w1; t[PT_W2] = (unsigned long long)p.mlp_w2; t[PT_OUT] = (unsigned long long)p.out; t[PT_WS] = (unsigned long long)p.ws;
        }
        __syncthreads();
    }
    (void)xcd_barrier_post((unsigned*)(p.ws + WS_BARW), (volatile LAS unsigned*)(lds + 131072 + 64), wv_);
#define GSYNC() do { XcdBarrier xb_; xb_.bar = WSP(unsigned*, WS_BARW); xb_.x = xb_xcc_id(); xb_.st = (volatile LAS unsigned*)(lds + 131072 + 64); xcd_barrier(xb_, wv_); } while (0)
    if (p.ws == nullptr) grid.sync();
    p0_mod_gemv(lds, PIN_(PT_C, const float*), PIN_(PT_ADAW, const float*), PIN_(PT_ADAB, const float*), PIN_(PT_KVAW, const float*), PIN_(PT_KVAB, const float*), WSP(float*, WS_MOD), WSP(float*, WS_KVMOD), wv_);
    __syncthreads();
    convert_layer(lds, 0, 2, wv_);
    rope_tables(PIN_(PT_POS, const int*), WSP(float*, WS_RCOS), WSP(float*, WS_RSIN), WSP(float*, WS_DCOS), WSP(float*, WS_DSIN), wv_);
    GSYNC();
    { float* mod = WSP(float*, WS_MOD);
      row_phase(PIN_(PT_X, const float*), nullptr, nullptr, nullptr, nullptr, 0, 1, PIN_(PT_NORMG, const float*), mod + 1024, mod, 6144, WSP(bf16_t*, WS_H), nullptr, nullptr, nullptr, 0, nullptr, nullptr, 0, WSP(float*, WS_H0S), wv_); }
    GSYNC();

    for (int l = 0; l < 4; ++l) {
        const bool fusedp = (G == 256);
        const size_t hkv_off = fusedp ? WS_Y : (WS_R + 64 * MiB);
        if (l < 2) {
            {
                bf16_t* wsb = WSP(bf16_t*, 0);
                pg8::Gemm g{(const bf16_t*)((unsigned char*)wsb + WS_H), (const bf16_t*)((unsigned char*)wsb + WS_W) + WO_RET_IN, MTOK, 6144, 1024}; pg8::StaticOrder S; S.init(MTOK, 6144, G, bx);
                pg8::EpiRetProj E{(bf16_t*)((unsigned char*)wsb + WS_A), (bf16_t*)((unsigned char*)wsb + WS_B), (bf16_t*)((unsigned char*)wsb + WS_KZT), (bf16_t*)((unsigned char*)wsb + WS_VT), (bf16_t*)((unsigned char*)wsb + WS_R),
                                  (const float*)((unsigned char*)wsb + WS_RCOS), (const float*)((unsigned char*)wsb + WS_RSIN)};
                for (int rep = 0; rep < REP_GEMM; ++rep) pg8::gemm_phase<pg8::EpiRetProj, pg8::StaticOrder, true, true>(lds, g, S, E, wv_);
            }
            gemv8p(lds, WSP(const float*, WS_H0S), 1, 0, 1024, PIN_(PT_RWIN, const float*) + (size_t)l * 1024 * 6144, 6144, WSP(float*, WS_PROJ0), wv_);
            if (fusedp && l > 0) convert_layer(lds, l, 1, wv_);
            GSYNC();
            shadow_gate(WSP(const float*, WS_PROJ0), WSP(float*, WS_GATED0), wv_);
            ret_intra(lds, WSP(const bf16_t*, WS_A), WSP(const bf16_t*, WS_B), WSP(const bf16_t*, WS_VT), WSP(bf16_t*, WS_R + 64 * MiB), wv_);
            GSYNC();
            ret_scan(lds, WSP(const bf16_t*, WS_A), WSP(const bf16_t*, WS_KZT), WSP(const bf16_t*, WS_VT), WSP(bf16_t*, WS_R + 64 * MiB), wv_);
            gemv8p(lds, WSP(const float*, WS_GATED0), 1, 0, 2048, PIN_(PT_RWOUT, const float*) + (size_t)l * 2048 * 1024, 1024, WSP(float*, WS_Y0S), wv_);
            GSYNC();
            gate_phase(WSP(const bf16_t*, WS_R + 64 * MiB), WSP(bf16_t*, WS_R), wv_);
            GSYNC();
        } else {
            {
                unsigned char* wsb = WSP(unsigned char*, 0);
                pg8::Gemm g{(const bf16_t*)(wsb + WS_H), (const bf16_t*)(wsb + WS_W) + WO_DF_Q, MTOK, 1024, 1024}; pg8::StaticOrder S; S.init(MTOK, 1024, G, bx);
                pg8::EpiRope64<false> E{(bf16_t*)(wsb + WS_R), nullptr, (const float*)(wsb + WS_DCOS), (const float*)(wsb + WS_DSIN), 0.125f * 1.4426950408889634f};
                for (int rep = 0; rep < REP_GEMM; ++rep) pg8::gemm_phase<pg8::EpiRope64<false>, pg8::StaticOrder, true, true>(lds, g, S, E, wv_);
            }
            if (l == 2) {
                unsigned char* wsb = WSP(unsigned char*, 0);
                pg8::Gemm g{(const bf16_t*)(wsb + hkv_off), (const bf16_t*)(wsb + WS_W) + WO_DF_KV, MTOK, 2048, 1024}; pg8::StaticOrder S; S.init(MTOK, 2048, G, bx);
                pg8::EpiRope64<true> E{(bf16_t*)(wsb + WS_A), (bf16_t*)(wsb + WS_B), (const float*)(wsb + WS_DCOS), (const float*)(wsb + WS_DSIN), 1.0f};
                for (int rep = 0; rep < REP_GEMM; ++rep) pg8::gemm_phase<pg8::EpiRope64<true>, pg8::StaticOrder, true, true>(lds, g, S, E, wv_);
            }
            if (fusedp) convert_layer(lds, l, 1, wv_);
            GSYNC();
            for (int rep = 0; rep < REP_ATT; ++rep)
            diff_attn(lds, WSP(const bf16_t*, WS_R), WSP(const bf16_t*, WS_A), WSP(const bf16_t*, WS_B), WSP(bf16_t*, WS_R + 32 * MiB),
                      PIN_(PT_DLAM, const float*) + (size_t)(l - 2) * 256, PIN_(PT_DSG, const float*) + (size_t)(l - 2) * 128, (l == 2) ? p.linit2 : p.linit3, wv_);
            GSYNC();
        }
        if (fusedp) {
            unsigned char* wsb = WSP(unsigned char*, 0);
            const float* ng = PIN_(PT_NORMG, const float*) + (size_t)l * 4 * 1024; const float* modl = (const float*)(wsb + WS_MOD) + (size_t)l * 8 * 6144;
            float* outp = PIN_(PT_OUT, float*);
            pg8::Gemm g{(const bf16_t*)(wsb + WS_R + (l < 2 ? 0 : 32 * MiB)), (const bf16_t*)(wsb + WS_W) + (l < 2 ? WO_RET_OUT : WO_DF_O), MTOK, 1024, (l < 2) ? 2048 : 1024};
            pg8::StaticOrder S; S.init(MTOK, 1024, G, bx);
            pg8::RmsStats s1{(unsigned long long*)(wsb + WS_XB1), (unsigned)(l * 4 + 1)}, s2{(unsigned long long*)(wsb + WS_XB2), (unsigned)(l * 4 + 2)};
            pg8::EpiResNorm E{(l == 0) ? PIN_(PT_X, const float*) : (const float*)outp, outp, ng + 1024, modl + 2048, 6144,
                              1, ng + 2048, modl + 4096, modl + 3072, 6144, (bf16_t*)(wsb + WS_H), nullptr, nullptr, nullptr, 0, nullptr,
                              (l < 2) ? (const float*)(wsb + WS_Y0S) : nullptr, 8, (l < 2) ? (float*)(wsb + WS_H0S) : nullptr, s1, s2};
            if (l < 2) shadow_presum(lds, S, (const float*)(wsb + WS_Y0S), 8, wv_);
            pg8::gemm_phase<pg8::EpiResNorm, pg8::StaticOrder, false, true>(lds, g, S, E, wv_);
            GSYNC();
        } else {
            {
                unsigned char* wsb = WSP(unsigned char*, 0);
                pg8::Gemm g{(const bf16_t*)(wsb + WS_R + (l < 2 ? 0 : 32 * MiB)), (const bf16_t*)(wsb + WS_W) + (l < 2 ? WO_RET_OUT : WO_DF_O), MTOK, 1024, (l < 2) ? 2048 : 1024};
                pg8::StaticOrder S; S.init(MTOK, 1024, G, bx);
                pg8::EpiF32 E{(float*)(wsb + WS_Y), 1024};
                for (int rep = 0; rep < REP_GEMM; ++rep) pg8::gemm_phase<pg8::EpiF32, pg8::StaticOrder, true, true>(lds, g, S, E, wv_);
            }
            GSYNC();
            {
                const float* ng = PIN_(PT_NORMG, const float*) + (size_t)l * 4 * 1024; const float* modl = WSP(const float*, WS_MOD) + (size_t)l * 8 * 6144;
                float* outp = PIN_(PT_OUT, float*);
                row_phase((l == 0) ? PIN_(PT_X, const float*) : (const float*)outp, outp, WSP(const float*, WS_Y), ng + 1024, modl + 2048, 6144, 1, ng + 2048, modl + 4096, modl + 3072, 6144, WSP(bf16_t*, WS_H),
                          nullptr, nullptr, nullptr, 0, nullptr, (l < 2) ? WSP(const float*, WS_Y0S) : nullptr, 8, (l < 2) ? WSP(float*, WS_H0S) : nullptr, wv_);
            }
            GSYNC();
        }
        {
            unsigned char* wsb = WSP(unsigned char*, 0);
            pg8::Gemm g{(const bf16_t*)(wsb + WS_H), (const bf16_t*)(wsb + WS_W) + (l < 2 ? WO_RET_W1 : WO_DF_W1), MTOK, 4096, 1024}; pg8::StaticOrder S; S.init(MTOK, 4096, G, bx);
            pg8::EpiRelu2 E{(bf16_t*)(wsb + WS_R), 4096};
            for (int rep = 0; rep < REP_GEMM; ++rep) pg8::gemm_phase<pg8::EpiRelu2, pg8::StaticOrder, true, true>(lds, g, S, E, wv_);
        }
        if (l < 2) gemv8p(lds, WSP(const float*, WS_H0S), 1, 0, 1024, PIN_(PT_W1, const float*) + (size_t)l * 1024 * 4096, 4096, WSP(float*, WS_U0S), wv_);
        GSYNC();
        if (l < 2) {
            gemv8p(lds, WSP(const float*, WS_U0S), 4, 1, 4096, PIN_(PT_W2, const float*) + (size_t)l * 4096 * 1024, 1024, WSP(float*, WS_Y0S), wv_);
            GSYNC();
        }
        if (fusedp) {
            unsigned char* wsb = WSP(unsigned char*, 0);
            const float* ng = PIN_(PT_NORMG, const float*) + (size_t)l * 4 * 1024; const float* modl = (const float*)(wsb + WS_MOD) + (size_t)l * 8 * 6144;
            const float* ngn = ng + 4 * 1024; const float* modn = modl + 8 * 6144; const float* kvmod = (const float*)(wsb + WS_KVMOD);
            float* outp = PIN_(PT_OUT, float*);
            pg8::Gemm g{(const bf16_t*)(wsb + WS_R), (const bf16_t*)(wsb + WS_W) + (l < 2 ? WO_RET_W2 : WO_DF_W2), MTOK, 1024, 4096}; pg8::StaticOrder S; S.init(MTOK, 1024, G, bx);
            pg8::RmsStats s1{(unsigned long long*)(wsb + WS_XB1), (unsigned)(l * 4 + 3)}, s2{(unsigned long long*)(wsb + WS_XB2), (unsigned)(l * 4 + 4)};
            pg8::EpiResNorm E{(const float*)outp, outp, ng + 3072, modl + 5120, 6144,
                              (l == 3) ? 0 : ((l == 1) ? 2 : 1), ngn, modn + 1024, modn, 6144, (bf16_t*)(wsb + WS_H),
                              PIN_(PT_KVNG, const float*), kvmod + 1024, kvmod, 2048, (bf16_t*)(wsb + hkv_off),
                              (l < 2) ? (const float*)(wsb + WS_Y0S) : nullptr, 16, (l == 0) ? (float*)(wsb + WS_H0S) : nullptr, s1, s2};
            if (l < 2) shadow_presum(lds, S, (const float*)(wsb + WS_Y0S), 16, wv_);
            pg8::gemm_phase<pg8::EpiResNorm, pg8::StaticOrder, false, true>(lds, g, S, E, wv_);
            if (l < 3) { __syncthreads(); convert_layer(lds, l + 1, 0, wv_); GSYNC(); }
        } else {
            {
                unsigned char* wsb = WSP(unsigned char*, 0);
                pg8::Gemm g{(const bf16_t*)(wsb + WS_R), (const bf16_t*)(wsb + WS_W) + (l < 2 ? WO_RET_W2 : WO_DF_W2), MTOK, 1024, 4096}; pg8::StaticOrder S; S.init(MTOK, 1024, G, bx);
                pg8::EpiF32 E{(float*)(wsb + WS_Y), 1024};
                for (int rep = 0; rep < REP_GEMM; ++rep) pg8::gemm_phase<pg8::EpiF32, pg8::StaticOrder, true, true>(lds, g, S, E, wv_);
            }
            GSYNC();
            {
                const float* ng = PIN_(PT_NORMG, const float*) + (size_t)l * 4 * 1024; const float* mod = WSP(const float*, WS_MOD); const float* modl = mod + (size_t)l * 8 * 6144;
                float* outp = PIN_(PT_OUT, float*);
                if (l < 3) {
                    const float* ngn = ng + 4 * 1024; const float* modn = modl + 8 * 6144; const float* kvmod = WSP(const float*, WS_KVMOD);
                    row_phase(outp, outp, WSP(const float*, WS_Y), ng + 3072, modl + 5120, 6144, (l == 1) ? 2 : 1, ngn, modn + 1024, modn, 6144, WSP(bf16_t*, WS_H),
                              PIN_(PT_KVNG, const float*), kvmod + 1024, kvmod, 2048, WSP(bf16_t*, hkv_off), (l < 2) ? WSP(const float*, WS_Y0S) : nullptr, 16, (l == 0) ? WSP(float*, WS_H0S) : nullptr, wv_);
                    __syncthreads();
                    convert_layer(lds, l + 1, 2, wv_);
                    GSYNC();
                } else {
                    row_phase(outp, outp, WSP(const float*, WS_Y), ng + 3072, modl + 5120, 6144, 0, nullptr, nullptr, nullptr, 0, nullptr, nullptr, nullptr, nullptr, 0, nullptr, nullptr, 0, nullptr, wv_);
                }
            }
        }
    }
}

extern "C" void kernel_launch(void* const* d_in, const int* in_sizes, int n_in, void* d_out, int out_size, void* d_ws, size_t ws_size, hipStream_t stream) {
    static int grid_blocks = 0;
    if (!grid_blocks) {
        int dev = 0, cus = 0, per_cu = 0;
        hipGetDevice(&dev);
        hipDeviceGetAttribute(&cus, hipDeviceAttributeMultiprocessorCount, dev);
        hipFuncSetAttribute((const void*)yoco_fwd, hipFuncAttributeMaxDynamicSharedMemorySize, LDS_BYTES);
        if (hipOccupancyMaxActiveBlocksPerMultiprocessor(&per_cu, (const void*)yoco_fwd, 512, LDS_BYTES) != hipSuccess || per_cu < 1) per_cu = 1;
        (void)hipGetLastError();
        if (cus < 1) cus = 256;
        grid_blocks = cus * per_cu;
    }
    Params p{};
    p.x = (const float*)d_in[0]; p.c = (const float*)d_in[1]; p.pos = (const int*)d_in[2];
    p.norm_g = (const float*)d_in[3]; p.ada_w = (const float*)d_in[4]; p.ada_b = (const float*)d_in[5];
    p.ret_w_in = (const float*)d_in[6]; p.ret_w_out = (const float*)d_in[7]; p.kv_norm_g = (const float*)d_in[8];
    p.kv_ada_w = (const float*)d_in[9]; p.kv_ada_b = (const float*)d_in[10]; p.kv_w = (const float*)d_in[11];
    p.diff_w_q = (const float*)d_in[12]; p.diff_w_o = (const float*)d_in[13]; p.diff_lam = (const float*)d_in[14];
    p.diff_subln_g = (const float*)d_in[15]; p.mlp_w1 = (const float*)d_in[16]; p.mlp_w2 = (const float*)d_in[17];
    p.out = (float*)d_out; p.ws = (unsigned char*)d_ws;
    p.linit2 = (float)(0.8 - 0.6 * exp(-0.3 * 2.0)); p.linit3 = (float)(0.8 - 0.6 * exp(-0.3 * 3.0));
    (void)hipMemsetAsync((char*)d_ws + WS_XCNT, 0, 1048576 + 16384, stream);
    void* args[] = {&p};
    hipError_t e = hipLaunchCooperativeKernel((const void*)yoco_fwd, dim3(grid_blocks), dim3(512), args, LDS_BYTES, stream);
    if (e != hipSuccess) fprintf(stderr, "cooperative launch failed: %s (grid %d)\n", hipGetErrorString(e), grid_blocks);
}
```
